# Optimizing an MI355X kernel written in HIP

```python
import numpy as np
import jax
import jax.numpy as jnp
from jax import lax


D_MODEL = 1024
BATCH = 2
SEQ = 8192
DEPTH = 2

GRID_W = 64
CTX_LEN = 256
EPS = 1e-6
NEG = -1e30
TINY = 1e-30
N_MOD = 6
N_BRANCHES = 4
CONV_CH = 256
CONV_K = 31
HG_HEADS = 4
HG_DK = 64
HG_DV = 64
HG_W = HG_HEADS * HG_DK
HG_V = HG_HEADS * HG_DV
GLA_HEADS = 4
GLA_DK = 32
GLA_DV = 64
GLA_K = GLA_HEADS * GLA_DK
GLA_V = GLA_HEADS * GLA_DV
GLA_RANK = 16
GLA_TAU = 16.0
CHUNK = 64
ATT_HEADS = 4
ATT_KV_HEADS = 2
ATT_HD = 64
ATT_Q = ATT_HEADS * ATT_HD
ATT_KV = ATT_KV_HEADS * ATT_HD
WINDOW = 128
ATT_BLOCK = 128
ROPE_BASE = 10000.0
N_EXPERTS = 16
N_GROUPS = 4
TOP_K = 2
EXPERT_FF = 1024
MOE_BLOCK = 256

IN_NAMES = ('conv_u', 'hg_q', 'hg_f_fwd', 'hg_f_bwd', 'hg_i', 'hg_gate',
            'gla_q', 'gla_k', 'gla_v', 'gla_a_fwd', 'gla_a_bwd', 'gla_gate',
            'att_q', 'att_k', 'att_v', 'branch_gate')
IN_SPLITS = (2 * CONV_CH, HG_W, HG_W, HG_W, HG_V, HG_V,
             GLA_K, GLA_K, GLA_V, GLA_RANK, GLA_RANK, GLA_V,
             ATT_Q, ATT_KV, ATT_KV, N_BRANCHES * D_MODEL)
W_IN_COLS = sum(IN_SPLITS)

kernel_name = 'hybrid_flow_backbone_block'


def rmsnorm(x, g):
    xf = x.astype(jnp.float32)
    y = xf * lax.rsqrt(jnp.mean(xf * xf, axis=-1, keepdims=True) + EPS)
    return (y * g.astype(jnp.float32)).astype(x.dtype)


def head_rmsnorm(o, g, n_heads):
    B, T, W = o.shape
    of = o.astype(jnp.float32).reshape(B, T, n_heads, W // n_heads)
    of = of * lax.rsqrt(jnp.mean(of * of, axis=-1, keepdims=True) + EPS)
    return of.reshape(B, T, W) * g.astype(jnp.float32)


def split_cols(p):
    idx = np.cumsum(IN_SPLITS)[:-1].tolist()
    return dict(zip(IN_NAMES, jnp.split(p, idx, axis=-1)))


def to_heads(a, n_heads):
    B, T, W = a.shape
    return a.reshape(B, T, n_heads, W // n_heads).transpose(0, 2, 1, 3)


def from_heads(a):
    B, H, T, d = a.shape
    return a.transpose(0, 2, 1, 3).reshape(B, T, H * d)


def axial_rope_tables(n_tokens):
    rows = n_tokens // GRID_W
    row = jnp.broadcast_to(jnp.arange(rows, dtype=jnp.float32)[:, None], (rows, GRID_W)).reshape(-1)
    col = jnp.broadcast_to(jnp.arange(GRID_W, dtype=jnp.float32)[None, :], (rows, GRID_W)).reshape(-1)
    half = ATT_HD // 4
    inv = ROPE_BASE ** (-jnp.arange(half, dtype=jnp.float32) / half)
    ang = jnp.stack([row[:, None] * inv, col[:, None] * inv], axis=1)
    return jnp.cos(ang), jnp.sin(ang)


def apply_rope(x, cos, sin):
    B, T, H, hd = x.shape
    xa = x.astype(jnp.float32).reshape(B, T, H, 2, 2, hd // 4)
    x1, x2 = xa[..., 0, :], xa[..., 1, :]
    c = cos[None, :, None]
    s = sin[None, :, None]
    out = jnp.stack([x1 * c - x2 * s, x1 * s + x2 * c], axis=-2)
    return out.reshape(B, T, H, hd).astype(x.dtype)


def conformer_conv(u, dw_w, dw_b, ln_g, ln_b):
    a, b = jnp.split(u, 2, axis=-1)
    z = a * jax.nn.sigmoid(b)
    ch = z.shape[-1]
    z = lax.conv_general_dilated(z, dw_w[:, None, :].astype(z.dtype), window_strides=(1,),
                                 padding=((CONV_K // 2, CONV_K // 2),),
                                 dimension_numbers=('NWC', 'WIO', 'NWC'),
                                 feature_group_count=ch) + dw_b
    zf = z.astype(jnp.float32)
    mu = jnp.mean(zf, axis=-1, keepdims=True)
    var = jnp.mean(jnp.square(zf - mu), axis=-1, keepdims=True)
    zn = (zf - mu) * lax.rsqrt(var + EPS) * ln_g + ln_b
    return jax.nn.silu(zn)


def chunk_gated_scan(q, k, v, g, s0):
    B, H, T, dk = q.shape
    dv = v.shape[-1]
    n = T // CHUNK

    def chunks(a):
        return jnp.moveaxis(a.astype(jnp.float32).reshape(B, H, n, CHUNK, a.shape[-1]), 2, 0)

    tri = jnp.tril(jnp.ones((CHUNK, CHUNK), dtype=bool))[:, :, None]

    def step(state, inp):
        qc, kc, vc, gc = inp
        b = jnp.cumsum(gc, axis=2)
        o = jnp.einsum('bhtk,bhkv->bhtv', qc * jnp.exp(b), state)
        diff = b[:, :, :, None, :] - b[:, :, None, :, :]
        decay = jnp.where(tri, jnp.exp(jnp.minimum(diff, 0.0)), 0.0)
        scores = jnp.einsum('bhtk,bhsk,bhtsk->bhts', qc, kc, decay)
        o = o + jnp.einsum('bhts,bhsv->bhtv', scores, vc)
        b_last = b[:, :, -1:, :]
        state = (jnp.exp(b_last[:, :, 0, :, None]) * state
                 + jnp.einsum('bhsk,bhsv->bhkv', kc * jnp.exp(b_last - b), vc))
        return state, o

    state, o = lax.scan(step, s0.astype(jnp.float32), (chunks(q), chunks(k), chunks(v), chunks(g)))
    return jnp.moveaxis(o, 0, 2).reshape(B, H, T, dv), state


def bidir_gated_scan(ctx_in, lat_in):
    qc, kc, vc, gc = ctx_in
    ql, kl, vl, gl = lat_in
    B, H, _, dk = qc.shape
    s0 = jnp.zeros((B, H, dk, vc.shape[-1]), jnp.float32)

    def flip(a):
        return jnp.flip(a, axis=2)

    oc_f, sc_f = chunk_gated_scan(qc, kc[0], vc, gc[0], s0)
    ol_f, _ = chunk_gated_scan(ql, kl[0], vl, gl[0], sc_f)
    oc_b, sc_b = chunk_gated_scan(flip(qc), flip(kc[1]), flip(vc), flip(gc[1]), s0)
    ol_b, _ = chunk_gated_scan(flip(ql), flip(kl[1]), flip(vl), flip(gl[1]), sc_b)
    return oc_f + flip(oc_b), ol_f + flip(ol_b)


def hgrn2_inputs(p, lb):
    q = to_heads(p['hg_q'], HG_HEADS)
    ks, gs = [], []
    for name, lb_d in (('hg_f_fwd', lb[0]), ('hg_f_bwd', lb[1])):
        z = p[name].astype(jnp.float32)
        f = lb_d + (1.0 - lb_d) * jax.nn.sigmoid(z)
        ks.append(to_heads((1.0 - lb_d) * jax.nn.sigmoid(-z), HG_HEADS))
        gs.append(to_heads(jnp.log(jnp.maximum(f, TINY)), HG_HEADS))
    return q, (ks[0], ks[1]), to_heads(p['hg_i'], HG_HEADS), (gs[0], gs[1])


def gla_inputs(p, w2, b2):
    q = to_heads(p['gla_q'], GLA_HEADS) * GLA_DK ** -0.5
    k = to_heads(p['gla_k'], GLA_HEADS)
    v = to_heads(p['gla_v'], GLA_HEADS)
    g_f = to_heads(jax.nn.log_sigmoid((p['gla_a_fwd'] @ w2[0] + b2[0]).astype(jnp.float32)) / GLA_TAU, GLA_HEADS)
    g_b = to_heads(jax.nn.log_sigmoid((p['gla_a_bwd'] @ w2[1] + b2[1]).astype(jnp.float32)) / GLA_TAU, GLA_HEADS)
    return q, (k, k), v, (g_f, g_b)


def attn_heads(p):
    B, T, _ = p['att_q'].shape
    return (p['att_q'].reshape(B, T, ATT_HEADS, ATT_HD),
            p['att_k'].reshape(B, T, ATT_KV_HEADS, ATT_HD),
            p['att_v'].reshape(B, T, ATT_KV_HEADS, ATT_HD))


def window_sink_attention(q, k, v, kc, vc, sink):
    B, T, Hq, hd = q.shape
    Hkv = k.shape[2]
    G = Hq // Hkv
    nb = T // ATT_BLOCK
    L = kc.shape[1]
    qb = q.reshape(B, nb, ATT_BLOCK, Hkv, G, hd) * hd ** -0.5

    def band(a):
        pad = jnp.zeros((B, ATT_BLOCK, Hkv, hd), a.dtype)
        ap = jnp.concatenate([pad, a, pad], axis=1)
        return jnp.concatenate([ap[:, i * ATT_BLOCK:i * ATT_BLOCK + T].reshape(B, nb, ATT_BLOCK, Hkv, hd)
                                for i in range(3)], axis=2)

    kb, vb = band(k), band(v)
    q_pos = jnp.arange(nb)[:, None] * ATT_BLOCK + jnp.arange(ATT_BLOCK)[None, :]
    k_pos = jnp.arange(nb)[:, None] * ATT_BLOCK - ATT_BLOCK + jnp.arange(3 * ATT_BLOCK)[None, :]
    valid = ((jnp.abs(q_pos[:, :, None] - k_pos[:, None, :]) <= WINDOW)
             & (k_pos >= 0)[:, None, :] & (k_pos < T)[:, None, :])
    s_band = jnp.einsum('bnqhgd,bnshd->bnhgqs', qb, kb).astype(jnp.float32)
    s_band = jnp.where(valid[None, :, None, None], s_band, NEG)
    s_ctx = jnp.einsum('bnqhgd,bchd->bnhgqc', qb, kc).astype(jnp.float32)
    s_sink = jnp.broadcast_to(sink.astype(jnp.float32).reshape(1, 1, Hkv, G, 1, 1), s_band.shape[:-1] + (1,))
    p = jax.nn.softmax(jnp.concatenate([s_band, s_ctx, s_sink], axis=-1), axis=-1)
    nk = 3 * ATT_BLOCK
    out = (jnp.einsum('bnhgqs,bnshd->bnqhgd', p[..., :nk].astype(vb.dtype), vb)
           + jnp.einsum('bnhgqc,bchd->bnqhgd', p[..., nk:nk + L].astype(vc.dtype), vc))
    return out.reshape(B, T, Hq * hd)


def context_sink_attention(qc, kc, vc, sink):
    B, L, Hq, hd = qc.shape
    Hkv = kc.shape[2]
    G = Hq // Hkv
    qg = qc.reshape(B, L, Hkv, G, hd) * hd ** -0.5
    s = jnp.einsum('bqhgd,bchd->bhgqc', qg, kc).astype(jnp.float32)
    s_sink = jnp.broadcast_to(sink.astype(jnp.float32).reshape(1, Hkv, G, 1, 1), s.shape[:-1] + (1,))
    p = jax.nn.softmax(jnp.concatenate([s, s_sink], axis=-1), axis=-1)[..., :L]
    return jnp.einsum('bhgqc,bchd->bqhgd', p.astype(vc.dtype), vc).reshape(B, L, Hq * hd)


def moe_ffn(h, router_w, router_b, w1, w3, w2):
    n_tok, d = h.shape
    epg = N_EXPERTS // N_GROUPS
    aff = jax.nn.sigmoid(h.astype(jnp.float32) @ router_w.astype(jnp.float32))
    grouped = (aff + router_b.astype(jnp.float32)).reshape(n_tok, N_GROUPS, epg)
    best_group = jnp.argmax(lax.top_k(grouped, TOP_K)[0].sum(-1), axis=-1)
    _, local = lax.top_k(grouped[jnp.arange(n_tok), best_group], TOP_K)
    expert = best_group[:, None] * epg + local
    gate = jnp.take_along_axis(aff, expert, axis=1)
    gate = gate / jnp.sum(gate, axis=-1, keepdims=True)

    n_slot = n_tok * TOP_K
    e_flat = expert.reshape(-1)
    order = jnp.argsort(e_flat)
    e_sorted = e_flat[order]
    tok_sorted = (order // TOP_K).astype(jnp.int32)
    gate_sorted = gate.reshape(-1)[order]
    counts = jnp.zeros((N_EXPERTS,), jnp.int32).at[e_flat].add(1)
    starts = jnp.cumsum(counts) - counts
    padded = (counts + MOE_BLOCK - 1) // MOE_BLOCK * MOE_BLOCK
    padded_end = jnp.cumsum(padded)
    padded_start = padded_end - padded
    dest = padded_start[e_sorted] + jnp.arange(n_slot, dtype=jnp.int32) - starts[e_sorted]
    n_blocks = -(-n_slot // MOE_BLOCK) + N_EXPERTS
    n_rows = n_blocks * MOE_BLOCK
    row_tok = jnp.full((n_rows,), n_tok, jnp.int32).at[dest].set(tok_sorted)
    row_gate = jnp.zeros((n_rows,), jnp.float32).at[dest].set(gate_sorted)
    block_expert = jnp.minimum(
        jnp.searchsorted(padded_end, jnp.arange(n_blocks, dtype=jnp.int32) * MOE_BLOCK, side='right'),
        N_EXPERTS - 1)
    xs = jnp.concatenate([h, jnp.zeros((1, d), h.dtype)], axis=0)[row_tok].reshape(n_blocks, MOE_BLOCK, d)

    def expert_block(args):
        xb, e = args
        return (jax.nn.silu(xb @ w1[e]) * (xb @ w3[e])) @ w2[e]

    ys = lax.map(expert_block, (xs, block_expert)).reshape(n_rows, d)
    out = jax.ops.segment_sum(ys.astype(jnp.float32) * row_gate[:, None], row_tok, num_segments=n_tok + 1)
    return out[:n_tok].astype(h.dtype)


def mixing_sublayer(hc, hl, cos, sin, lb, w_in, conv_w, conv_b, conv_ln_g, conv_ln_b,
                    hg_norm_g, gla_w2, gla_b2, gla_norm_g, att_sink,
                    w_br_conv, w_br_hg, w_br_gla, w_br_att, w_out, need_ctx_out):
    pc = split_cols(hc @ w_in)
    pl = split_cols(hl @ w_in)
    hg_c, hg_l = bidir_gated_scan(hgrn2_inputs(pc, lb), hgrn2_inputs(pl, lb))
    gla_c, gla_l = bidir_gated_scan(gla_inputs(pc, gla_w2, gla_b2), gla_inputs(pl, gla_w2, gla_b2))
    qc, kc, vc = attn_heads(pc)
    ql, kl, vl = attn_heads(pl)
    att_l = window_sink_attention(apply_rope(ql, cos, sin), apply_rope(kl, cos, sin), vl, kc, vc, att_sink)

    def branch_merge(p, hg_o, gla_o, att_o):
        conv_y = conformer_conv(p['conv_u'], conv_w, conv_b, conv_ln_g, conv_ln_b)
        hg_y = head_rmsnorm(from_heads(hg_o), hg_norm_g, HG_HEADS) * jax.nn.silu(p['hg_gate'].astype(jnp.float32))
        gla_y = head_rmsnorm(from_heads(gla_o), gla_norm_g, GLA_HEADS) * jax.nn.silu(p['gla_gate'].astype(jnp.float32))
        branches = (conv_y @ w_br_conv, hg_y @ w_br_hg, gla_y @ w_br_gla, att_o @ w_br_att)
        gates = jnp.split(jax.nn.sigmoid(p['branch_gate'].astype(jnp.float32)), N_BRANCHES, axis=-1)
        merged = gates[0] * branches[0]
        for gt, br in zip(gates[1:], branches[1:]):
            merged = merged + gt * br
        return merged @ w_out

    mix_l = branch_merge(pl, hg_l, gla_l, att_l)
    mix_c = branch_merge(pc, hg_c, gla_c, context_sink_attention(qc, kc, vc, att_sink)) if need_ctx_out else None
    return mix_c, mix_l


def hybrid_layer(xc, xl, c, c_ctx, cos, sin, lb, router_w, router_b, w_mod, b_mod, g_mix, g_ffn, w_in,
                 conv_w, conv_b, conv_ln_g, conv_ln_b, hg_norm_g, gla_w2, gla_b2, gla_norm_g, att_sink,
                 w_br_conv, w_br_hg, w_br_gla, w_br_att, w_out, moe_w1, moe_w3, moe_w2, need_ctx_out):
    mod_l = jnp.split((jax.nn.silu(c) @ w_mod + b_mod)[:, None], N_MOD, axis=-1)
    mod_c = jnp.split((jax.nn.silu(c_ctx) @ w_mod + b_mod)[None, None], N_MOD, axis=-1)

    def modulated_norm(x, g, shift, scale):
        return rmsnorm(x, g) * (1 + scale) + shift

    mix_c, mix_l = mixing_sublayer(
        modulated_norm(xc, g_mix, mod_c[0], mod_c[1]), modulated_norm(xl, g_mix, mod_l[0], mod_l[1]),
        cos, sin, lb, w_in, conv_w, conv_b, conv_ln_g, conv_ln_b, hg_norm_g, gla_w2, gla_b2, gla_norm_g,
        att_sink, w_br_conv, w_br_hg, w_br_gla, w_br_att, w_out, need_ctx_out)
    xl = xl + mod_l[2] * mix_l
    h2l = modulated_norm(xl, g_ffn, mod_l[3], mod_l[4])
    d = xl.shape[-1]
    if need_ctx_out:
        xc = xc + mod_c[2] * mix_c
        h2c = modulated_norm(xc, g_ffn, mod_c[3], mod_c[4])
        n_ctx = xc.shape[1]
        h2 = jnp.concatenate([h2c, h2l], axis=1)
        y = moe_ffn(h2.reshape(-1, d), router_w, router_b, moe_w1, moe_w3, moe_w2).reshape(h2.shape)
        return xc + mod_c[5] * y[:, :n_ctx], xl + mod_l[5] * y[:, n_ctx:]
    y = moe_ffn(h2l.reshape(-1, d), router_w, router_b, moe_w1, moe_w3, moe_w2).reshape(h2l.shape)
    return None, xl + mod_l[5] * y


def setup_inputs(seed: int = 0) -> dict:
    key = jax.random.key(seed)
    keys = iter(jax.random.split(key, 32))

    def nrm(shape, scale):
        return jax.random.normal(next(keys), shape, jnp.float32) * scale

    D = D_MODEL
    L = DEPTH
    return {
        'x': nrm((BATCH, SEQ, D), 1.0),
        'c': nrm((BATCH, D), 1.0),
        'ctx': nrm((BATCH, CTX_LEN, D), 1.0),
        'c_ctx': nrm((D,), 1.0),
        'hg_lb_logits': nrm((L, 2, HG_W), 0.5),
        'router_w': nrm((D, N_EXPERTS), D ** -0.5),
        'router_b': nrm((N_EXPERTS,), 0.01),
        'final_g': 1.0 + nrm((D,), 0.05),
        'w_mod': nrm((L, D, N_MOD * D), 0.5 * D ** -0.5),
        'b_mod': nrm((L, N_MOD * D), 0.02),
        'g_mix': 1.0 + nrm((L, D), 0.05),
        'g_ffn': 1.0 + nrm((L, D), 0.05),
        'w_in': nrm((L, D, W_IN_COLS), D ** -0.5),
        'conv_w': nrm((L, CONV_K, CONV_CH), CONV_K ** -0.5),
        'conv_b': nrm((L, CONV_CH), 0.02),
        'conv_ln_g': 1.0 + nrm((L, CONV_CH), 0.05),
        'conv_ln_b': nrm((L, CONV_CH), 0.02),
        'hg_norm_g': 1.0 + nrm((L, HG_V), 0.05),
        'gla_w2': nrm((L, 2, GLA_RANK, GLA_K), GLA_RANK ** -0.5),
        'gla_b2': nrm((L, 2, GLA_K), 0.1),
        'gla_norm_g': 1.0 + nrm((L, GLA_V), 0.05),
        'att_sink': nrm((L, ATT_HEADS), 0.5),
        'w_br_conv': nrm((L, CONV_CH, D), CONV_CH ** -0.5),
        'w_br_hg': nrm((L, HG_V, D), HG_V ** -0.5),
        'w_br_gla': nrm((L, GLA_V, D), GLA_V ** -0.5),
        'w_br_att': nrm((L, ATT_Q, D), ATT_Q ** -0.5),
        'w_out': nrm((L, D, D), D ** -0.5),
        'moe_w1': nrm((L, N_EXPERTS, D, EXPERT_FF), D ** -0.5),
        'moe_w3': nrm((L, N_EXPERTS, D, EXPERT_FF), D ** -0.5),
        'moe_w2': nrm((L, N_EXPERTS, EXPERT_FF, D), EXPERT_FF ** -0.5),
    }


def reference(x, c, ctx, c_ctx, hg_lb_logits, router_w, router_b, final_g, w_mod, b_mod, g_mix, g_ffn,
              w_in, conv_w, conv_b, conv_ln_g, conv_ln_b, hg_norm_g, gla_w2, gla_b2, gla_norm_g, att_sink,
              w_br_conv, w_br_hg, w_br_gla, w_br_att, w_out, moe_w1, moe_w3, moe_w2):
    cos, sin = axial_rope_tables(x.shape[1])
    lb_sm = jax.nn.softmax(hg_lb_logits.astype(jnp.float32), axis=0)
    lower_bounds = jnp.cumsum(lb_sm, axis=0) - lb_sm[0]
    xc, xl = ctx, x
    for l in range(DEPTH):
        xc, xl = hybrid_layer(
            xc, xl, c, c_ctx, cos, sin, lower_bounds[l], router_w, router_b,
            w_mod[l], b_mod[l], g_mix[l], g_ffn[l], w_in[l], conv_w[l], conv_b[l], conv_ln_g[l], conv_ln_b[l],
            hg_norm_g[l], gla_w2[l], gla_b2[l], gla_norm_g[l], att_sink[l],
            w_br_conv[l], w_br_hg[l], w_br_gla[l], w_br_att[l], w_out[l],
            moe_w1[l], moe_w3[l], moe_w2[l], need_ctx_out=(l < DEPTH - 1))
    return rmsnorm(xl, final_g)
```

```cpp
#include <hip/hip_runtime.h>
#include <cstdio>
#include <cstdint>

#ifndef MK_N_LAUNCHES
#define MK_N_LAUNCHES 1
#endif

#define GAS __attribute__((address_space(1)))
#define LAS __attribute__((address_space(3)))
typedef unsigned short bf16;
typedef short bf16x8 __attribute__((ext_vector_type(8)));
typedef short s16x4 __attribute__((ext_vector_type(4)));
typedef float f32x4 __attribute__((ext_vector_type(4)));
typedef float f32x2 __attribute__((ext_vector_type(2)));
typedef unsigned u32x4 __attribute__((ext_vector_type(4)));
typedef unsigned u32x2 __attribute__((ext_vector_type(2)));
typedef __bf16 bf16x2_t __attribute__((ext_vector_type(2)));

__device__ __forceinline__ unsigned pk2(float lo, float hi) { f32x2 v = {lo, hi}; bf16x2_t b = __builtin_convertvector(v, bf16x2_t); return __builtin_bit_cast(unsigned, b); }
__device__ __forceinline__ float bflo(unsigned w) { return __uint_as_float(w << 16); }
__device__ __forceinline__ float bfhi(unsigned w) { return __uint_as_float(w & 0xffff0000u); }
__device__ __forceinline__ float bf2f(bf16 v) { return __uint_as_float(((unsigned)v) << 16); }
__device__ __forceinline__ float sigmoidf_(float x) { return __builtin_amdgcn_rcpf(1.0f + __expf(-x)); }
__device__ __forceinline__ float siluf_(float x) { return x * __builtin_amdgcn_rcpf(1.0f + __expf(-x)); }
__device__ __forceinline__ float wave_sum(float v) {
#pragma unroll
    for (int o = 1; o < 64; o <<= 1) v += __shfl_xor(v, o);
    return v;
}

constexpr int DM = 1024, NBATCH = 2, SEQ = 8192, CTXL = 256, RB = SEQ + CTXL, R = NBATCH * RB;
constexpr int NBLK = RB / 256;
constexpr int LDP = 7424;
constexpr int C_CONV = 0, C_HGQ = 512, C_HGFF = 768, C_HGFB = 1024, C_HGI = 1280, C_HGG = 1536, C_GLQ = 1792, C_GLK = 1920, C_GLV = 2048,
              C_GLAF = 2304, C_GLAB = 2320, C_GLG = 2336, C_ATQ = 2592, C_ATK = 2848, C_ATV = 2976, C_BG = 3104, W_IN_COLS = 7200;
constexpr float EPS = 1e-6f;
constexpr int NEXP = 16, RLCAP = 2 * R;
constexpr int NWAVES = 8, NTHREADS = 512;

constexpr size_t MiB = 1u << 20;
constexpr size_t WS_CTL = 0, CTL_ZERO_BYTES = 1 * MiB;
constexpr size_t WS_MP = 1 * MiB;
constexpr size_t WS_MOD = WS_MP + 1280 * 1024;
constexpr size_t WS_LB = WS_MOD + 256 * 1024;
constexpr size_t WS_ROPE = 3 * MiB;
constexpr size_t WS_RL = 5 * MiB;
constexpr size_t WS_SG = WS_RL + (size_t)NEXP * RLCAP * 4;
constexpr size_t WS_SEGH = 8 * MiB;
constexpr size_t WS_SEGG = WS_SEGH + (size_t)16 * NBLK * 4096 * 4;
constexpr size_t WS_SEGDH = WS_SEGG + (size_t)16 * NBLK * 2048 * 4;
constexpr size_t WS_SEGDG = WS_SEGDH + (size_t)16 * NBLK * 64 * 4;
constexpr size_t WS_WIN = 21 * MiB;
constexpr size_t WS_WBR = 36 * MiB;
constexpr size_t WS_WOUT = 38 * MiB;
constexpr size_t WS_W13 = 40 * MiB;
constexpr size_t WS_W2 = 104 * MiB;
constexpr size_t WS_XL = 136 * MiB;
constexpr size_t WS_H = 202 * MiB;
constexpr size_t WS_Y = 235 * MiB;
constexpr size_t WS_P = 268 * MiB;
constexpr size_t WS_XS = WS_P, WS_ACT = WS_P + 74 * MiB, WS_YS = WS_P + 148 * MiB;
constexpr size_t WS_END = WS_P + (size_t)R * LDP * 2;
static_assert(WS_SEGDG + 16 * NBLK * 32 * 4 <= WS_WIN && WS_END <= 508 * MiB, "ws map");
static_assert((size_t)(2 * R + 16 * 256) * 2048 <= 74 * MiB, "XS fits");
constexpr int CW_BAR = 4096;
constexpr int CW_CNT = 16384;

constexpr int RING_BYTES = 131072;
constexpr int MISC_OFF = RING_BYTES + 320;
constexpr int LDS_BYTES = 147456;

namespace pg8 {
#define PG8_LAS __attribute__((address_space(3)))
typedef unsigned short bf16_t;
constexpr int BM = 256, BK = 64, HALF = 128, HTB = HALF * BK * 2, STAGE_BYTES = 8 * HTB, NXCD = 8, WGM = 8;
__host__ __device__ __forceinline__ int lds_byte(int r, int c) { const int st = (r >> 4) * 2 + (c >> 5), rr = r & 15, cc = c & 31, ob = rr * 64 + cc * 2; return st * 1024 + (ob ^ (((ob >> 9) & 1) << 5)); }
__host__ __device__ __forceinline__ void stage_rc(int b, int& R_, int& C) { const int st = b / 1024, sb = b % 1024, swz = sb ^ (((sb >> 9) & 1) << 5); R_ = (st >> 1) * 16 + swz / 64; C = (st & 1) * 32 + (swz % 64) / 2; }
__host__ __device__ __forceinline__ int perm32(int rho) { const int n = rho >> 4, i = rho & 15; return 8 * (i >> 2) + 4 * n + (i & 3); }

struct Unit { int pm, pn, pb, aux, kofs; };
struct Gemm { const bf16_t* A; const bf16_t* Bt; int lda, ldb, K; };

struct StaticOrder {
    int nM, nN, nwg, G, c;
    __host__ __device__ void init(int M, int N, int G_, int c_) { nM = M / BM; nN = N / BM; nwg = nM * nN; G = G_; c = c_; }
    __host__ __device__ bool next(int i, Unit& u) const {
        const long L = (long)i * G + c; if (L >= nwg) return false;
        int wgid = (int)L; { const int q = nwg / NXCD, r = nwg % NXCD, xcd = wgid % NXCD, off = wgid / NXCD; wgid = (xcd < r ? xcd * (q + 1) : r * (q + 1) + (xcd - r) * q) + off; }
        const int nig = WGM * nN, gid = wgid / nig, fm = gid * WGM, gsz = (nM - fm) < WGM ? (nM - fm) : WGM;
        u.pm = fm + ((wgid % nig) % gsz); u.pn = (wgid % nig) / gsz; u.pb = u.pn; u.aux = 0; u.kofs = 0; return true;
    }
};
struct MoeOrder {
    int bs[NEXP + 1]; int ncol, G, c;
    __device__ __forceinline__ void init(const unsigned* cnt, int ncol_, int G_, int c_) {
        ncol = ncol_; G = G_; c = c_; bs[0] = 0;
#pragma unroll
        for (int e = 0; e < NEXP; ++e) bs[e + 1] = bs[e] + __builtin_amdgcn_readfirstlane((int)((cnt[e * 64] + 255u) >> 8));
    }
    __device__ __forceinline__ bool next(int i, Unit& u) const {
        const long L = (long)i * G + c; if (L >= (long)bs[NEXP] * ncol) return false;
        const int cb = (int)(L / ncol), pn = (int)(L % ncol); int e = 0, jb = 0;
#pragma unroll
        for (int q = 1; q < NEXP; ++q) if (cb >= bs[q]) { e = q; jb = bs[q]; }
        u.pm = cb; u.pn = pn; u.pb = e * ncol + pn; u.aux = (e << 16) | (cb - jb); u.kofs = 0; return true;
    }
};
struct MergeOrder {
    StaticOrder S;
    __device__ __forceinline__ bool next(int i, Unit& u) const { if (!S.next(i >> 2, u)) return false; u.aux = i & 3; u.kofs = 256 * (i & 3); return true; }
};

template <class Epi, class Sched, bool ALIGN_EPI = false, bool SP2 = false>
__device__ __forceinline__ void gemm_phase(PG8_LAS unsigned char* lds, const Gemm g, const Sched& S, const Epi& E, const int tid) {
    const int wid = __builtin_amdgcn_readfirstlane(tid >> 6), lane = tid & 63, wr = wid >> 2, wc = wid & 3, fr = lane & 15, fq = lane >> 4;
    const int K = g.K, nt = K / BK;
    unsigned voffA[2], voffB[2];
#pragma unroll
    for (int i = 0; i < 2; ++i) { int R_, C; stage_rc(tid * 16 + i * 8192, R_, C); const int Rb = Epi::PERM ? ((R_ & ~31) + perm32(R_ & 31)) : R_;
        voffA[i] = (unsigned)(R_ * g.lda + C) * 2u; voffB[i] = (unsigned)(Rb * g.ldb + C) * 2u; }
    const size_t kstep = (size_t)(BK * 2);
    const size_t hstepA = (size_t)HALF * g.lda * 2, hstepB = (size_t)HALF * g.ldb * 2;
    const size_t tstepA = 2 * hstepA, tstepB = 2 * hstepB;
    const unsigned ldsw = (unsigned)wid * 1024u;
    const int aoff = lds_byte(wr * 64 + fr, fq * 8), boff = lds_byte(wc * 32 + fr, fq * 8);
#define PG8_SA(b, h) (((b) * 2 + (h)) * HTB)
#define PG8_SB(b, h) ((4 + (b) * 2 + (h)) * HTB)
#define PG8_STAGE(bufoff, gbase, voff) do { _Pragma("unroll") for (int _i = 0; _i < 2; ++_i) \
        __builtin_amdgcn_global_load_lds((const unsigned*)((const char*)(gbase) + (voff)[_i]), (PG8_LAS unsigned*)(lds + (bufoff) + ldsw + _i * 8192), 16, 0, 0); } while (0)
#define PG8_LDA(dst, b, h) do { _Pragma("unroll") for (int m = 0; m < 4; ++m) _Pragma("unroll") for (int k = 0; k < 2; ++k) dst[m][k] = *(const PG8_LAS bf16x8*)(lds + PG8_SA(b, h) + aoff + m * 2048 + k * 1024); } while (0)
#define PG8_LDB(dst, b, h) do { _Pragma("unroll") for (int n = 0; n < 2; ++n) _Pragma("unroll") for (int k = 0; k < 2; ++k) dst[n][k] = *(const PG8_LAS bf16x8*)(lds + PG8_SB(b, h) + boff + n * 2048 + k * 1024); } while (0)
#define PG8_MMA(ai, bj, At, Bt) do { __builtin_amdgcn_s_setprio(1); _Pragma("unroll") for (int m = 0; m < 4; ++m) _Pragma("unroll") for (int n = 0; n < 2; ++n) _Pragma("unroll") for (int k = 0; k < 2; ++k) \
        acc[ai][bj][m][n] = __builtin_amdgcn_mfma_f32_16x16x32_bf16(Bt[n][k], At[m][k], acc[ai][bj][m][n], 0, 0, 0); __builtin_amdgcn_s_setprio(0); } while (0)
#define PG8_WAIT_V(n) asm volatile("s_waitcnt vmcnt(" #n ")" ::: "memory")
#define PG8_WAIT_L(n) asm volatile("s_waitcnt lgkmcnt(" #n ")" ::: "memory")
#define PG8_BAR __builtin_amdgcn_s_barrier()
#define PG8_SCHED __builtin_amdgcn_sched_barrier(0)
    Unit cur, nxt; int ui = 0;
    if (!S.next(0, cur)) return;
    f32x4 acc[2][2][4][2];
#pragma unroll
    for (int a = 0; a < 2; ++a)
#pragma unroll
        for (int b = 0; b < 2; ++b)
#pragma unroll
            for (int m = 0; m < 4; ++m)
#pragma unroll
                for (int n = 0; n < 2; ++n) acc[a][b][m][n] = (f32x4){0.f, 0.f, 0.f, 0.f};
    bf16x8 At[4][2], B0[2][2], B1[2][2];
    const char* cA = (const char*)g.A + (size_t)cur.pm * tstepA + cur.kofs * 2; const char* cB = (const char*)g.Bt + (size_t)cur.pb * tstepB + cur.kofs * 2;
    if constexpr (SP2) {
        PG8_STAGE(PG8_SB(0, 0), cB, voffB); PG8_STAGE(PG8_SB(0, 1), cB + hstepB, voffB); PG8_STAGE(PG8_SA(0, 0), cA, voffA); PG8_STAGE(PG8_SA(0, 1), cA + hstepA, voffA);
        if (wr == 1) PG8_BAR;
        PG8_WAIT_V(2); PG8_BAR;
        PG8_STAGE(PG8_SB(1, 0), cB + kstep, voffB); PG8_STAGE(PG8_SA(1, 0), cA + kstep, voffA); PG8_STAGE(PG8_SB(1, 1), cB + hstepB + kstep, voffB);
        PG8_WAIT_V(6); PG8_BAR;
    } else {
        PG8_STAGE(PG8_SB(0, 0), cB, voffB); PG8_STAGE(PG8_SA(0, 0), cA, voffA); PG8_STAGE(PG8_SB(0, 1), cB + hstepB, voffB); PG8_STAGE(PG8_SA(0, 1), cA + hstepA, voffA);
        if (wr == 1) PG8_BAR;
        PG8_WAIT_V(4); PG8_BAR;
        PG8_STAGE(PG8_SB(1, 0), cB + kstep, voffB); PG8_STAGE(PG8_SA(1, 0), cA + kstep, voffA); PG8_STAGE(PG8_SB(1, 1), cB + hstepB + kstep, voffB);
        PG8_WAIT_V(6); PG8_BAR;
    }
    for (;;) {
        const bool has_next = S.next(ui + 1, nxt);
        const char* nA = has_next ? (const char*)g.A + (size_t)nxt.pm * tstepA + nxt.kofs * 2 : cA; const char* nB = has_next ? (const char*)g.Bt + (size_t)nxt.pb * tstepB + nxt.kofs * 2 : cB;
        for (int t = 0; t < nt; t += 2) {
            const bool last = (t == nt - 2);
            const char* a1 = cA + (size_t)(t + 1) * kstep;
            const char* a2 = last ? nA : cA + (size_t)(t + 2) * kstep; const char* b2 = last ? nB : cB + (size_t)(t + 2) * kstep;
            const char* a3 = a2 + kstep; const char* b3 = b2 + kstep;
            if constexpr (SP2) {
            PG8_LDB(B0, 0, 0); PG8_LDB(B1, 0, 1); PG8_SCHED; PG8_LDA(At, 0, 0); PG8_STAGE(PG8_SA(1, 1), a1 + hstepA, voffA);
            PG8_WAIT_V(8); PG8_WAIT_L(0); PG8_BAR; PG8_MMA(0, 0, At, B0); PG8_MMA(0, 1, At, B1); PG8_BAR; PG8_SCHED;
            PG8_LDA(At, 0, 1); PG8_STAGE(PG8_SB(0, 0), b2, voffB); PG8_STAGE(PG8_SB(0, 1), b2 + hstepB, voffB); PG8_STAGE(PG8_SA(0, 0), a2, voffA);
            PG8_WAIT_V(8); PG8_WAIT_L(0); PG8_BAR; PG8_MMA(1, 0, At, B0); PG8_MMA(1, 1, At, B1); PG8_BAR; PG8_SCHED;
            PG8_LDB(B0, 1, 0); PG8_LDB(B1, 1, 1); PG8_SCHED; PG8_LDA(At, 1, 0); PG8_STAGE(PG8_SA(0, 1), a2 + hstepA, voffA);
            PG8_WAIT_V(8); PG8_WAIT_L(0); PG8_BAR; PG8_MMA(0, 0, At, B0); PG8_MMA(0, 1, At, B1); PG8_BAR; PG8_SCHED;
            PG8_LDA(At, 1, 1); PG8_STAGE(PG8_SB(1, 0), b3, voffB); PG8_STAGE(PG8_SB(1, 1), b3 + hstepB, voffB); PG8_STAGE(PG8_SA(1, 0), a3, voffA);
            PG8_WAIT_V(8); PG8_WAIT_L(0); PG8_BAR; PG8_MMA(1, 0, At, B0); PG8_MMA(1, 1, At, B1); PG8_BAR; PG8_SCHED;
            } else {
            PG8_LDB(B0, 0, 0); PG8_SCHED; PG8_LDA(At, 0, 0); PG8_STAGE(PG8_SA(1, 1), a1 + hstepA, voffA);
            PG8_WAIT_L(8); PG8_BAR; PG8_WAIT_L(0); PG8_MMA(0, 0, At, B0); PG8_BAR; PG8_SCHED;
            PG8_LDB(B1, 0, 1); PG8_STAGE(PG8_SB(0, 0), b2, voffB);
            PG8_BAR; PG8_WAIT_L(0); PG8_MMA(0, 1, At, B1); PG8_BAR;
            PG8_LDA(At, 0, 1); PG8_STAGE(PG8_SA(0, 0), a2, voffA);
            PG8_BAR; PG8_WAIT_L(0); PG8_MMA(1, 0, At, B0); PG8_BAR; PG8_SCHED;
            PG8_STAGE(PG8_SB(0, 1), b2 + hstepB, voffB);
            PG8_WAIT_V(6); PG8_BAR; PG8_MMA(1, 1, At, B1); PG8_BAR;
            PG8_LDB(B0, 1, 0); PG8_SCHED; PG8_LDA(At, 1, 0); PG8_STAGE(PG8_SA(0, 1), a2 + hstepA, voffA);
            PG8_WAIT_L(8); PG8_BAR; PG8_WAIT_L(0); PG8_MMA(0, 0, At, B0); PG8_BAR; PG8_SCHED;
            PG8_LDB(B1, 1, 1); PG8_STAGE(PG8_SB(1, 0), b3, voffB);
            PG8_BAR; PG8_WAIT_L(0); PG8_MMA(0, 1, At, B1); PG8_BAR;
            PG8_LDA(At, 1, 1); PG8_STAGE(PG8_SA(1, 0), a3, voffA);
            PG8_BAR; PG8_WAIT_L(0); PG8_MMA(1, 0, At, B0); PG8_BAR; PG8_SCHED;
            PG8_STAGE(PG8_SB(1, 1), b3 + hstepB, voffB);
            PG8_WAIT_V(6); PG8_BAR; PG8_MMA(1, 1, At, B1); PG8_BAR;
            }
        }
        if constexpr (ALIGN_EPI) { if (wr == 0) PG8_BAR; }
        E(acc, cur, wr, wc, fr, fq);
        if (!has_next) break;
#pragma unroll
        for (int a = 0; a < 2; ++a)
#pragma unroll
            for (int b = 0; b < 2; ++b)
#pragma unroll
                for (int m = 0; m < 4; ++m)
#pragma unroll
                    for (int n = 0; n < 2; ++n) acc[a][b][m][n] = (f32x4){0.f, 0.f, 0.f, 0.f};
        cur = nxt; cA = nA; cB = nB; ++ui;
        if constexpr (ALIGN_EPI) { if (wr == 1) PG8_BAR; }
    }
    PG8_WAIT_V(0);
    if constexpr (!ALIGN_EPI) { if (wr == 0) PG8_BAR; }
    PG8_BAR;
#undef PG8_SA
#undef PG8_SB
#undef PG8_STAGE
#undef PG8_LDA
#undef PG8_LDB
#undef PG8_MMA
#undef PG8_WAIT_V
#undef PG8_WAIT_L
#undef PG8_BAR
#undef PG8_SCHED
}

struct EpiStoreBf16 {
    static constexpr bool PERM = true;
    bf16_t* O; int ldc;
    __device__ __forceinline__ void operator()(const f32x4 (&acc)[2][2][4][2], const Unit& u, int wr, int wc, int fr, int fq) const {
        const int row0 = u.pm * BM + wr * 64 + fr, col0 = u.pn * BM + wc * 32 + 8 * fq;
#pragma unroll
        for (int ai = 0; ai < 2; ++ai)
#pragma unroll
            for (int m = 0; m < 4; ++m) { bf16_t* rowp = O + (size_t)(row0 + ai * HALF + m * 16) * ldc + col0;
#pragma unroll
                for (int bj = 0; bj < 2; ++bj) { const f32x4 v0 = acc[ai][bj][m][0], v1 = acc[ai][bj][m][1];
                    u32x4 w; w.x = pk2(v0[0], v0[1]); w.y = pk2(v0[2], v0[3]); w.z = pk2(v1[0], v1[1]); w.w = pk2(v1[2], v1[3]);
                    *(u32x4*)(rowp + bj * HALF) = w; } }
    }
};
struct EpiMerge {
    static constexpr bool PERM = true;
    const bf16_t* P; bf16_t* MG;
    __device__ __forceinline__ void operator()(const f32x4 (&acc)[2][2][4][2], const Unit& u, int wr, int wc, int fr, int fq) const {
        const int row0 = u.pm * BM + wr * 64 + fr, col0 = u.pn * BM + wc * 32 + 8 * fq; const int br = u.aux;
        const bf16_t* gp = P + C_BG + br * 1024 + col0;
#pragma unroll
        for (int ai = 0; ai < 2; ++ai)
#pragma unroll
            for (int m = 0; m < 4; ++m) { const int row = row0 + ai * HALF + m * 16;
#pragma unroll
                for (int bj = 0; bj < 2; ++bj) { const int col = col0 + bj * HALF;
                    const u32x4 gw = *(const u32x4*)(gp + (size_t)row * LDP + bj * HALF);
                    u32x4 ow = {0u, 0u, 0u, 0u}; if (br > 0) ow = *(const u32x4*)(MG + (size_t)row * DM + col);
                    const f32x4 v0 = acc[ai][bj][m][0], v1 = acc[ai][bj][m][1];
                    u32x4 w;
                    w.x = pk2(bflo(ow.x) + sigmoidf_(bflo(gw.x)) * v0[0], bfhi(ow.x) + sigmoidf_(bfhi(gw.x)) * v0[1]);
                    w.y = pk2(bflo(ow.y) + sigmoidf_(bflo(gw.y)) * v0[2], bfhi(ow.y) + sigmoidf_(bfhi(gw.y)) * v0[3]);
                    w.z = pk2(bflo(ow.z) + sigmoidf_(bflo(gw.z)) * v1[0], bfhi(ow.z) + sigmoidf_(bfhi(gw.z)) * v1[1]);
                    w.w = pk2(bflo(ow.w) + sigmoidf_(bflo(gw.w)) * v1[2], bfhi(ow.w) + sigmoidf_(bfhi(gw.w)) * v1[3]);
                    *(u32x4*)(MG + (size_t)row * DM + col) = w; }
                asm volatile("" ::: "memory"); }
    }
};
struct EpiOut {
    static constexpr bool PERM = false;
    float* XL; const float* MODL;
    __device__ __forceinline__ void operator()(const f32x4 (&acc)[2][2][4][2], const Unit& u, int wr, int wc, int fr, int fq) const {
        const int row0 = u.pm * BM + wr * 64 + fr, col0 = u.pn * BM + wc * 32 + 4 * fq;
        const int cond = (u.pm % NBLK == 0) ? 2 : (u.pm / NBLK);
        const float* gp = MODL + (cond * 6 + 2) * DM + col0;
        f32x4 gv[2][2];
#pragma unroll
        for (int bj = 0; bj < 2; ++bj)
#pragma unroll
            for (int n = 0; n < 2; ++n) gv[bj][n] = *(const f32x4*)(gp + bj * HALF + n * 16);
#pragma unroll
        for (int ai = 0; ai < 2; ++ai)
#pragma unroll
            for (int m = 0; m < 4; ++m) { float* rowp = XL + (size_t)(row0 + ai * HALF + m * 16) * DM + col0;
#pragma unroll
                for (int bj = 0; bj < 2; ++bj)
#pragma unroll
                    for (int n = 0; n < 2; ++n) { const f32x4 x = *(const f32x4*)(rowp + bj * HALF + n * 16); *(f32x4*)(rowp + bj * HALF + n * 16) = x + gv[bj][n] * acc[ai][bj][m][n]; } }
    }
};
struct EpiMoe1 {
    static constexpr bool PERM = true;
    bf16_t* ACT;
    __device__ __forceinline__ void operator()(const f32x4 (&acc)[2][2][4][2], const Unit& u, int wr, int wc, int fr, int fq) const {
        const int row0 = u.pm * BM + wr * 64 + fr, col0 = u.pn * HALF + wc * 32 + 8 * fq;
#pragma unroll
        for (int ai = 0; ai < 2; ++ai)
#pragma unroll
            for (int m = 0; m < 4; ++m) { bf16_t* rowp = ACT + (size_t)(row0 + ai * HALF + m * 16) * DM + col0;
                const f32x4 a0 = acc[ai][0][m][0], a1 = acc[ai][0][m][1], b0 = acc[ai][1][m][0], b1 = acc[ai][1][m][1];
                u32x4 w; w.x = pk2(siluf_(a0[0]) * b0[0], siluf_(a0[1]) * b0[1]); w.y = pk2(siluf_(a0[2]) * b0[2], siluf_(a0[3]) * b0[3]);
                w.z = pk2(siluf_(a1[0]) * b1[0], siluf_(a1[1]) * b1[1]); w.w = pk2(siluf_(a1[2]) * b1[2], siluf_(a1[3]) * b1[3]);
                *(u32x4*)rowp = w; }
    }
};
struct EpiMoe2 {
    static constexpr bool PERM = true;
    bf16_t* YS; const int* RL; const unsigned* cnt;
    __device__ __forceinline__ void operator()(const f32x4 (&acc)[2][2][4][2], const Unit& u, int wr, int wc, int fr, int fq) const {
        const int e = u.aux >> 16, jb = u.aux & 0xffff; const int n_e = __builtin_amdgcn_readfirstlane((int)cnt[e * 64]);
        const int col0 = u.pn * BM + wc * 32 + 8 * fq;
#pragma unroll
        for (int ai = 0; ai < 2; ++ai)
#pragma unroll
            for (int m = 0; m < 4; ++m) { const int rank = jb * BM + ai * HALF + wr * 64 + m * 16 + fr;
                if (rank < n_e) { const int slot = RL[(size_t)e * RLCAP + rank]; bf16_t* rowp = YS + (size_t)slot * DM + col0;
#pragma unroll
                    for (int bj = 0; bj < 2; ++bj) { const f32x4 v0 = acc[ai][bj][m][0], v1 = acc[ai][bj][m][1];
                        u32x4 w; w.x = pk2(v0[0], v0[1]); w.y = pk2(v0[2], v0[3]); w.z = pk2(v1[0], v1[1]); w.w = pk2(v1[2], v1[3]);
                        *(u32x4*)(rowp + bj * HALF) = w; } } }
    }
};
}

#define XB_TMO      128
#define XB_XCNT(j)  (256  + 64 * (j))
#define XB_XSUB(j)  (1280 + 64 * (j))
#define XB_XGEN(j)  (2304 + 64 * (j))
#define XB_TOP      3328
#define XB_TOPGEN   3392
#define XCD_BAR_WORDS 3456
#define XB_SPIN_CAP (1u << 18)
__device__ __forceinline__ unsigned xb_ld(unsigned* p)              { return __hip_atomic_load(p, __ATOMIC_RELAXED, __HIP_MEMORY_SCOPE_AGENT); }
__device__ __forceinline__ unsigned xb_add(unsigned* p, unsigned v) { return __hip_atomic_fetch_add(p, v, __ATOMIC_RELAXED, __HIP_MEMORY_SCOPE_AGENT); }
__device__ __forceinline__ unsigned xb_xcc_id() { return (unsigned)__builtin_amdgcn_s_getreg((3 << 11) | 20) & 0xFu; }
#define XB_SPIN(cond, bar) do { unsigned _sp = 0; while (cond) { __builtin_amdgcn_s_sleep(1); \
    if ((++_sp & 255u) == 0u) { if (xb_ld(&(bar)[XB_TMO])) break; if (_sp > XB_SPIN_CAP) { atomicAdd(&(bar)[XB_TMO], 1u); break; } } } } while (0)
struct XcdBarrier { unsigned* bar; unsigned x; volatile LAS unsigned* st; };
__device__ __forceinline__ XcdBarrier xcd_barrier_post(unsigned* bar, volatile LAS unsigned* st) {
    XcdBarrier b; b.bar = bar; b.x = xb_xcc_id(); b.st = st;
    if (threadIdx.x == 0) (void)xb_add(&bar[XB_XCNT(b.x)], 1u);
    return b;
}
__device__ __forceinline__ void xcd_barrier_complete(unsigned* bar, unsigned x, unsigned& nloc, unsigned& nx) {
    const unsigned G = gridDim.x * gridDim.y * gridDim.z;
    unsigned sum, cnt, mine, sp = 0u;
    for (;;) {
        sum = 0u; cnt = 0u; mine = 0u;
#pragma unroll
        for (unsigned j = 0; j < 16; ++j) { const unsigned c = xb_ld(&bar[XB_XCNT(j)]); sum += c; cnt += (c > 0u) ? 1u : 0u; mine = (j == x) ? c : mine; }
        if (sum == G) break;
        __builtin_amdgcn_s_sleep(1);
        if ((++sp & 255u) == 0u) { if (xb_ld(&bar[XB_TMO])) break; if (sp > XB_SPIN_CAP) { atomicAdd(&bar[XB_TMO], 1u); break; } }
    }
    nloc = mine > 0u ? mine : 1u; nx = cnt > 0u ? cnt : 1u;
}
__device__ __forceinline__ void xcd_barrier(const XcdBarrier& b) {
    asm volatile("s_waitcnt vmcnt(0)" ::: "memory");
    __syncthreads();
    if (threadIdx.x == 0) {
        unsigned* bar = b.bar;
        __builtin_amdgcn_s_waitcnt(0);
        unsigned nloc = b.st[0], nx = b.st[1];
        if (nloc == 0u) { xcd_barrier_complete(bar, b.x, nloc, nx); b.st[0] = nloc; b.st[1] = nx; }
        const unsigned old = xb_add(&bar[XB_XSUB(b.x)], 1u);
        const unsigned gen = old / nloc;
        if (old + 1u == (gen + 1u) * nloc) {
            __builtin_amdgcn_fence(__ATOMIC_RELEASE, "agent");
            asm volatile("s_waitcnt vmcnt(0)" ::: "memory");
            const unsigned og = xb_add(&bar[XB_TOP], 1u);
            const unsigned tg = og / nx;
            if (og + 1u == (tg + 1u) * nx) xb_add(&bar[XB_TOPGEN], 1u);
            else XB_SPIN(xb_ld(&bar[XB_TOPGEN]) == tg, bar);
            __builtin_amdgcn_fence(__ATOMIC_ACQUIRE, "agent");
            xb_add(&bar[XB_XGEN(b.x)], 1u);
            asm volatile("s_waitcnt vmcnt(0)" ::: "memory");
        } else {
            XB_SPIN(xb_ld(&bar[XB_XGEN(b.x)]) == gen, bar);
            __builtin_amdgcn_fence(__ATOMIC_ACQUIRE, "agent");
            asm volatile("s_waitcnt vmcnt(0)" ::: "memory");
        }
    }
    __syncthreads();
}

struct Args { const float* in[30]; float* out; unsigned char* ws; int ph_lo, ph_hi; };
typedef const __attribute__((address_space(4))) Args* ArgP;
enum { I_X = 0, I_C, I_CTX, I_CCTX, I_LBLOG, I_RW, I_RB, I_FINALG, I_WMOD, I_BMOD, I_GMIX, I_GFFN, I_WIN, I_CONVW, I_CONVB, I_CLNG, I_CLNB, I_HGNG,
       I_GLW2, I_GLB2, I_GLNG, I_SINK, I_WBRC, I_WBRH, I_WBRG, I_WBRA, I_WOUT, I_W1, I_W3, I_W2 };

__device__ __forceinline__ int row_cond(int row) { const int b = row / RB, j = row - b * RB; return j < CTXL ? 2 : b; }

__device__ __forceinline__ void transpose_item(const float* W, int N, bf16* WT, int ldt, int koff, int mode, LAS float* scr, int kb, int nb, int lane) {
    const int k0 = 64 * kb, n0 = 32 * nb;
#pragma unroll 8
    for (int i = 0; i < 32; ++i) { const int kk = 2 * i + (lane >> 5); scr[kk * 33 + (lane & 31)] = W[(size_t)(k0 + kk) * N + n0 + (lane & 31)]; }
    asm volatile("s_waitcnt lgkmcnt(0)" ::: "memory");
    const int c = lane & 7;
    const int nd0 = (mode == 0) ? n0 : ((n0 >> 7) * 256 + (mode == 2 ? 128 : 0) + (n0 & 127));
#pragma unroll
    for (int j = 0; j < 4; ++j) { const int n = (lane >> 3) + 8 * j; const LAS float* s = scr + (8 * c) * 33 + n;
        u32x4 o; o.x = pk2(s[0 * 33], s[1 * 33]); o.y = pk2(s[2 * 33], s[3 * 33]); o.z = pk2(s[4 * 33], s[5 * 33]); o.w = pk2(s[6 * 33], s[7 * 33]);
        *(u32x4*)(WT + (size_t)(nd0 + n) * ldt + koff + k0 + 8 * c) = o; }
    asm volatile("s_waitcnt lgkmcnt(0)" ::: "memory");
}
__device__ __forceinline__ void convert_weights(ArgP ap, int l, LAS unsigned char* lds, int gw, int NGW, int wave, int lane) {
    LAS float* scr = (LAS float*)(lds + wave * 16384);
    unsigned char* ws = ap->ws;
    bf16* WIN = (bf16*)(ws + WS_WIN); bf16* WBR = (bf16*)(ws + WS_WBR); bf16* WOUT = (bf16*)(ws + WS_WOUT); bf16* W13 = (bf16*)(ws + WS_W13); bf16* W2 = (bf16*)(ws + WS_W2);
    constexpr int I_IN = 16 * 225, I_BR = 4 * 32, I_O = 16 * 32, I_E = 16 * 32;
    constexpr int NITEMS = I_IN + 4 * I_BR + I_O + 48 * I_E;
    for (int it = gw; it < NITEMS; it += NGW) {
        int r = it;
        if (r < I_IN) { transpose_item(ap->in[I_WIN] + (size_t)l * DM * W_IN_COLS, W_IN_COLS, WIN, DM, 0, 0, scr, r / 225, r % 225, lane); continue; } r -= I_IN;
        if (r < 4 * I_BR) { const int br = r / I_BR, q = r % I_BR; transpose_item(ap->in[I_WBRC + br] + (size_t)l * 256 * DM, DM, WBR, DM, 256 * br, 0, scr, q / 32, q % 32, lane); continue; } r -= 4 * I_BR;
        if (r < I_O) { transpose_item(ap->in[I_WOUT] + (size_t)l * DM * DM, DM, WOUT, DM, 0, 0, scr, r / 32, r % 32, lane); continue; } r -= I_O;
        const int mat = r / I_E, q = r % I_E;
        const int e = mat / 3, wh = mat % 3;
        const size_t eoff = ((size_t)l * NEXP + e) * DM * DM;
        if (wh == 0) transpose_item(ap->in[I_W1] + eoff, DM, W13 + (size_t)e * 2048 * DM, DM, 0, 1, scr, q / 32, q % 32, lane);
        else if (wh == 1) transpose_item(ap->in[I_W3] + eoff, DM, W13 + (size_t)e * 2048 * DM, DM, 0, 2, scr, q / 32, q % 32, lane);
        else transpose_item(ap->in[I_W2] + eoff, DM, W2 + (size_t)e * DM * DM, DM, 0, 0, scr, q / 32, q % 32, lane);
    }
    for (int rr = gw; rr < LDP - W_IN_COLS; rr += NGW) { u32x4* p = (u32x4*)(WIN + (size_t)(W_IN_COLS + rr) * DM);
        p[lane] = (u32x4){0u, 0u, 0u, 0u}; p[lane + 64] = (u32x4){0u, 0u, 0u, 0u}; }
}

__device__ __forceinline__ void modnorm_store(const f32x4 (&v)[4], const float* g, const float* shift, const float* scale, bf16* orow, int lane) {
    float ss = 0.f;
#pragma unroll
    for (int j = 0; j < 4; ++j) ss += (v[j].x * v[j].x + v[j].y * v[j].y) + (v[j].z * v[j].z + v[j].w * v[j].w);
    const float rstd = rsqrtf(wave_sum(ss) * (1.f / DM) + EPS);
#pragma unroll
    for (int j = 0; j < 4; ++j) { const int c = 4 * lane + 256 * j;
        const f32x4 gg = *(const f32x4*)(g + c), sh = *(const f32x4*)(shift + c), sc = *(const f32x4*)(scale + c);
        const f32x4 y = (v[j] * rstd) * gg * (sc + 1.0f) + sh;
        u32x2 w; w.x = pk2(y.x, y.y); w.y = pk2(y.z, y.w); *(u32x2*)(orow + c) = w; }
}

__device__ __forceinline__ void attn_unit(const bf16* P, bf16* Y, const float* COS, const float* SIN, const float* sinkp, int b, int kvh, int qblk, bool ctxq, LAS unsigned char* lds, int tid, int wave, int lane) {
    LAS bf16* KS = (LAS bf16*)lds;
    LAS bf16* VT = (LAS bf16*)(lds + 64 * 72 * 2);
    const int fr = lane & 15, fq = lane >> 4;
    const int hq = kvh * 2 + (wave >> 2);
    const int t0 = qblk * 128, tq0 = t0 + (wave & 3) * 32;
    const size_t rowbase = (size_t)b * RB + (ctxq ? 0 : CTXL);
    bf16x8 qf[2][2];
#pragma unroll
    for (int qt = 0; qt < 2; ++qt)
#pragma unroll
        for (int ks = 0; ks < 2; ++ks) {
            const int tq = tq0 + 16 * qt + fr, dch = 4 * ks + fq;
            const bf16* qp = P + (rowbase + tq) * LDP + C_ATQ + hq * 64;
            const u32x4 own = *(const u32x4*)(qp + 8 * dch), oth = *(const u32x4*)(qp + 8 * (dch ^ 2));
            float o[8], p[8], r[8];
            o[0] = bflo(own.x); o[1] = bfhi(own.x); o[2] = bflo(own.y); o[3] = bfhi(own.y); o[4] = bflo(own.z); o[5] = bfhi(own.z); o[6] = bflo(own.w); o[7] = bfhi(own.w);
            p[0] = bflo(oth.x); p[1] = bfhi(oth.x); p[2] = bflo(oth.y); p[3] = bfhi(oth.y); p[4] = bflo(oth.z); p[5] = bfhi(oth.z); p[6] = bflo(oth.w); p[7] = bfhi(oth.w);
            if (!ctxq) {
                const int ci = tq * 32 + (dch >> 2) * 16 + (dch & 1) * 8;
#pragma unroll
                for (int j = 0; j < 8; ++j) { const float c = COS[ci + j], s = SIN[ci + j]; r[j] = (dch & 2) ? (p[j] * s + o[j] * c) : (o[j] * c - p[j] * s); }
            } else {
#pragma unroll
                for (int j = 0; j < 8; ++j) r[j] = o[j];
            }
            u32x4 w; w.x = pk2(r[0] * 0.125f, r[1] * 0.125f); w.y = pk2(r[2] * 0.125f, r[3] * 0.125f); w.z = pk2(r[4] * 0.125f, r[5] * 0.125f); w.w = pk2(r[6] * 0.125f, r[7] * 0.125f);
            qf[qt][ks] = __builtin_bit_cast(bf16x8, w);
        }
    f32x4 ot[4][2];
#pragma unroll
    for (int dt = 0; dt < 4; ++dt)
#pragma unroll
        for (int qt = 0; qt < 2; ++qt) ot[dt][qt] = (f32x4){0.f, 0.f, 0.f, 0.f};
    float mrun[2] = {-1e30f, -1e30f}, lrun[2] = {0.f, 0.f};
    const int ntile = ctxq ? 4 : 10;
    for (int ti = 0; ti < ntile; ++ti) {
        const bool band = (!ctxq) && ti < 6;
        const int s0 = band ? (t0 - 128 + 64 * ti) : 64 * (ctxq ? ti : ti - 6);
        if (band && (s0 < 0 || s0 >= SEQ)) continue;
        __syncthreads();
        {
            const int key = tid >> 3, dch = tid & 7;
            const bf16* kp = P + ((size_t)b * RB + (band ? CTXL : 0) + s0 + key) * LDP;
            const u32x4 own = *(const u32x4*)(kp + C_ATK + kvh * 64 + 8 * dch);
            u32x4 kw = own;
            if (band) {
                const u32x4 oth = *(const u32x4*)(kp + C_ATK + kvh * 64 + 8 * (dch ^ 2));
                float o[8], p[8], r[8];
                o[0] = bflo(own.x); o[1] = bfhi(own.x); o[2] = bflo(own.y); o[3] = bfhi(own.y); o[4] = bflo(own.z); o[5] = bfhi(own.z); o[6] = bflo(own.w); o[7] = bfhi(own.w);
                p[0] = bflo(oth.x); p[1] = bfhi(oth.x); p[2] = bflo(oth.y); p[3] = bfhi(oth.y); p[4] = bflo(oth.z); p[5] = bfhi(oth.z); p[6] = bflo(oth.w); p[7] = bfhi(oth.w);
                const int ci = (s0 + key) * 32 + (dch >> 2) * 16 + (dch & 1) * 8;
#pragma unroll
                for (int j = 0; j < 8; ++j) { const float c = COS[ci + j], s = SIN[ci + j]; r[j] = (dch & 2) ? (p[j] * s + o[j] * c) : (o[j] * c - p[j] * s); }
                kw.x = pk2(r[0], r[1]); kw.y = pk2(r[2], r[3]); kw.z = pk2(r[4], r[5]); kw.w = pk2(r[6], r[7]);
            }
            *(LAS u32x4*)(KS + key * 72 + 8 * dch) = kw;
            const u32x4 vw = *(const u32x4*)(kp + C_ATV + kvh * 64 + 8 * dch);
            LAS bf16* vp = VT + (8 * dch) * 72 + key;
            vp[0 * 72] = (bf16)(vw.x & 0xffffu); vp[1 * 72] = (bf16)(vw.x >> 16); vp[2 * 72] = (bf16)(vw.y & 0xffffu); vp[3 * 72] = (bf16)(vw.y >> 16);
            vp[4 * 72] = (bf16)(vw.z & 0xffffu); vp[5 * 72] = (bf16)(vw.z >> 16); vp[6 * 72] = (bf16)(vw.w & 0xffffu); vp[7 * 72] = (bf16)(vw.w >> 16);
        }
        __syncthreads();
        f32x4 st[4][2];
#pragma unroll
        for (int kt = 0; kt < 4; ++kt) {
            const bf16x8 ka0 = *(const LAS bf16x8*)(KS + (16 * kt + fr) * 72 + 8 * fq), ka1 = *(const LAS bf16x8*)(KS + (16 * kt + fr) * 72 + 32 + 8 * fq);
#pragma unroll
            for (int qt = 0; qt < 2; ++qt) { f32x4 c = (f32x4){0.f, 0.f, 0.f, 0.f};
                c = __builtin_amdgcn_mfma_f32_16x16x32_bf16(ka0, qf[qt][0], c, 0, 0, 0);
                c = __builtin_amdgcn_mfma_f32_16x16x32_bf16(ka1, qf[qt][1], c, 0, 0, 0);
                st[kt][qt] = c; }
        }
#pragma unroll
        for (int qt = 0; qt < 2; ++qt) {
            const int tq = tq0 + 16 * qt + fr;
            float mx = -1e30f;
#pragma unroll
            for (int kt = 0; kt < 4; ++kt)
#pragma unroll
                for (int j = 0; j < 4; ++j) { const int s = s0 + 16 * kt + 4 * fq + j; const int dd = tq - s; const bool ok = (!band) || (dd <= 128 && dd >= -128);
                    st[kt][qt][j] = ok ? st[kt][qt][j] : -1e30f; mx = fmaxf(mx, st[kt][qt][j]); }
            mx = fmaxf(mx, __shfl_xor(mx, 16)); mx = fmaxf(mx, __shfl_xor(mx, 32));
            const float mnew = fmaxf(mrun[qt], mx), alpha = __expf(mrun[qt] - mnew);
            mrun[qt] = mnew;
            float ps = 0.f;
#pragma unroll
            for (int kt = 0; kt < 4; ++kt)
#pragma unroll
                for (int j = 0; j < 4; ++j) { const float sv = st[kt][qt][j]; const float pv = (sv > -1e29f) ? __expf(sv - mnew) : 0.f; st[kt][qt][j] = pv; ps += pv; }
            lrun[qt] = lrun[qt] * alpha + ps;
#pragma unroll
            for (int dt = 0; dt < 4; ++dt) ot[dt][qt] = ot[dt][qt] * alpha;
        }
#pragma unroll
        for (int kk = 0; kk < 2; ++kk) {
            bf16x8 pb[2];
#pragma unroll
            for (int qt = 0; qt < 2; ++qt) { u32x4 w; w.x = pk2(st[2 * kk][qt][0], st[2 * kk][qt][1]); w.y = pk2(st[2 * kk][qt][2], st[2 * kk][qt][3]);
                w.z = pk2(st[2 * kk + 1][qt][0], st[2 * kk + 1][qt][1]); w.w = pk2(st[2 * kk + 1][qt][2], st[2 * kk + 1][qt][3]); pb[qt] = __builtin_bit_cast(bf16x8, w); }
#pragma unroll
            for (int dt = 0; dt < 4; ++dt) {
                const u32x2 v0 = *(const LAS u32x2*)(VT + (16 * dt + fr) * 72 + 32 * kk + 4 * fq), v1 = *(const LAS u32x2*)(VT + (16 * dt + fr) * 72 + 32 * kk + 16 + 4 * fq);
                u32x4 vw; vw.x = v0.x; vw.y = v0.y; vw.z = v1.x; vw.w = v1.y; const bf16x8 va = __builtin_bit_cast(bf16x8, vw);
#pragma unroll
                for (int qt = 0; qt < 2; ++qt) ot[dt][qt] = __builtin_amdgcn_mfma_f32_16x16x32_bf16(va, pb[qt], ot[dt][qt], 0, 0, 0);
            }
        }
    }
    const float sk = sinkp[hq];
#pragma unroll
    for (int qt = 0; qt < 2; ++qt) {
        float l = lrun[qt]; l += __shfl_xor(l, 16); l += __shfl_xor(l, 32);
        const float mf = fmaxf(mrun[qt], sk); const float a = __expf(mrun[qt] - mf); const float denom = l * a + __expf(sk - mf); const float sc = a / denom;
        const int tq = tq0 + 16 * qt + fr;
        bf16* yp = Y + (rowbase + tq) * DM + 768 + hq * 64 + 4 * fq;
#pragma unroll
        for (int dt = 0; dt < 4; ++dt) { const f32x4 o = ot[dt][qt] * sc; u32x2 w; w.x = pk2(o.x, o.y); w.y = pk2(o.z, o.w); *(u32x2*)(yp + 16 * dt) = w; }
    }
}

__device__ __forceinline__ void conv_unit(const bf16* P, bf16* Y, const float* cw, const float* cb, const float* lng, const float* lnb, int cu, LAS unsigned char* lds, int tid, int wave, int lane) {
    LAS float* Z = (LAS float*)lds;
    LAS float* CO = (LAS float*)(lds + 62 * 256 * 4);
    const int row0 = cu * 32; const int b = row0 / RB, j0 = row0 - b * RB;
    const int seg0 = b * RB + (j0 < CTXL ? 0 : CTXL), seg1 = b * RB + (j0 < CTXL ? CTXL : RB);
    __syncthreads();
    for (int idx = tid; idx < 62 * 256; idx += NTHREADS) { const int tt = idx >> 8, c = idx & 255; const int row = row0 - 15 + tt; float z = 0.f;
        if (row >= seg0 && row < seg1) { const float av = bf2f(P[(size_t)row * LDP + C_CONV + c]), bv = bf2f(P[(size_t)row * LDP + C_CONV + 256 + c]); z = av * sigmoidf_(bv); }
        Z[idx] = z; }
    __syncthreads();
    { const int c = tid & 255, hf = tid >> 8; float w[31];
#pragma unroll
      for (int j = 0; j < 31; ++j) w[j] = cw[j * 256 + c];
      const float bias = cb[c];
#pragma unroll 1
      for (int t = hf * 16; t < hf * 16 + 16; ++t) { float s = bias;
#pragma unroll
          for (int j = 0; j < 31; ++j) s += Z[(t + j) * 256 + c] * w[j];
          CO[t * 256 + c] = s; } }
    __syncthreads();
#pragma unroll
    for (int q = 0; q < 4; ++q) { const int t = wave * 4 + q; const f32x4 x = *(const LAS f32x4*)(CO + t * 256 + 4 * lane);
        const float mu = wave_sum((x.x + x.y) + (x.z + x.w)) * (1.f / 256.f); const f32x4 d = x - mu;
        const float var = wave_sum((d.x * d.x + d.y * d.y) + (d.z * d.z + d.w * d.w)) * (1.f / 256.f); const float rstd = rsqrtf(var + EPS);
        const f32x4 g = *(const f32x4*)(lng + 4 * lane), bb = *(const f32x4*)(lnb + 4 * lane); const f32x4 zn = d * rstd * g + bb;
        u32x2 w; w.x = pk2(siluf_(zn.x), siluf_(zn.y)); w.y = pk2(siluf_(zn.z), siluf_(zn.w));
        *(u32x2*)(Y + (size_t)(row0 + t) * DM + 4 * lane) = w; }
}

template <int DK, bool HG>
__device__ __forceinline__ void scan_unit(ArgP ap, int l, int passB, int b, int h, int blk, LAS unsigned char* lds, int tid, int wave, int lane) {
    constexpr int KPT = DK / 8;
    unsigned char* ws = ap->ws;
    const bf16* P = (const bf16*)(ws + WS_P); bf16* Y = (bf16*)(ws + WS_Y);
    float* SEGS = (float*)(ws + (HG ? WS_SEGH : WS_SEGG)); float* SEGD = (float*)(ws + (HG ? WS_SEGDH : WS_SEGDG));
    const float* LB = (const float*)(ws + WS_LB) + l * 512;
    LAS float* Lq = (LAS float*)lds; LAS float* Ld = Lq + 16 * 64; LAS float* Lk = Ld + 16 * 64; LAS float* Lv = Lk + 16 * 64;
    LAS float* PO = Lv + 16 * 64;
    LAS float* OS = PO + 8 * 16 * 64;
    const int v = lane, kg = wave;
    const size_t row0 = (size_t)b * RB + blk * 256;
    for (int dir = 0; dir < 2; ++dir) {
        const int ch = (b * 2 + dir) * 4 + h;
        float S[KPT], Dk[KPT];
#pragma unroll
        for (int j = 0; j < KPT; ++j) { S[j] = 0.f; Dk[j] = 1.f; }
        if (passB) {
            const int npre = (dir == 0) ? blk : (blk == 0 ? 0 : (1 + (NBLK - 1 - blk)));
            for (int q = 0; q < npre; ++q) { const int i = (dir == 0) ? q : (q == 0 ? 0 : (NBLK - q));
                const float* sp = SEGS + ((size_t)(ch * NBLK + i) * DK + kg * KPT) * 64 + v; const float* dp = SEGD + (size_t)(ch * NBLK + i) * DK + kg * KPT;
#pragma unroll
                for (int j = 0; j < KPT; ++j) S[j] = dp[j] * S[j] + sp[j * 64]; }
        }
        for (int sb = 0; sb < 16; ++sb) {
            __syncthreads();
            for (int idx = tid; idx < 16 * DK; idx += NTHREADS) { const int tt = idx / DK, k = idx % DK; const int tok = dir ? 255 - (16 * sb + tt) : 16 * sb + tt;
                const bf16* pr = P + (row0 + tok) * LDP; float qv, dv, kv;
                if (HG) { const float z = bf2f(pr[(dir ? C_HGFB : C_HGFF) + h * 64 + k]); const float lbv = LB[dir * 256 + h * 64 + k]; const float sg = sigmoidf_(z);
                    const float f = lbv + (1.f - lbv) * sg; dv = fmaxf(f, 1e-30f); kv = (1.f - lbv) * (1.f - sg); qv = bf2f(pr[C_HGQ + h * 64 + k]); }
                else { const float* w2 = ap->in[I_GLW2] + (size_t)(l * 2 + dir) * 16 * 128 + h * 32 + k; float u = ap->in[I_GLB2][(l * 2 + dir) * 128 + h * 32 + k];
#pragma unroll
                    for (int r = 0; r < 16; ++r) u += bf2f(pr[(dir ? C_GLAB : C_GLAF) + r]) * w2[r * 128];
                    const float ls = fminf(u, 0.f) - log1pf(__expf(-fabsf(u))); dv = __expf(ls * (1.f / 16.f)); kv = bf2f(pr[C_GLK + h * 32 + k]); qv = bf2f(pr[C_GLQ + h * 32 + k]) * 0.17677669529663687f; }
                Lq[tt * 64 + k] = qv; Ld[tt * 64 + k] = dv; Lk[tt * 64 + k] = kv; }
            for (int idx = tid; idx < 16 * 64; idx += NTHREADS) { const int tt = idx >> 6, vv = idx & 63; const int tok = dir ? 255 - (16 * sb + tt) : 16 * sb + tt;
                Lv[idx] = bf2f(P[(row0 + tok) * LDP + (HG ? C_HGI : C_GLV) + h * 64 + vv]); }
            __syncthreads();
            for (int tt = 0; tt < 16; ++tt) { const float vv = Lv[tt * 64 + v]; float o = 0.f;
#pragma unroll
                for (int j = 0; j < KPT; ++j) { const int k = kg * KPT + j; const float d = Ld[tt * 64 + k]; S[j] = d * S[j] + Lk[tt * 64 + k] * vv; Dk[j] *= d; o += Lq[tt * 64 + k] * S[j]; }
                if (passB) PO[(kg * 16 + tt) * 64 + v] = o; }
            if (passB) {
                __syncthreads();
                for (int idx = tid; idx < 16 * 64; idx += NTHREADS) { const int tt = idx >> 6, vv = idx & 63; float o = 0.f;
#pragma unroll
                    for (int g = 0; g < 8; ++g) o += PO[(g * 16 + tt) * 64 + vv];
                    const int tok = dir ? 255 - (16 * sb + tt) : 16 * sb + tt;
                    if (dir == 0) OS[tok * 64 + vv] = o; else OS[tok * 64 + vv] += o; }
            }
        }
        if (!passB) {
            float* sp = SEGS + ((size_t)(ch * NBLK + blk) * DK + kg * KPT) * 64 + v; float* dp = SEGD + (size_t)(ch * NBLK + blk) * DK + kg * KPT;
#pragma unroll
            for (int j = 0; j < KPT; ++j) { sp[j * 64] = S[j]; if (v == 0) dp[j] = Dk[j]; }
        }
    }
    if (passB) {
        __syncthreads();
        const float* ng = ap->in[HG ? I_HGNG : I_GLNG] + l * 256 + h * 64; const int gcol = (HG ? C_HGG : C_GLG) + h * 64, ycol = (HG ? 256 : 512) + h * 64;
        const float gn = ng[lane];
        for (int q = 0; q < 32; ++q) { const int tok = wave * 32 + q; const float o = OS[tok * 64 + lane];
            const float ss = wave_sum(o * o); const float gt = bf2f(P[(row0 + tok) * LDP + gcol + lane]);
            const float y = o * rsqrtf(ss * (1.f / 64.f) + EPS) * gn * siluf_(gt);
            Y[(row0 + tok) * DM + ycol + lane] = (bf16)(pk2(y, 0.f) & 0xffffu); }
    }
}

#define IN(k) (lo <= (k) && (k) < hi)
#if MK_N_LAUNCHES == 1
#define SEAM(k) do { if (IN(k) && IN((k) + 1)) xcd_barrier(bar); } while (0)
#else
#define SEAM(k) do { } while (0)
#endif
#define PHASE_BEGIN \
    int lane; asm volatile("v_mbcnt_lo_u32_b32 %0, -1, 0\n\tv_mbcnt_hi_u32_b32 %0, -1, %0" : "=v"(lane)); const int wave = wave0; const int tid = wave * 64 + lane; \
    const int gw = bid * NWAVES + wave, NGW = G * NWAVES; (void)gw; (void)NGW; (void)lane; \
    ArgP ap = (ArgP)__builtin_amdgcn_kernarg_segment_ptr(); asm volatile("" : "+s"(ap)); \
    unsigned char* ws = ap->ws; \
    float* XL = (float*)(ws + WS_XL); bf16* H = (bf16*)(ws + WS_H); bf16* Y = (bf16*)(ws + WS_Y); bf16* P = (bf16*)(ws + WS_P); \
    float* MP = (float*)(ws + WS_MP); float* MOD = (float*)(ws + WS_MOD); float* LB = (float*)(ws + WS_LB); \
    float* COS = (float*)(ws + WS_ROPE); float* SIN = COS + SEQ * 32; \
    int* RL = (int*)(ws + WS_RL); float* SG = (float*)(ws + WS_SG); \
    bf16* XS = (bf16*)(ws + WS_XS); bf16* ACT = (bf16*)(ws + WS_ACT); bf16* YS = (bf16*)(ws + WS_YS); \
    (void)XL; (void)H; (void)Y; (void)P; (void)MP; (void)MOD; (void)LB; (void)COS; (void)SIN; (void)RL; (void)SG; (void)XS; (void)ACT; (void)YS;


template <int l>
__device__ __forceinline__ void layer_phases(const int lo, const int hi, LAS unsigned char* lds, const int bid, const int G, const int wave0, const XcdBarrier& bar) {
        constexpr int pb = 3 + 10 * l;
        if (IN(pb + 0)) {
            PHASE_BEGIN
            const float* MODL = MOD + (size_t)l * 3 * 6144; unsigned* cnt = (unsigned*)(ws + WS_CTL) + CW_CNT + l * 16 * 64; (void)MODL; (void)cnt;
            pg8::Gemm g{H, (const bf16*)(ws + WS_WIN), DM, DM, DM}; pg8::StaticOrder S; S.init(R, LDP, G, bid);
            pg8::EpiStoreBf16 E{P, LDP};
            pg8::gemm_phase<pg8::EpiStoreBf16, pg8::StaticOrder, true, true>(lds, g, S, E, tid);
        }
        SEAM(pb + 0);
        if (IN(pb + 1)) {
            PHASE_BEGIN
            const float* MODL = MOD + (size_t)l * 3 * 6144; unsigned* cnt = (unsigned*)(ws + WS_CTL) + CW_CNT + l * 16 * 64; (void)MODL; (void)cnt;
            const int n_att = 256 + (l == 0 ? 8 : 0), n_scan = 2 * 2 * 4 * NBLK, n_conv = R / 32;
            for (int it = bid; it < n_att; it += G) {
                if (it < 256) { const int b = it >> 7, kvh = (it >> 6) & 1, qb = it & 63; attn_unit(P, Y, COS, SIN, ap->in[I_SINK] + l * 4, b, kvh, qb, false, lds, tid, wave, lane); }
                else { const int q = it - 256; attn_unit(P, Y, COS, SIN, ap->in[I_SINK] + l * 4, q >> 2, (q >> 1) & 1, q & 1, true, lds, tid, wave, lane); }
            }
            for (int q = (bid + G - n_att % G) % G; q < n_scan; q += G) {
                const int kind = q / (2 * 4 * NBLK), r = q % (2 * 4 * NBLK); const int b = r / (4 * NBLK), h = (r / NBLK) & 3, blk = r % NBLK;
                if (kind == 0) scan_unit<64, true>(ap, l, 0, b, h, blk, lds, tid, wave, lane); else scan_unit<32, false>(ap, l, 0, b, h, blk, lds, tid, wave, lane);
            }
            for (int cu = (bid + 2 * G - (n_att + n_scan) % G) % G; cu < n_conv; cu += G)
                conv_unit(P, Y, ap->in[I_CONVW] + l * 31 * 256, ap->in[I_CONVB] + l * 256, ap->in[I_CLNG] + l * 256, ap->in[I_CLNB] + l * 256, cu, lds, tid, wave, lane);
        }
        SEAM(pb + 1);
        if (IN(pb + 2)) {
            PHASE_BEGIN
            const float* MODL = MOD + (size_t)l * 3 * 6144; unsigned* cnt = (unsigned*)(ws + WS_CTL) + CW_CNT + l * 16 * 64; (void)MODL; (void)cnt;
            const int n_scan = 2 * 2 * 4 * NBLK;
            for (int it = bid; it < n_scan; it += G) {
                const int kind = it / (2 * 4 * NBLK), r = it % (2 * 4 * NBLK); const int b = r / (4 * NBLK), h = (r / NBLK) & 3, blk = r % NBLK;
                if (kind == 0) scan_unit<64, true>(ap, l, 1, b, h, blk, lds, tid, wave, lane); else scan_unit<32, false>(ap, l, 1, b, h, blk, lds, tid, wave, lane);
            }
        }
        SEAM(pb + 2);
        if (IN(pb + 3)) {
            PHASE_BEGIN
            const float* MODL = MOD + (size_t)l * 3 * 6144; unsigned* cnt = (unsigned*)(ws + WS_CTL) + CW_CNT + l * 16 * 64; (void)MODL; (void)cnt;
            pg8::MergeOrder S; S.S.init(R, DM, G, bid);
            pg8::Gemm g{Y, (const bf16*)(ws + WS_WBR), DM, DM, 256}; pg8::EpiMerge E{P, H};
            pg8::gemm_phase<pg8::EpiMerge, pg8::MergeOrder, true, true>(lds, g, S, E, tid);
        }
        SEAM(pb + 3);
        if (IN(pb + 4)) {
            PHASE_BEGIN
            const float* MODL = MOD + (size_t)l * 3 * 6144; unsigned* cnt = (unsigned*)(ws + WS_CTL) + CW_CNT + l * 16 * 64; (void)MODL; (void)cnt;
            pg8::Gemm g{H, (const bf16*)(ws + WS_WOUT), DM, DM, DM}; pg8::StaticOrder S; S.init(R, DM, G, bid);
            pg8::EpiOut E{XL, MODL};
            pg8::gemm_phase<pg8::EpiOut, pg8::StaticOrder, true, true>(lds, g, S, E, tid);
        }
        SEAM(pb + 4);
        if (IN(pb + 5)) {
            PHASE_BEGIN
            const float* MODL = MOD + (size_t)l * 3 * 6144; unsigned* cnt = (unsigned*)(ws + WS_CTL) + CW_CNT + l * 16 * 64; (void)MODL; (void)cnt;
            LAS float* RW = (LAS float*)lds;
            __syncthreads();
            for (int idx = tid; idx < 16 * DM; idx += NTHREADS) { const int e = idx >> 10, d = idx & 1023; RW[idx] = ap->in[I_RW][d * 16 + e]; }
            __syncthreads();
            for (int row = gw; row < R; row += NGW) { const int cond = row_cond(row); if (l == 1 && cond == 2) continue;
                asm volatile("" ::: "memory");
                const f32x4* x4 = (const f32x4*)(XL + (size_t)row * DM); f32x4 v[4]; float ss = 0.f;
#pragma unroll
                for (int q = 0; q < 4; ++q) { v[q] = x4[lane + 64 * q]; ss += (v[q].x * v[q].x + v[q].y * v[q].y) + (v[q].z * v[q].z + v[q].w * v[q].w); }
                const float rstd = rsqrtf(wave_sum(ss) * (1.f / DM) + EPS);
                const float* md = MODL + (size_t)cond * 6144; const float* gf = ap->in[I_GFFN] + l * DM;
#pragma unroll
                for (int q = 0; q < 4; ++q) { const int c = 4 * lane + 256 * q; const f32x4 gg = *(const f32x4*)(gf + c), sh = *(const f32x4*)(md + 3 * DM + c), sc = *(const f32x4*)(md + 4 * DM + c);
                    v[q] = (v[q] * rstd) * gg * (sc + 1.0f) + sh; u32x2 w; w.x = pk2(v[q].x, v[q].y); w.y = pk2(v[q].z, v[q].w); *(u32x2*)(H + (size_t)row * DM + c) = w; }
                float af[16];
#pragma unroll
                for (int e = 0; e < 16; ++e) { float s = 0.f;
#pragma unroll
                    for (int q = 0; q < 4; ++q) { const f32x4 w = *(const LAS f32x4*)(RW + e * DM + 4 * lane + 256 * q); s += (v[q].x * w.x + v[q].y * w.y) + (v[q].z * w.z + v[q].w * w.w); }
                    af[e] = sigmoidf_(wave_sum(s)); }
                float bestsum = -1e30f; int e0 = 0, e1 = 1; float a0 = 0.f, a1 = 0.f;
#pragma unroll
                for (int gI = 0; gI < 4; ++gI) { float m1 = -1e30f, m2 = -1e30f; int i1 = 0, i2 = 0; float f1 = 0.f, f2 = 0.f;
#pragma unroll
                    for (int i = 0; i < 4; ++i) { const float bv = af[gI * 4 + i] + ap->in[I_RB][gI * 4 + i];
                        if (bv > m1) { m2 = m1; i2 = i1; f2 = f1; m1 = bv; i1 = gI * 4 + i; f1 = af[gI * 4 + i]; } else if (bv > m2) { m2 = bv; i2 = gI * 4 + i; f2 = af[gI * 4 + i]; } }
                    const float gs = m1 + m2; if (gs > bestsum) { bestsum = gs; e0 = i1; e1 = i2; a0 = f1; a1 = f2; } }
                if (lane == 0) { const float inv = 1.f / (a0 + a1);
                    const unsigned r0 = atomicAdd(cnt + e0 * 64, 1u); RL[(size_t)e0 * RLCAP + r0] = row * 2; SG[row * 2] = a0 * inv;
                    const unsigned r1 = atomicAdd(cnt + e1 * 64, 1u); RL[(size_t)e1 * RLCAP + r1] = row * 2 + 1; SG[row * 2 + 1] = a1 * inv; }
            }
        }
        SEAM(pb + 5);
        if (IN(pb + 6)) {
            PHASE_BEGIN
            const float* MODL = MOD + (size_t)l * 3 * 6144; unsigned* cnt = (unsigned*)(ws + WS_CTL) + CW_CNT + l * 16 * 64; (void)MODL; (void)cnt;
            int bs[NEXP + 1]; bs[0] = 0;
#pragma unroll
            for (int e = 0; e < NEXP; ++e) bs[e + 1] = bs[e] + (int)((cnt[e * 64] + 255u) >> 8);
            const int nrows = bs[NEXP] * 256;
            for (int cr = gw; cr < nrows; cr += NGW) { const int cb = cr >> 8; int e = 0, jb = 0;
#pragma unroll
                for (int q = 1; q < NEXP; ++q) if (cb >= bs[q]) { e = q; jb = bs[q]; }
                const int rank = (cb - jb) * 256 + (cr & 255);
                u32x4 v0 = {0u, 0u, 0u, 0u}, v1 = v0;
                if (rank < (int)cnt[e * 64]) { const int tok = RL[(size_t)e * RLCAP + rank] >> 1; const u32x4* s = (const u32x4*)(H + (size_t)tok * DM); v0 = s[lane]; v1 = s[lane + 64]; }
                u32x4* d = (u32x4*)(XS + (size_t)cr * DM); d[lane] = v0; d[lane + 64] = v1; }
        }
        SEAM(pb + 6);
        if (IN(pb + 7)) {
            PHASE_BEGIN
            const float* MODL = MOD + (size_t)l * 3 * 6144; unsigned* cnt = (unsigned*)(ws + WS_CTL) + CW_CNT + l * 16 * 64; (void)MODL; (void)cnt;
            pg8::Gemm g{XS, (const bf16*)(ws + WS_W13), DM, DM, DM}; pg8::MoeOrder S; S.init(cnt, 8, G, bid);
            pg8::EpiMoe1 E{ACT};
            pg8::gemm_phase<pg8::EpiMoe1, pg8::MoeOrder, true, true>(lds, g, S, E, tid);
        }
        SEAM(pb + 7);
        if (IN(pb + 8)) {
            PHASE_BEGIN
            const float* MODL = MOD + (size_t)l * 3 * 6144; unsigned* cnt = (unsigned*)(ws + WS_CTL) + CW_CNT + l * 16 * 64; (void)MODL; (void)cnt;
            pg8::Gemm g{ACT, (const bf16*)(ws + WS_W2), DM, DM, DM}; pg8::MoeOrder S; S.init(cnt, 4, G, bid);
            pg8::EpiMoe2 E{YS, RL, cnt};
            pg8::gemm_phase<pg8::EpiMoe2, pg8::MoeOrder, true, true>(lds, g, S, E, tid);
        }
        SEAM(pb + 8);
        if (IN(pb + 9)) {
            PHASE_BEGIN
            const float* MODL = MOD + (size_t)l * 3 * 6144; unsigned* cnt = (unsigned*)(ws + WS_CTL) + CW_CNT + l * 16 * 64; (void)MODL; (void)cnt;
            for (int row = gw; row < R; row += NGW) { const int cond = row_cond(row); if (l == 1 && cond == 2) continue;
                const float g0 = SG[row * 2], g1 = SG[row * 2 + 1];
                const f32x4* x4 = (const f32x4*)(XL + (size_t)row * DM); const float* gm = MODL + (size_t)cond * 6144 + 5 * DM; f32x4 v[4];
#pragma unroll
                for (int q = 0; q < 4; ++q) { const int c = 4 * lane + 256 * q; const u32x2 y0 = *(const u32x2*)(YS + (size_t)(row * 2) * DM + c), y1 = *(const u32x2*)(YS + (size_t)(row * 2 + 1) * DM + c);
                    f32x4 y; y.x = g0 * bflo(y0.x) + g1 * bflo(y1.x); y.y = g0 * bfhi(y0.x) + g1 * bfhi(y1.x); y.z = g0 * bflo(y0.y) + g1 * bflo(y1.y); y.w = g0 * bfhi(y0.y) + g1 * bfhi(y1.y);
                    v[q] = x4[lane + 64 * q] + *(const f32x4*)(gm + c) * y; }
                if (l == 0) {
                    f32x4* xo = (f32x4*)(XL + (size_t)row * DM);
#pragma unroll
                    for (int q = 0; q < 4; ++q) xo[lane + 64 * q] = v[q];
                    const float* md = MOD + (size_t)(1 * 3 + cond) * 6144;
                    modnorm_store(v, ap->in[I_GMIX] + DM, md, md + DM, H + (size_t)row * DM, lane);
                } else {
                    float ss = 0.f;
#pragma unroll
                    for (int q = 0; q < 4; ++q) ss += (v[q].x * v[q].x + v[q].y * v[q].y) + (v[q].z * v[q].z + v[q].w * v[q].w);
                    const float rstd = rsqrtf(wave_sum(ss) * (1.f / DM) + EPS);
                    const int b = row / RB, t = row - b * RB - CTXL; f32x4* o4 = (f32x4*)(ap->out + ((size_t)b * SEQ + t) * DM);
#pragma unroll
                    for (int q = 0; q < 4; ++q) o4[lane + 64 * q] = v[q] * rstd * *(const f32x4*)(ap->in[I_FINALG] + 4 * lane + 256 * q);
                }
            }
            if (l == 0) { __syncthreads(); convert_weights(ap, 1, lds, gw, NGW, wave, lane); }
        }
        SEAM(pb + 9);
}

__global__ void __launch_bounds__(NTHREADS, 2) fwd(Args a) {
    extern __shared__ __attribute__((aligned(16))) unsigned char lds_raw[];
    LAS unsigned char* lds = (LAS unsigned char*)lds_raw;
    volatile LAS unsigned* MISC = (volatile LAS unsigned*)(lds + MISC_OFF);
    const int tid0 = threadIdx.x; const int wave0 = __builtin_amdgcn_readfirstlane(tid0 >> 6);
    const int G = gridDim.x, bid = blockIdx.x;
    unsigned* ctl = (unsigned*)(a.ws + WS_CTL);
    for (int u = tid0; u < (LDS_BYTES - RING_BYTES) / 4; u += NTHREADS) ((LAS unsigned*)(lds + RING_BYTES))[u] = 0u;
    __syncthreads();
    XcdBarrier bar; bar.bar = ctl + CW_BAR; bar.x = 0; bar.st = nullptr;
#if MK_N_LAUNCHES == 1
    bar = xcd_barrier_post(ctl + CW_BAR, MISC + 8);
#endif
    const int lo = a.ph_lo, hi = a.ph_hi;
    if (IN(0)) {
        PHASE_BEGIN
        for (int row = gw; row < R; row += NGW) { const int b = row / RB, j = row - b * RB;
            const float* src = (j < CTXL) ? ap->in[I_CTX] + ((size_t)b * CTXL + j) * DM : ap->in[I_X] + ((size_t)b * SEQ + (j - CTXL)) * DM;
            const f32x4* s4 = (const f32x4*)src; f32x4* d4 = (f32x4*)(XL + (size_t)row * DM);
#pragma unroll
            for (int q = 0; q < 4; ++q) d4[lane + 64 * q] = s4[lane + 64 * q]; }
        for (int it = gw; it < 384; it += NGW) { const int l = it / 192, r = it % 192, kc = r / 24, jb = r % 24;
            f32x4 a0 = {0.f, 0.f, 0.f, 0.f}, a1 = a0, a2 = a0;
            const float* wp = ap->in[I_WMOD] + ((size_t)l * DM + kc * 128) * 6144 + jb * 256 + lane * 4;
            for (int k = 0; k < 128; ++k) { const f32x4 w = *(const f32x4*)(wp + (size_t)k * 6144); const int kk = kc * 128 + k;
                const float s0 = siluf_(ap->in[I_C][kk]), s1 = siluf_(ap->in[I_C][DM + kk]), s2 = siluf_(ap->in[I_CCTX][kk]);
                a0 += w * s0; a1 += w * s1; a2 += w * s2; }
            float* mp = MP + ((size_t)(l * 8 + kc) * 3) * 6144 + jb * 256 + lane * 4;
            *(f32x4*)(mp) = a0; *(f32x4*)(mp + 6144) = a1; *(f32x4*)(mp + 2 * 6144) = a2; }
        if (bid == 0) { for (int i = tid; i < 512; i += NTHREADS) { const float x0 = ap->in[I_LBLOG][i], x1 = ap->in[I_LBLOG][512 + i]; const float m = fmaxf(x0, x1);
            const float e0 = expf(x0 - m), e1 = expf(x1 - m); LB[i] = 0.f; LB[512 + i] = e1 / (e0 + e1); } }
        for (int idx = bid * NTHREADS + tid; idx < SEQ * 32; idx += G * NTHREADS) { const int t = idx >> 5, ai = idx & 31; const int ax = ai >> 4, i = ai & 15;
            const float inv = powf(10000.0f, -(float)i / 16.0f); const float pos = (float)(ax == 0 ? (t >> 6) : (t & 63)); const float ang = pos * inv;
            COS[idx] = cosf(ang); SIN[idx] = sinf(ang); }
        convert_weights(ap, 0, lds, gw, NGW, wave, lane);
    }
    SEAM(0);
    if (IN(1)) {
        PHASE_BEGIN
        for (int idx = bid * NTHREADS + tid; idx < 2 * 3 * 6144; idx += G * NTHREADS) { const int l = idx / (3 * 6144), r = idx % (3 * 6144), cond = r / 6144, j = r % 6144;
            float s = ap->in[I_BMOD][l * 6144 + j];
#pragma unroll
            for (int kc = 0; kc < 8; ++kc) s += MP[((size_t)(l * 8 + kc) * 3 + cond) * 6144 + j];
            MOD[idx] = s; }
    }
    SEAM(1);
    if (IN(2)) {
        PHASE_BEGIN
        for (int row = gw; row < R; row += NGW) { const int cond = row_cond(row); const f32x4* x4 = (const f32x4*)(XL + (size_t)row * DM); f32x4 v[4];
#pragma unroll
            for (int q = 0; q < 4; ++q) v[q] = x4[lane + 64 * q];
            const float* md = MOD + (size_t)(0 * 3 + cond) * 6144;
            modnorm_store(v, ap->in[I_GMIX], md, md + DM, H + (size_t)row * DM, lane); }
    }
    SEAM(2);

    layer_phases<0>(lo, hi, lds, bid, G, wave0, bar);
    layer_phases<1>(lo, hi, lds, bid, G, wave0, bar);
}

constexpr int NPHASES = 23;
extern "C" void kernel_launch(void* const* d_in, const int* in_sizes, int n_in, void* d_out, int out_size, void* d_ws, size_t ws_size, hipStream_t stream) {
    static int grid = 0;
    if (grid == 0) {
        int dev = 0, cus = 0, per_cu = 0;
        if (hipGetDevice(&dev) != hipSuccess || hipDeviceGetAttribute(&cus, hipDeviceAttributeMultiprocessorCount, dev) != hipSuccess) { grid = -1; return; }
        if (hipFuncSetAttribute((const void*)fwd, hipFuncAttributeMaxDynamicSharedMemorySize, LDS_BYTES) != hipSuccess) { grid = -1; return; }
        if (hipOccupancyMaxActiveBlocksPerMultiprocessor(&per_cu, (const void*)fwd, NTHREADS, LDS_BYTES) != hipSuccess || per_cu < 1) per_cu = 1;
        (void)hipGetLastError();
        grid = cus;
        if (ws_size < WS_END) fprintf(stderr, "kernel_launch: workspace too small: %zu < %zu\n", ws_size, (size_t)WS_END);
    }
    if (grid < 0) return;
    (void)hipMemsetAsync((char*)d_ws + WS_CTL, 0, CTL_ZERO_BYTES, stream);
    Args a{};
    for (int i = 0; i < 30; ++i) a.in[i] = (const float*)d_in[i];
    a.out = (float*)d_out; a.ws = (unsigned char*)d_ws;
#if MK_N_LAUNCHES == 1
    a.ph_lo = 0; a.ph_hi = NPHASES;
    hipLaunchKernelGGL(fwd, dim3(grid), dim3(NTHREADS), LDS_BYTES, stream, a);
#else
    for (int ph = 0; ph < NPHASES; ++ph) { a.ph_lo = ph; a.ph_hi = ph + 1; hipLaunchKernelGGL(fwd, dim3(grid), dim3(NTHREADS), LDS_BYTES, stream, a); }
#endif
}
```

```cpp
#include <hip/hip_runtime.h>
#include <cstdio>
#include <cstdint>

#ifndef PROBE_REP
#define PROBE_REP 0
#endif
#define REP(j) ((((PROBE_REP) >> (j)) & 1) + 1)
#ifndef MK_N_LAUNCHES
#define MK_N_LAUNCHES 1
#endif

#define GAS __attribute__((address_space(1)))
#define LAS __attribute__((address_space(3)))
typedef unsigned short bf16;
typedef short bf16x8 __attribute__((ext_vector_type(8)));
typedef short s16x4 __attribute__((ext_vector_type(4)));
typedef float f32x4 __attribute__((ext_vector_type(4)));
typedef float f32x2 __attribute__((ext_vector_type(2)));
typedef unsigned u32x4 __attribute__((ext_vector_type(4)));
typedef unsigned u32x2 __attribute__((ext_vector_type(2)));
typedef __bf16 bf16x2_t __attribute__((ext_vector_type(2)));

__device__ __forceinline__ unsigned pk2(float lo, float hi) { f32x2 v = {lo, hi}; bf16x2_t b = __builtin_convertvector(v, bf16x2_t); return __builtin_bit_cast(unsigned, b); }
__device__ __forceinline__ float bflo(unsigned w) { return __uint_as_float(w << 16); }
__device__ __forceinline__ float bfhi(unsigned w) { return __uint_as_float(w & 0xffff0000u); }
__device__ __forceinline__ float bf2f(bf16 v) { return __uint_as_float(((unsigned)v) << 16); }
__device__ __forceinline__ float sigmoidf_(float x) { return __builtin_amdgcn_rcpf(1.0f + __expf(-x)); }
__device__ __forceinline__ float siluf_(float x) { return x * __builtin_amdgcn_rcpf(1.0f + __expf(-x)); }
__device__ __forceinline__ float wave_sum(float v) {
#pragma unroll
    for (int o = 1; o < 64; o <<= 1) v += __shfl_xor(v, o);
    return v;
}

constexpr int DM = 1024, NBATCH = 2, SEQ = 8192, CTXL = 256, RB = SEQ + CTXL, R = NBATCH * RB;
constexpr int NBLK = RB / 256;
constexpr int LDP = 7424;
constexpr int C_CONV = 0, C_HGQ = 512, C_HGFF = 768, C_HGFB = 1024, C_HGI = 1280, C_HGG = 1536, C_GLQ = 1792, C_GLK = 1920, C_GLV = 2048,
              C_GLAF = 2304, C_GLAB = 2320, C_GLG = 2336, C_ATQ = 2592, C_ATK = 2848, C_ATV = 2976, C_BG = 3104, W_IN_COLS = 7200;
constexpr float EPS = 1e-6f;
constexpr int NEXP = 16, RLCAP = 2 * R;
constexpr int NWAVES = 8, NTHREADS = 512;

constexpr size_t MiB = 1u << 20;
constexpr size_t WS_CTL = 0, CTL_ZERO_BYTES = 1 * MiB;
constexpr size_t WS_MP = 1 * MiB;
constexpr size_t WS_MOD = WS_MP + 1280 * 1024;
constexpr size_t WS_LB = WS_MOD + 256 * 1024;
constexpr size_t WS_ROPE = 3 * MiB;
constexpr size_t WS_RL = 5 * MiB;
constexpr size_t WS_SG = WS_RL + (size_t)NEXP * RLCAP * 4;
constexpr size_t WS_SEGH = 8 * MiB;
constexpr size_t WS_SEGG = WS_SEGH + (size_t)16 * NBLK * 4096 * 4;
constexpr size_t WS_SEGDH = WS_SEGG + (size_t)16 * NBLK * 2048 * 4;
constexpr size_t WS_SEGDG = WS_SEGDH + (size_t)16 * NBLK * 64 * 4;
constexpr size_t WS_WIN = 21 * MiB;
constexpr size_t WS_WBR = 36 * MiB;
constexpr size_t WS_WOUT = 38 * MiB;
constexpr size_t WS_W13 = 40 * MiB;
constexpr size_t WS_W2 = 104 * MiB;
constexpr size_t WS_XL = 136 * MiB;
constexpr size_t WS_H = 202 * MiB;
constexpr size_t WS_Y = 235 * MiB;
constexpr size_t WS_P = 268 * MiB;
constexpr size_t WS_XS = WS_P, WS_ACT = WS_P + 74 * MiB, WS_YS = WS_P + 148 * MiB;
constexpr size_t WS_END = WS_P + (size_t)R * LDP * 2;
static_assert(WS_SEGDG + 16 * NBLK * 32 * 4 <= WS_WIN && WS_END <= 508 * MiB, "ws map");
static_assert((size_t)(2 * R + 16 * 256) * 2048 <= 74 * MiB, "XS fits");
constexpr int CW_BAR = 4096;
constexpr int CW_CNT = 16384;

constexpr int RING_BYTES = 131072;
constexpr int MISC_OFF = RING_BYTES + 320;
constexpr int LDS_BYTES = 147456;

namespace pg8 {
#define PG8_LAS __attribute__((address_space(3)))
typedef unsigned short bf16_t;
constexpr int BM = 256, BK = 64, HALF = 128, HTB = HALF * BK * 2, STAGE_BYTES = 8 * HTB, NXCD = 8, WGM = 8;
__host__ __device__ __forceinline__ int lds_byte(int r, int c) { const int st = (r >> 4) * 2 + (c >> 5), rr = r & 15, cc = c & 31, ob = rr * 64 + cc * 2; return st * 1024 + (ob ^ (((ob >> 9) & 1) << 5)); }
__host__ __device__ __forceinline__ void stage_rc(int b, int& R_, int& C) { const int st = b / 1024, sb = b % 1024, swz = sb ^ (((sb >> 9) & 1) << 5); R_ = (st >> 1) * 16 + swz / 64; C = (st & 1) * 32 + (swz % 64) / 2; }
__host__ __device__ __forceinline__ int perm32(int rho) { const int n = rho >> 4, i = rho & 15; return 8 * (i >> 2) + 4 * n + (i & 3); }

struct Unit { int pm, pn, pb, aux, kofs; };
struct Gemm { const bf16_t* A; const bf16_t* Bt; int lda, ldb, K; };

struct StaticOrder {
    int nM, nN, nwg, G, c;
    __host__ __device__ void init(int M, int N, int G_, int c_) { nM = M / BM; nN = N / BM; nwg = nM * nN; G = G_; c = c_; }
    __host__ __device__ bool next(int i, Unit& u) const {
        const long L = (long)i * G + c; if (L >= nwg) return false;
        int wgid = (int)L; { const int q = nwg / NXCD, r = nwg % NXCD, xcd = wgid % NXCD, off = wgid / NXCD; wgid = (xcd < r ? xcd * (q + 1) : r * (q + 1) + (xcd - r) * q) + off; }
        const int nig = WGM * nN, gid = wgid / nig, fm = gid * WGM, gsz = (nM - fm) < WGM ? (nM - fm) : WGM;
        u.pm = fm + ((wgid % nig) % gsz); u.pn = (wgid % nig) / gsz; u.pb = u.pn; u.aux = 0; u.kofs = 0; return true;
    }
};
struct MoeOrder {
    int bs[NEXP + 1]; int ncol, G, c;
    __device__ __forceinline__ void init(const unsigned* cnt, int ncol_, int G_, int c_) {
        ncol = ncol_; G = G_; c = c_; bs[0] = 0;
#pragma unroll
        for (int e = 0; e < NEXP; ++e) bs[e + 1] = bs[e] + __builtin_amdgcn_readfirstlane((int)((cnt[e * 64] + 255u) >> 8));
    }
    __device__ __forceinline__ bool next(int i, Unit& u) const {
        const long L = (long)i * G + c; if (L >= (long)bs[NEXP] * ncol) return false;
        const int cb = (int)(L / ncol), pn = (int)(L % ncol); int e = 0, jb = 0;
#pragma unroll
        for (int q = 1; q < NEXP; ++q) if (cb >= bs[q]) { e = q; jb = bs[q]; }
        u.pm = cb; u.pn = pn; u.pb = e * ncol + pn; u.aux = (e << 16) | (cb - jb); u.kofs = 0; return true;
    }
};
struct MergeOrder {
    StaticOrder S;
    __device__ __forceinline__ bool next(int i, Unit& u) const { if (!S.next(i >> 2, u)) return false; u.aux = i & 3; u.kofs = 256 * (i & 3); return true; }
};

template <class Epi, class Sched, bool ALIGN_EPI = false, bool SP2 = false>
__device__ __forceinline__ void gemm_phase(PG8_LAS unsigned char* lds, const Gemm g, const Sched& S, const Epi& E, const int tid) {
    const int wid = __builtin_amdgcn_readfirstlane(tid >> 6), lane = tid & 63, wr = wid >> 2, wc = wid & 3, fr = lane & 15, fq = lane >> 4;
    const int K = g.K, nt = K / BK;
    unsigned voffA[2], voffB[2];
#pragma unroll
    for (int i = 0; i < 2; ++i) { int R_, C; stage_rc(tid * 16 + i * 8192, R_, C); const int Rb = Epi::PERM ? ((R_ & ~31) + perm32(R_ & 31)) : R_;
        voffA[i] = (unsigned)(R_ * g.lda + C) * 2u; voffB[i] = (unsigned)(Rb * g.ldb + C) * 2u; }
    const size_t kstep = (size_t)(BK * 2);
    const size_t hstepA = (size_t)HALF * g.lda * 2, hstepB = (size_t)HALF * g.ldb * 2;
    const size_t tstepA = 2 * hstepA, tstepB = 2 * hstepB;
    const unsigned ldsw = (unsigned)wid * 1024u;
    const int aoff = lds_byte(wr * 64 + fr, fq * 8), boff = lds_byte(wc * 32 + fr, fq * 8);
#define PG8_SA(b, h) (((b) * 2 + (h)) * HTB)
#define PG8_SB(b, h) ((4 + (b) * 2 + (h)) * HTB)
#define PG8_STAGE(bufoff, gbase, voff) do { _Pragma("unroll") for (int _i = 0; _i < 2; ++_i) \
        __builtin_amdgcn_global_load_lds((const unsigned*)((const char*)(gbase) + (voff)[_i]), (PG8_LAS unsigned*)(lds + (bufoff) + ldsw + _i * 8192), 16, 0, 0); } while (0)
#define PG8_LDA(dst, b, h) do { _Pragma("unroll") for (int m = 0; m < 4; ++m) _Pragma("unroll") for (int k = 0; k < 2; ++k) dst[m][k] = *(const PG8_LAS bf16x8*)(lds + PG8_SA(b, h) + aoff + m * 2048 + k * 1024); } while (0)
#define PG8_LDB(dst, b, h) do { _Pragma("unroll") for (int n = 0; n < 2; ++n) _Pragma("unroll") for (int k = 0; k < 2; ++k) dst[n][k] = *(const PG8_LAS bf16x8*)(lds + PG8_SB(b, h) + boff + n * 2048 + k * 1024); } while (0)
#define PG8_MMA(ai, bj, At, Bt) do { __builtin_amdgcn_s_setprio(1); _Pragma("unroll") for (int m = 0; m < 4; ++m) _Pragma("unroll") for (int n = 0; n < 2; ++n) _Pragma("unroll") for (int k = 0; k < 2; ++k) \
        acc[ai][bj][m][n] = __builtin_amdgcn_mfma_f32_16x16x32_bf16(Bt[n][k], At[m][k], acc[ai][bj][m][n], 0, 0, 0); __builtin_amdgcn_s_setprio(0); } while (0)
#define PG8_WAIT_V(n) asm volatile("s_waitcnt vmcnt(" #n ")" ::: "memory")
#define PG8_WAIT_L(n) asm volatile("s_waitcnt lgkmcnt(" #n ")" ::: "memory")
#define PG8_BAR __builtin_amdgcn_s_barrier()
#define PG8_SCHED __builtin_amdgcn_sched_barrier(0)
    Unit cur, nxt; int ui = 0;
    if (!S.next(0, cur)) return;
    f32x4 acc[2][2][4][2];
#pragma unroll
    for (int a = 0; a < 2; ++a)
#pragma unroll
        for (int b = 0; b < 2; ++b)
#pragma unroll
            for (int m = 0; m < 4; ++m)
#pragma unroll
                for (int n = 0; n < 2; ++n) acc[a][b][m][n] = (f32x4){0.f, 0.f, 0.f, 0.f};
    bf16x8 At[4][2], B0[2][2], B1[2][2];
    const char* cA = (const char*)g.A + (size_t)cur.pm * tstepA + cur.kofs * 2; const char* cB = (const char*)g.Bt + (size_t)cur.pb * tstepB + cur.kofs * 2;
    if constexpr (SP2) {
        PG8_STAGE(PG8_SB(0, 0), cB, voffB); PG8_STAGE(PG8_SB(0, 1), cB + hstepB, voffB); PG8_STAGE(PG8_SA(0, 0), cA, voffA); PG8_STAGE(PG8_SA(0, 1), cA + hstepA, voffA);
        if (wr == 1) PG8_BAR;
        PG8_WAIT_V(2); PG8_BAR;
        PG8_STAGE(PG8_SB(1, 0), cB + kstep, voffB); PG8_STAGE(PG8_SA(1, 0), cA + kstep, voffA); PG8_STAGE(PG8_SB(1, 1), cB + hstepB + kstep, voffB);
        PG8_WAIT_V(6); PG8_BAR;
    } else {
        PG8_STAGE(PG8_SB(0, 0), cB, voffB); PG8_STAGE(PG8_SA(0, 0), cA, voffA); PG8_STAGE(PG8_SB(0, 1), cB + hstepB, voffB); PG8_STAGE(PG8_SA(0, 1), cA + hstepA, voffA);
        if (wr == 1) PG8_BAR;
        PG8_WAIT_V(4); PG8_BAR;
        PG8_STAGE(PG8_SB(1, 0), cB + kstep, voffB); PG8_STAGE(PG8_SA(1, 0), cA + kstep, voffA); PG8_STAGE(PG8_SB(1, 1), cB + hstepB + kstep, voffB);
        PG8_WAIT_V(6); PG8_BAR;
    }
    for (;;) {
        const bool has_next = S.next(ui + 1, nxt);
        const char* nA = has_next ? (const char*)g.A + (size_t)nxt.pm * tstepA + nxt.kofs * 2 : cA; const char* nB = has_next ? (const char*)g.Bt + (size_t)nxt.pb * tstepB + nxt.kofs * 2 : cB;
        for (int t = 0; t < nt; t += 2) {
            const bool last = (t == nt - 2);
            const char* a1 = cA + (size_t)(t + 1) * kstep;
            const char* a2 = last ? nA : cA + (size_t)(t + 2) * kstep; const char* b2 = last ? nB : cB + (size_t)(t + 2) * kstep;
            const char* a3 = a2 + kstep; const char* b3 = b2 + kstep;
            if constexpr (SP2) {
            PG8_LDB(B0, 0, 0); PG8_LDB(B1, 0, 1); PG8_SCHED; PG8_LDA(At, 0, 0); PG8_STAGE(PG8_SA(1, 1), a1 + hstepA, voffA);
            PG8_WAIT_V(8); PG8_WAIT_L(0); PG8_BAR; PG8_MMA(0, 0, At, B0); PG8_MMA(0, 1, At, B1); PG8_BAR; PG8_SCHED;
            PG8_LDA(At, 0, 1); PG8_STAGE(PG8_SB(0, 0), b2, voffB); PG8_STAGE(PG8_SB(0, 1), b2 + hstepB, voffB); PG8_STAGE(PG8_SA(0, 0), a2, voffA);
            PG8_WAIT_V(8); PG8_WAIT_L(0); PG8_BAR; PG8_MMA(1, 0, At, B0); PG8_MMA(1, 1, At, B1); PG8_BAR; PG8_SCHED;
            PG8_LDB(B0, 1, 0); PG8_LDB(B1, 1, 1); PG8_SCHED; PG8_LDA(At, 1, 0); PG8_STAGE(PG8_SA(0, 1), a2 + hstepA, voffA);
            PG8_WAIT_V(8); PG8_WAIT_L(0); PG8_BAR; PG8_MMA(0, 0, At, B0); PG8_MMA(0, 1, At, B1); PG8_BAR; PG8_SCHED;
            PG8_LDA(At, 1, 1); PG8_STAGE(PG8_SB(1, 0), b3, voffB); PG8_STAGE(PG8_SB(1, 1), b3 + hstepB, voffB); PG8_STAGE(PG8_SA(1, 0), a3, voffA);
            PG8_WAIT_V(8); PG8_WAIT_L(0); PG8_BAR; PG8_MMA(1, 0, At, B0); PG8_MMA(1, 1, At, B1); PG8_BAR; PG8_SCHED;
            } else {
            PG8_LDB(B0, 0, 0); PG8_SCHED; PG8_LDA(At, 0, 0); PG8_STAGE(PG8_SA(1, 1), a1 + hstepA, voffA);
            PG8_WAIT_L(8); PG8_BAR; PG8_WAIT_L(0); PG8_MMA(0, 0, At, B0); PG8_BAR; PG8_SCHED;
            PG8_LDB(B1, 0, 1); PG8_STAGE(PG8_SB(0, 0), b2, voffB);
            PG8_BAR; PG8_WAIT_L(0); PG8_MMA(0, 1, At, B1); PG8_BAR;
            PG8_LDA(At, 0, 1); PG8_STAGE(PG8_SA(0, 0), a2, voffA);
            PG8_BAR; PG8_WAIT_L(0); PG8_MMA(1, 0, At, B0); PG8_BAR; PG8_SCHED;
            PG8_STAGE(PG8_SB(0, 1), b2 + hstepB, voffB);
            PG8_WAIT_V(6); PG8_BAR; PG8_MMA(1, 1, At, B1); PG8_BAR;
            PG8_LDB(B0, 1, 0); PG8_SCHED; PG8_LDA(At, 1, 0); PG8_STAGE(PG8_SA(0, 1), a2 + hstepA, voffA);
            PG8_WAIT_L(8); PG8_BAR; PG8_WAIT_L(0); PG8_MMA(0, 0, At, B0); PG8_BAR; PG8_SCHED;
            PG8_LDB(B1, 1, 1); PG8_STAGE(PG8_SB(1, 0), b3, voffB);
            PG8_BAR; PG8_WAIT_L(0); PG8_MMA(0, 1, At, B1); PG8_BAR;
            PG8_LDA(At, 1, 1); PG8_STAGE(PG8_SA(1, 0), a3, voffA);
            PG8_BAR; PG8_WAIT_L(0); PG8_MMA(1, 0, At, B0); PG8_BAR; PG8_SCHED;
            PG8_STAGE(PG8_SB(1, 1), b3 + hstepB, voffB);
            PG8_WAIT_V(6); PG8_BAR; PG8_MMA(1, 1, At, B1); PG8_BAR;
            }
        }
        if constexpr (ALIGN_EPI) { if (wr == 0) PG8_BAR; }
        E(acc, cur, wr, wc, fr, fq);
        if (!has_next) break;
#pragma unroll
        for (int a = 0; a < 2; ++a)
#pragma unroll
            for (int b = 0; b < 2; ++b)
#pragma unroll
                for (int m = 0; m < 4; ++m)
#pragma unroll
                    for (int n = 0; n < 2; ++n) acc[a][b][m][n] = (f32x4){0.f, 0.f, 0.f, 0.f};
        cur = nxt; cA = nA; cB = nB; ++ui;
        if constexpr (ALIGN_EPI) { if (wr == 1) PG8_BAR; }
    }
    PG8_WAIT_V(0);
    if constexpr (!ALIGN_EPI) { if (wr == 0) PG8_BAR; }
    PG8_BAR;
#undef PG8_SA
#undef PG8_SB
#undef PG8_STAGE
#undef PG8_LDA
#undef PG8_LDB
#undef PG8_MMA
#undef PG8_WAIT_V
#undef PG8_WAIT_L
#undef PG8_BAR
#undef PG8_SCHED
}

struct EpiStoreBf16 {
    static constexpr bool PERM = true;
    bf16_t* O; int ldc;
    __device__ __forceinline__ void operator()(const f32x4 (&acc)[2][2][4][2], const Unit& u, int wr, int wc, int fr, int fq) const {
        const int row0 = u.pm * BM + wr * 64 + fr, col0 = u.pn * BM + wc * 32 + 8 * fq;
#pragma unroll
        for (int ai = 0; ai < 2; ++ai)
#pragma unroll
            for (int m = 0; m < 4; ++m) { bf16_t* rowp = O + (size_t)(row0 + ai * HALF + m * 16) * ldc + col0;
#pragma unroll
                for (int bj = 0; bj < 2; ++bj) { const f32x4 v0 = acc[ai][bj][m][0], v1 = acc[ai][bj][m][1];
                    u32x4 w; w.x = pk2(v0[0], v0[1]); w.y = pk2(v0[2], v0[3]); w.z = pk2(v1[0], v1[1]); w.w = pk2(v1[2], v1[3]);
                    *(u32x4*)(rowp + bj * HALF) = w; } }
    }
};
struct EpiMerge {
    static constexpr bool PERM = true;
    const bf16_t* P; bf16_t* MG;
    __device__ __forceinline__ void operator()(const f32x4 (&acc)[2][2][4][2], const Unit& u, int wr, int wc, int fr, int fq) const {
        const int row0 = u.pm * BM + wr * 64 + fr, col0 = u.pn * BM + wc * 32 + 8 * fq; const int br = u.aux;
        const bf16_t* gp = P + C_BG + br * 1024 + col0;
#pragma unroll
        for (int ai = 0; ai < 2; ++ai)
#pragma unroll
            for (int m = 0; m < 4; ++m) { const int row = row0 + ai * HALF + m * 16;
#pragma unroll
                for (int bj = 0; bj < 2; ++bj) { const int col = col0 + bj * HALF;
                    const u32x4 gw = *(const u32x4*)(gp + (size_t)row * LDP + bj * HALF);
                    u32x4 ow = {0u, 0u, 0u, 0u}; if (br > 0) ow = *(const u32x4*)(MG + (size_t)row * DM + col);
                    const f32x4 v0 = acc[ai][bj][m][0], v1 = acc[ai][bj][m][1];
                    u32x4 w;
                    w.x = pk2(bflo(ow.x) + sigmoidf_(bflo(gw.x)) * v0[0], bfhi(ow.x) + sigmoidf_(bfhi(gw.x)) * v0[1]);
                    w.y = pk2(bflo(ow.y) + sigmoidf_(bflo(gw.y)) * v0[2], bfhi(ow.y) + sigmoidf_(bfhi(gw.y)) * v0[3]);
                    w.z = pk2(bflo(ow.z) + sigmoidf_(bflo(gw.z)) * v1[0], bfhi(ow.z) + sigmoidf_(bfhi(gw.z)) * v1[1]);
                    w.w = pk2(bflo(ow.w) + sigmoidf_(bflo(gw.w)) * v1[2], bfhi(ow.w) + sigmoidf_(bfhi(gw.w)) * v1[3]);
                    *(u32x4*)(MG + (size_t)row * DM + col) = w; }
                asm volatile("" ::: "memory"); }
    }
};
struct EpiOut {
    static constexpr bool PERM = false;
    float* XL; const float* MODL;
    __device__ __forceinline__ void operator()(const f32x4 (&acc)[2][2][4][2], const Unit& u, int wr, int wc, int fr, int fq) const {
        const int row0 = u.pm * BM + wr * 64 + fr, col0 = u.pn * BM + wc * 32 + 4 * fq;
        const int cond = (u.pm % NBLK == 0) ? 2 : (u.pm / NBLK);
        const float* gp = MODL + (cond * 6 + 2) * DM + col0;
        f32x4 gv[2][2];
#pragma unroll
        for (int bj = 0; bj < 2; ++bj)
#pragma unroll
            for (int n = 0; n < 2; ++n) gv[bj][n] = *(const f32x4*)(gp + bj * HALF + n * 16);
#pragma unroll
        for (int ai = 0; ai < 2; ++ai)
#pragma unroll
            for (int m = 0; m < 4; ++m) { float* rowp = XL + (size_t)(row0 + ai * HALF + m * 16) * DM + col0;
#pragma unroll
                for (int bj = 0; bj < 2; ++bj)
#pragma unroll
                    for (int n = 0; n < 2; ++n) { const f32x4 x = *(const f32x4*)(rowp + bj * HALF + n * 16); *(f32x4*)(rowp + bj * HALF + n * 16) = x + gv[bj][n] * acc[ai][bj][m][n]; } }
    }
};
struct EpiMoe1 {
    static constexpr bool PERM = true;
    bf16_t* ACT;
    __device__ __forceinline__ void operator()(const f32x4 (&acc)[2][2][4][2], const Unit& u, int wr, int wc, int fr, int fq) const {
        const int row0 = u.pm * BM + wr * 64 + fr, col0 = u.pn * HALF + wc * 32 + 8 * fq;
#pragma unroll
        for (int ai = 0; ai < 2; ++ai)
#pragma unroll
            for (int m = 0; m < 4; ++m) { bf16_t* rowp = ACT + (size_t)(row0 + ai * HALF + m * 16) * DM + col0;
                const f32x4 a0 = acc[ai][0][m][0], a1 = acc[ai][0][m][1], b0 = acc[ai][1][m][0], b1 = acc[ai][1][m][1];
                u32x4 w; w.x = pk2(siluf_(a0[0]) * b0[0], siluf_(a0[1]) * b0[1]); w.y = pk2(siluf_(a0[2]) * b0[2], siluf_(a0[3]) * b0[3]);
                w.z = pk2(siluf_(a1[0]) * b1[0], siluf_(a1[1]) * b1[1]); w.w = pk2(siluf_(a1[2]) * b1[2], siluf_(a1[3]) * b1[3]);
                *(u32x4*)rowp = w; }
    }
};
struct EpiMoe2 {
    static constexpr bool PERM = true;
    bf16_t* YS; const int* RL; const unsigned* cnt;
    __device__ __forceinline__ void operator()(const f32x4 (&acc)[2][2][4][2], const Unit& u, int wr, int wc, int fr, int fq) const {
        const int e = u.aux >> 16, jb = u.aux & 0xffff; const int n_e = __builtin_amdgcn_readfirstlane((int)cnt[e * 64]);
        const int col0 = u.pn * BM + wc * 32 + 8 * fq;
#pragma unroll
        for (int ai = 0; ai < 2; ++ai)
#pragma unroll
            for (int m = 0; m < 4; ++m) { const int rank = jb * BM + ai * HALF + wr * 64 + m * 16 + fr;
                if (rank < n_e) { const int slot = RL[(size_t)e * RLCAP + rank]; bf16_t* rowp = YS + (size_t)slot * DM + col0;
#pragma unroll
                    for (int bj = 0; bj < 2; ++bj) { const f32x4 v0 = acc[ai][bj][m][0], v1 = acc[ai][bj][m][1];
                        u32x4 w; w.x = pk2(v0[0], v0[1]); w.y = pk2(v0[2], v0[3]); w.z = pk2(v1[0], v1[1]); w.w = pk2(v1[2], v1[3]);
                        *(u32x4*)(rowp + bj * HALF) = w; } } }
    }
};
}

#define XB_TMO      128
#define XB_XCNT(j)  (256  + 64 * (j))
#define XB_XSUB(j)  (1280 + 64 * (j))
#define XB_XGEN(j)  (2304 + 64 * (j))
#define XB_TOP      3328
#define XB_TOPGEN   3392
#define XCD_BAR_WORDS 3456
#define XB_SPIN_CAP (1u << 18)
__device__ __forceinline__ unsigned xb_ld(unsigned* p)              { return __hip_atomic_load(p, __ATOMIC_RELAXED, __HIP_MEMORY_SCOPE_AGENT); }
__device__ __forceinline__ unsigned xb_add(unsigned* p, unsigned v) { return __hip_atomic_fetch_add(p, v, __ATOMIC_RELAXED, __HIP_MEMORY_SCOPE_AGENT); }
__device__ __forceinline__ unsigned xb_xcc_id() { return (unsigned)__builtin_amdgcn_s_getreg((3 << 11) | 20) & 0xFu; }
#define XB_SPIN(cond, bar) do { unsigned _sp = 0; while (cond) { __builtin_amdgcn_s_sleep(1); \
    if ((++_sp & 255u) == 0u) { if (xb_ld(&(bar)[XB_TMO])) break; if (_sp > XB_SPIN_CAP) { atomicAdd(&(bar)[XB_TMO], 1u); break; } } } } while (0)
struct XcdBarrier { unsigned* bar; unsigned x; volatile LAS unsigned* st; };
__device__ __forceinline__ XcdBarrier xcd_barrier_post(unsigned* bar, volatile LAS unsigned* st) {
    XcdBarrier b; b.bar = bar; b.x = xb_xcc_id(); b.st = st;
    if (threadIdx.x == 0) (void)xb_add(&bar[XB_XCNT(b.x)], 1u);
    return b;
}
__device__ __forceinline__ void xcd_barrier_complete(unsigned* bar, unsigned x, unsigned& nloc, unsigned& nx) {
    const unsigned G = gridDim.x * gridDim.y * gridDim.z;
    unsigned sum, cnt, mine, sp = 0u;
    for (;;) {
        sum = 0u; cnt = 0u; mine = 0u;
#pragma unroll
        for (unsigned j = 0; j < 16; ++j) { const unsigned c = xb_ld(&bar[XB_XCNT(j)]); sum += c; cnt += (c > 0u) ? 1u : 0u; mine = (j == x) ? c : mine; }
        if (sum == G) break;
        __builtin_amdgcn_s_sleep(1);
        if ((++sp & 255u) == 0u) { if (xb_ld(&bar[XB_TMO])) break; if (sp > XB_SPIN_CAP) { atomicAdd(&bar[XB_TMO], 1u); break; } }
    }
    nloc = mine > 0u ? mine : 1u; nx = cnt > 0u ? cnt : 1u;
}
__device__ __forceinline__ void xcd_barrier(const XcdBarrier& b) {
    asm volatile("s_waitcnt vmcnt(0)" ::: "memory");
    __syncthreads();
    if (threadIdx.x == 0) {
        unsigned* bar = b.bar;
        __builtin_amdgcn_s_waitcnt(0);
        unsigned nloc = b.st[0], nx = b.st[1];
        if (nloc == 0u) { xcd_barrier_complete(bar, b.x, nloc, nx); b.st[0] = nloc; b.st[1] = nx; }
        const unsigned old = xb_add(&bar[XB_XSUB(b.x)], 1u);
        const unsigned gen = old / nloc;
        if (old + 1u == (gen + 1u) * nloc) {
            __builtin_amdgcn_fence(__ATOMIC_RELEASE, "agent");
            asm volatile("s_waitcnt vmcnt(0)" ::: "memory");
            const unsigned og = xb_add(&bar[XB_TOP], 1u);
            const unsigned tg = og / nx;
            if (og + 1u == (tg + 1u) * nx) xb_add(&bar[XB_TOPGEN], 1u);
            else XB_SPIN(xb_ld(&bar[XB_TOPGEN]) == tg, bar);
            __builtin_amdgcn_fence(__ATOMIC_ACQUIRE, "agent");
            xb_add(&bar[XB_XGEN(b.x)], 1u);
            asm volatile("s_waitcnt vmcnt(0)" ::: "memory");
        } else {
            XB_SPIN(xb_ld(&bar[XB_XGEN(b.x)]) == gen, bar);
            __builtin_amdgcn_fence(__ATOMIC_ACQUIRE, "agent");
            asm volatile("s_waitcnt vmcnt(0)" ::: "memory");
        }
    }
    __syncthreads();
}

struct Args { const float* in[30]; float* out; unsigned char* ws; int ph_lo, ph_hi; };
typedef const __attribute__((address_space(4))) Args* ArgP;
enum { I_X = 0, I_C, I_CTX, I_CCTX, I_LBLOG, I_RW, I_RB, I_FINALG, I_WMOD, I_BMOD, I_GMIX, I_GFFN, I_WIN, I_CONVW, I_CONVB, I_CLNG, I_CLNB, I_HGNG,
       I_GLW2, I_GLB2, I_GLNG, I_SINK, I_WBRC, I_WBRH, I_WBRG, I_WBRA, I_WOUT, I_W1, I_W3, I_W2 };

__device__ __forceinline__ int row_cond(int row) { const int b = row / RB, j = row - b * RB; return j < CTXL ? 2 : b; }

__device__ __forceinline__ void transpose_item(const float* W, int N, bf16* WT, int ldt, int koff, int mode, LAS float* scr, int kb, int nb, int lane) {
    const int k0 = 64 * kb, n0 = 32 * nb;
#pragma unroll 8
    for (int i = 0; i < 32; ++i) { const int kk = 2 * i + (lane >> 5); scr[kk * 33 + (lane & 31)] = W[(size_t)(k0 + kk) * N + n0 + (lane & 31)]; }
    asm volatile("s_waitcnt lgkmcnt(0)" ::: "memory");
    const int c = lane & 7;
    const int nd0 = (mode == 0) ? n0 : ((n0 >> 7) * 256 + (mode == 2 ? 128 : 0) + (n0 & 127));
#pragma unroll
    for (int j = 0; j < 4; ++j) { const int n = (lane >> 3) + 8 * j; const LAS float* s = scr + (8 * c) * 33 + n;
        u32x4 o; o.x = pk2(s[0 * 33], s[1 * 33]); o.y = pk2(s[2 * 33], s[3 * 33]); o.z = pk2(s[4 * 33], s[5 * 33]); o.w = pk2(s[6 * 33], s[7 * 33]);
        *(u32x4*)(WT + (size_t)(nd0 + n) * ldt + koff + k0 + 8 * c) = o; }
    asm volatile("s_waitcnt lgkmcnt(0)" ::: "memory");
}
__device__ __forceinline__ void convert_weights(ArgP ap, int l, LAS unsigned char* lds, int gw, int NGW, int wave, int lane) {
    LAS float* scr = (LAS float*)(lds + wave * 16384);
    unsigned char* ws = ap->ws;
    bf16* WIN = (bf16*)(ws + WS_WIN); bf16* WBR = (bf16*)(ws + WS_WBR); bf16* WOUT = (bf16*)(ws + WS_WOUT); bf16* W13 = (bf16*)(ws + WS_W13); bf16* W2 = (bf16*)(ws + WS_W2);
    constexpr int I_IN = 16 * 225, I_BR = 4 * 32, I_O = 16 * 32, I_E = 16 * 32;
    constexpr int NITEMS = I_IN + 4 * I_BR + I_O + 48 * I_E;
    for (int it = gw; it < NITEMS; it += NGW) {
        int r = it;
        if (r < I_IN) { transpose_item(ap->in[I_WIN] + (size_t)l * DM * W_IN_COLS, W_IN_COLS, WIN, DM, 0, 0, scr, r / 225, r % 225, lane); continue; } r -= I_IN;
        if (r < 4 * I_BR) { const int br = r / I_BR, q = r % I_BR; transpose_item(ap->in[I_WBRC + br] + (size_t)l * 256 * DM, DM, WBR, DM, 256 * br, 0, scr, q / 32, q % 32, lane); continue; } r -= 4 * I_BR;
        if (r < I_O) { transpose_item(ap->in[I_WOUT] + (size_t)l * DM * DM, DM, WOUT, DM, 0, 0, scr, r / 32, r % 32, lane); continue; } r -= I_O;
        const int mat = r / I_E, q = r % I_E;
        const int e = mat / 3, wh = mat % 3;
        const size_t eoff = ((size_t)l * NEXP + e) * DM * DM;
        if (wh == 0) transpose_item(ap->in[I_W1] + eoff, DM, W13 + (size_t)e * 2048 * DM, DM, 0, 1, scr, q / 32, q % 32, lane);
        else if (wh == 1) transpose_item(ap->in[I_W3] + eoff, DM, W13 + (size_t)e * 2048 * DM, DM, 0, 2, scr, q / 32, q % 32, lane);
        else transpose_item(ap->in[I_W2] + eoff, DM, W2 + (size_t)e * DM * DM, DM, 0, 0, scr, q / 32, q % 32, lane);
    }
    for (int rr = gw; rr < LDP - W_IN_COLS; rr += NGW) { u32x4* p = (u32x4*)(WIN + (size_t)(W_IN_COLS + rr) * DM);
        p[lane] = (u32x4){0u, 0u, 0u, 0u}; p[lane + 64] = (u32x4){0u, 0u, 0u, 0u}; }
}

__device__ __forceinline__ void modnorm_store(const f32x4 (&v)[4], const float* g, const float* shift, const float* scale, bf16* orow, int lane) {
    float ss = 0.f;
#pragma unroll
    for (int j = 0; j < 4; ++j) ss += (v[j].x * v[j].x + v[j].y * v[j].y) + (v[j].z * v[j].z + v[j].w * v[j].w);
    const float rstd = rsqrtf(wave_sum(ss) * (1.f / DM) + EPS);
#pragma unroll
    for (int j = 0; j < 4; ++j) { const int c = 4 * lane + 256 * j;
        const f32x4 gg = *(const f32x4*)(g + c), sh = *(const f32x4*)(shift + c), sc = *(const f32x4*)(scale + c);
        const f32x4 y = (v[j] * rstd) * gg * (sc + 1.0f) + sh;
        u32x2 w; w.x = pk2(y.x, y.y); w.y = pk2(y.z, y.w); *(u32x2*)(orow + c) = w; }
}

__device__ __forceinline__ void attn_unit(const bf16* P, bf16* Y, const float* COS, const float* SIN, const float* sinkp, int b, int kvh, int qblk, bool ctxq, LAS unsigned char* lds, int tid, int wave, int lane) {
    LAS bf16* KS = (LAS bf16*)lds;
    LAS bf16* VT = (LAS bf16*)(lds + 64 * 72 * 2);
    const int fr = lane & 15, fq = lane >> 4;
    const int hq = kvh * 2 + (wave >> 2);
    const int t0 = qblk * 128, tq0 = t0 + (wave & 3) * 32;
    const size_t rowbase = (size_t)b * RB + (ctxq ? 0 : CTXL);
    bf16x8 qf[2][2];
#pragma unroll
    for (int qt = 0; qt < 2; ++qt)
#pragma unroll
        for (int ks = 0; ks < 2; ++ks) {
            const int tq = tq0 + 16 * qt + fr, dch = 4 * ks + fq;
            const bf16* qp = P + (rowbase + tq) * LDP + C_ATQ + hq * 64;
            const u32x4 own = *(const u32x4*)(qp + 8 * dch), oth = *(const u32x4*)(qp + 8 * (dch ^ 2));
            float o[8], p[8], r[8];
            o[0] = bflo(own.x); o[1] = bfhi(own.x); o[2] = bflo(own.y); o[3] = bfhi(own.y); o[4] = bflo(own.z); o[5] = bfhi(own.z); o[6] = bflo(own.w); o[7] = bfhi(own.w);
            p[0] = bflo(oth.x); p[1] = bfhi(oth.x); p[2] = bflo(oth.y); p[3] = bfhi(oth.y); p[4] = bflo(oth.z); p[5] = bfhi(oth.z); p[6] = bflo(oth.w); p[7] = bfhi(oth.w);
            if (!ctxq) {
                const int ci = tq * 32 + (dch >> 2) * 16 + (dch & 1) * 8;
#pragma unroll
                for (int j = 0; j < 8; ++j) { const float c = COS[ci + j], s = SIN[ci + j]; r[j] = (dch & 2) ? (p[j] * s + o[j] * c) : (o[j] * c - p[j] * s); }
            } else {
#pragma unroll
                for (int j = 0; j < 8; ++j) r[j] = o[j];
            }
            u32x4 w; w.x = pk2(r[0] * 0.125f, r[1] * 0.125f); w.y = pk2(r[2] * 0.125f, r[3] * 0.125f); w.z = pk2(r[4] * 0.125f, r[5] * 0.125f); w.w = pk2(r[6] * 0.125f, r[7] * 0.125f);
            qf[qt][ks] = __builtin_bit_cast(bf16x8, w);
        }
    f32x4 ot[4][2];
#pragma unroll
    for (int dt = 0; dt < 4; ++dt)
#pragma unroll
        for (int qt = 0; qt < 2; ++qt) ot[dt][qt] = (f32x4){0.f, 0.f, 0.f, 0.f};
    float mrun[2] = {-1e30f, -1e30f}, lrun[2] = {0.f, 0.f};
    const int ntile = ctxq ? 4 : 10;
    for (int ti = 0; ti < ntile; ++ti) {
        const bool band = (!ctxq) && ti < 6;
        const int s0 = band ? (t0 - 128 + 64 * ti) : 64 * (ctxq ? ti : ti - 6);
        if (band && (s0 < 0 || s0 >= SEQ)) continue;
        __syncthreads();
        {
            const int key = tid >> 3, dch = tid & 7;
            const bf16* kp = P + ((size_t)b * RB + (band ? CTXL : 0) + s0 + key) * LDP;
            const u32x4 own = *(const u32x4*)(kp + C_ATK + kvh * 64 + 8 * dch);
            u32x4 kw = own;
            if (band) {
                const u32x4 oth = *(const u32x4*)(kp + C_ATK + kvh * 64 + 8 * (dch ^ 2));
                float o[8], p[8], r[8];
                o[0] = bflo(own.x); o[1] = bfhi(own.x); o[2] = bflo(own.y); o[3] = bfhi(own.y); o[4] = bflo(own.z); o[5] = bfhi(own.z); o[6] = bflo(own.w); o[7] = bfhi(own.w);
                p[0] = bflo(oth.x); p[1] = bfhi(oth.x); p[2] = bflo(oth.y); p[3] = bfhi(oth.y); p[4] = bflo(oth.z); p[5] = bfhi(oth.z); p[6] = bflo(oth.w); p[7] = bfhi(oth.w);
                const int ci = (s0 + key) * 32 + (dch >> 2) * 16 + (dch & 1) * 8;
#pragma unroll
                for (int j = 0; j < 8; ++j) { const float c = COS[ci + j], s = SIN[ci + j]; r[j] = (dch & 2) ? (p[j] * s + o[j] * c) : (o[j] * c - p[j] * s); }
                kw.x = pk2(r[0], r[1]); kw.y = pk2(r[2], r[3]); kw.z = pk2(r[4], r[5]); kw.w = pk2(r[6], r[7]);
            }
            *(LAS u32x4*)(KS + key * 72 + 8 * dch) = kw;
            const u32x4 vw = *(const u32x4*)(kp + C_ATV + kvh * 64 + 8 * dch);
            LAS bf16* vp = VT + (8 * dch) * 72 + key;
            vp[0 * 72] = (bf16)(vw.x & 0xffffu); vp[1 * 72] = (bf16)(vw.x >> 16); vp[2 * 72] = (bf16)(vw.y & 0xffffu); vp[3 * 72] = (bf16)(vw.y >> 16);
            vp[4 * 72] = (bf16)(vw.z & 0xffffu); vp[5 * 72] = (bf16)(vw.z >> 16); vp[6 * 72] = (bf16)(vw.w & 0xffffu); vp[7 * 72] = (bf16)(vw.w >> 16);
        }
        __syncthreads();
        f32x4 st[4][2];
#pragma unroll
        for (int kt = 0; kt < 4; ++kt) {
            const bf16x8 ka0 = *(const LAS bf16x8*)(KS + (16 * kt + fr) * 72 + 8 * fq), ka1 = *(const LAS bf16x8*)(KS + (16 * kt + fr) * 72 + 32 + 8 * fq);
#pragma unroll
            for (int qt = 0; qt < 2; ++qt) { f32x4 c = (f32x4){0.f, 0.f, 0.f, 0.f};
                c = __builtin_amdgcn_mfma_f32_16x16x32_bf16(ka0, qf[qt][0], c, 0, 0, 0);
                c = __builtin_amdgcn_mfma_f32_16x16x32_bf16(ka1, qf[qt][1], c, 0, 0, 0);
                st[kt][qt] = c; }
        }
#pragma unroll
        for (int qt = 0; qt < 2; ++qt) {
            const int tq = tq0 + 16 * qt + fr;
            float mx = -1e30f;
#pragma unroll
            for (int kt = 0; kt < 4; ++kt)
#pragma unroll
                for (int j = 0; j < 4; ++j) { const int s = s0 + 16 * kt + 4 * fq + j; const int dd = tq - s; const bool ok = (!band) || (dd <= 128 && dd >= -128);
                    st[kt][qt][j] = ok ? st[kt][qt][j] : -1e30f; mx = fmaxf(mx, st[kt][qt][j]); }
            mx = fmaxf(mx, __shfl_xor(mx, 16)); mx = fmaxf(mx, __shfl_xor(mx, 32));
            const float mnew = fmaxf(mrun[qt], mx), alpha = __expf(mrun[qt] - mnew);
            mrun[qt] = mnew;
            float ps = 0.f;
#pragma unroll
            for (int kt = 0; kt < 4; ++kt)
#pragma unroll
                for (int j = 0; j < 4; ++j) { const float sv = st[kt][qt][j]; const float pv = (sv > -1e29f) ? __expf(sv - mnew) : 0.f; st[kt][qt][j] = pv; ps += pv; }
            lrun[qt] = lrun[qt] * alpha + ps;
#pragma unroll
            for (int dt = 0; dt < 4; ++dt) ot[dt][qt] = ot[dt][qt] * alpha;
        }
#pragma unroll
        for (int kk = 0; kk < 2; ++kk) {
            bf16x8 pb[2];
#pragma unroll
            for (int qt = 0; qt < 2; ++qt) { u32x4 w; w.x = pk2(st[2 * kk][qt][0], st[2 * kk][qt][1]); w.y = pk2(st[2 * kk][qt][2], st[2 * kk][qt][3]);
                w.z = pk2(st[2 * kk + 1][qt][0], st[2 * kk + 1][qt][1]); w.w = pk2(st[2 * kk + 1][qt][2], st[2 * kk + 1][qt][3]); pb[qt] = __builtin_bit_cast(bf16x8, w); }
#pragma unroll
            for (int dt = 0; dt < 4; ++dt) {
                const u32x2 v0 = *(const LAS u32x2*)(VT + (16 * dt + fr) * 72 + 32 * kk + 4 * fq), v1 = *(const LAS u32x2*)(VT + (16 * dt + fr) * 72 + 32 * kk + 16 + 4 * fq);
                u32x4 vw; vw.x = v0.x; vw.y = v0.y; vw.z = v1.x; vw.w = v1.y; const bf16x8 va = __builtin_bit_cast(bf16x8, vw);
#pragma unroll
                for (int qt = 0; qt < 2; ++qt) ot[dt][qt] = __builtin_amdgcn_mfma_f32_16x16x32_bf16(va, pb[qt], ot[dt][qt], 0, 0, 0);
            }
        }
    }
    const float sk = sinkp[hq];
#pragma unroll
    for (int qt = 0; qt < 2; ++qt) {
        float l = lrun[qt]; l += __shfl_xor(l, 16); l += __shfl_xor(l, 32);
        const float mf = fmaxf(mrun[qt], sk); const float a = __expf(mrun[qt] - mf); const float denom = l * a + __expf(sk - mf); const float sc = a / denom;
        const int tq = tq0 + 16 * qt + fr;
        bf16* yp = Y + (rowbase + tq) * DM + 768 + hq * 64 + 4 * fq;
#pragma unroll
        for (int dt = 0; dt < 4; ++dt) { const f32x4 o = ot[dt][qt] * sc; u32x2 w; w.x = pk2(o.x, o.y); w.y = pk2(o.z, o.w); *(u32x2*)(yp + 16 * dt) = w; }
    }
}

__device__ __forceinline__ void conv_unit(const bf16* P, bf16* Y, const float* cw, const float* cb, const float* lng, const float* lnb, int cu, LAS unsigned char* lds, int tid, int wave, int lane) {
    LAS float* Z = (LAS float*)lds;
    LAS float* CO = (LAS float*)(lds + 62 * 256 * 4);
    const int row0 = cu * 32; const int b = row0 / RB, j0 = row0 - b * RB;
    const int seg0 = b * RB + (j0 < CTXL ? 0 : CTXL), seg1 = b * RB + (j0 < CTXL ? CTXL : RB);
    __syncthreads();
    for (int idx = tid; idx < 62 * 256; idx += NTHREADS) { const int tt = idx >> 8, c = idx & 255; const int row = row0 - 15 + tt; float z = 0.f;
        if (row >= seg0 && row < seg1) { const float av = bf2f(P[(size_t)row * LDP + C_CONV + c]), bv = bf2f(P[(size_t)row * LDP + C_CONV + 256 + c]); z = av * sigmoidf_(bv); }
        Z[idx] = z; }
    __syncthreads();
    { const int c = tid & 255, hf = tid >> 8; float w[31];
#pragma unroll
      for (int j = 0; j < 31; ++j) w[j] = cw[j * 256 + c];
      const float bias = cb[c];
#pragma unroll 1
      for (int t = hf * 16; t < hf * 16 + 16; ++t) { float s = bias;
#pragma unroll
          for (int j = 0; j < 31; ++j) s += Z[(t + j) * 256 + c] * w[j];
          CO[t * 256 + c] = s; } }
    __syncthreads();
#pragma unroll
    for (int q = 0; q < 4; ++q) { const int t = wave * 4 + q; const f32x4 x = *(const LAS f32x4*)(CO + t * 256 + 4 * lane);
        const float mu = wave_sum((x.x + x.y) + (x.z + x.w)) * (1.f / 256.f); const f32x4 d = x - mu;
        const float var = wave_sum((d.x * d.x + d.y * d.y) + (d.z * d.z + d.w * d.w)) * (1.f / 256.f); const float rstd = rsqrtf(var + EPS);
        const f32x4 g = *(const f32x4*)(lng + 4 * lane), bb = *(const f32x4*)(lnb + 4 * lane); const f32x4 zn = d * rstd * g + bb;
        u32x2 w; w.x = pk2(siluf_(zn.x), siluf_(zn.y)); w.y = pk2(siluf_(zn.z), siluf_(zn.w));
        *(u32x2*)(Y + (size_t)(row0 + t) * DM + 4 * lane) = w; }
}

typedef short bf16x4 __attribute__((ext_vector_type(4)));
constexpr int SC_LD = 72;
constexpr int SC_DIRB = 4 * 64 * SC_LD * 2 + 4 * 64 * 4;
template <bool HG>
__device__ __forceinline__ void scan_mfma(ArgP ap, int l, int passB, int b, int h, int blk, LAS unsigned char* lds, int tid, int wave, int lane) {
    constexpr int DK = HG ? 64 : 32, NM = DK / 16, NKS = DK / 32;
    unsigned char* ws = ap->ws;
    const bf16* P = (const bf16*)(ws + WS_P); bf16* Y = (bf16*)(ws + WS_Y);
    float* SEGS = (float*)(ws + (HG ? WS_SEGH : WS_SEGG)); float* SEGD = (float*)(ws + (HG ? WS_SEGDH : WS_SEGDG));
    const int dir = wave >> 2, slab = wave & 3, htid = tid & 255, fr = lane & 15, fq = lane >> 4;
    LAS unsigned char* dbase = lds + dir * SC_DIRB;
    LAS bf16* QT = (LAS bf16*)dbase; LAS bf16* KH = QT + 64 * SC_LD; LAS bf16* KBT = KH + 64 * SC_LD; LAS bf16* VT = KBT + 64 * SC_LD; LAS float* EB = (LAS float*)(VT + 64 * SC_LD);
    LAS bf16* OS = (LAS bf16*)(lds + 2 * SC_DIRB);
    const size_t row0 = (size_t)b * RB + blk * 256;
    const int ch = (b * 2 + dir) * 4 + h;
    f32x4 S[NM];
#pragma unroll
    for (int m = 0; m < NM; ++m) S[m] = (f32x4){0.f, 0.f, 0.f, 0.f};
    __syncthreads();
    if (passB) {
        const int npre = (dir == 0) ? blk : (blk == 0 ? 0 : (1 + (NBLK - 1 - blk)));
        for (int q = 0; q < npre; ++q) { const int i = (dir == 0) ? q : (q == 0 ? 0 : (NBLK - q));
            const float* sp = SEGS + ((size_t)(ch * NBLK + i) * DK + 4 * fq) * 64 + 16 * slab + fr; const float* dp = SEGD + (size_t)(ch * NBLK + i) * DK + 4 * fq;
#pragma unroll
            for (int m = 0; m < NM; ++m) { const f32x4 d = *(const f32x4*)(dp + 16 * m);
#pragma unroll
                for (int j = 0; j < 4; ++j) S[m][j] = d[j] * S[m][j] + sp[(16 * m + j) * 64]; } }
        for (int i = tid; i < 256 * 64 / 2; i += NTHREADS) ((LAS unsigned*)OS)[i] = 0u;
    }
    float Dk = 1.f;
    const int pc = htid >> 6, pk = htid & 63;
    for (int gi = 0; gi < 4; ++gi) {
        const int T0 = 64 * (dir ? 3 - gi : gi);
        __syncthreads();
        if (pk < DK) {
            float f[16], qv[16], kv[16];
            const bf16* pr = P + (row0 + T0 + 16 * pc) * LDP;
            if (HG) {
                const float lbv = ((const float*)(ws + WS_LB))[l * 512 + dir * 256 + h * 64 + pk];
                const int cz = (dir ? C_HGFB : C_HGFF) + h * 64 + pk, cq = C_HGQ + h * 64 + pk;
#pragma unroll
                for (int j = 0; j < 16; ++j) { const float z = bf2f(pr[(size_t)j * LDP + cz]); qv[j] = bf2f(pr[(size_t)j * LDP + cq]); const float sg = sigmoidf_(z);
                    f[j] = fmaxf(lbv + (1.f - lbv) * sg, 1e-30f); kv[j] = (1.f - lbv) * (1.f - sg); }
            } else {
                const float* w2 = ap->in[I_GLW2] + (size_t)(l * 2 + dir) * 16 * 128 + h * 32 + pk; const float b2 = ap->in[I_GLB2][(l * 2 + dir) * 128 + h * 32 + pk];
                float w2r[16];
#pragma unroll
                for (int r = 0; r < 16; ++r) w2r[r] = w2[r * 128];
                const int ca = dir ? C_GLAB : C_GLAF, ck = C_GLK + h * 32 + pk, cq = C_GLQ + h * 32 + pk;
#pragma unroll
                for (int j = 0; j < 16; ++j) { const u32x4 a0 = *(const u32x4*)(pr + (size_t)j * LDP + ca), a1 = *(const u32x4*)(pr + (size_t)j * LDP + ca + 8);
                    float u = b2;
                    u += bflo(a0.x) * w2r[0] + bfhi(a0.x) * w2r[1] + bflo(a0.y) * w2r[2] + bfhi(a0.y) * w2r[3] + bflo(a0.z) * w2r[4] + bfhi(a0.z) * w2r[5] + bflo(a0.w) * w2r[6] + bfhi(a0.w) * w2r[7];
                    u += bflo(a1.x) * w2r[8] + bfhi(a1.x) * w2r[9] + bflo(a1.y) * w2r[10] + bfhi(a1.y) * w2r[11] + bflo(a1.z) * w2r[12] + bfhi(a1.z) * w2r[13] + bflo(a1.w) * w2r[14] + bfhi(a1.w) * w2r[15];
                    const float ls = fminf(u, 0.f) - __logf(1.f + __expf(-fabsf(u)));
                    f[j] = __expf(ls * (1.f / 16.f)); kv[j] = bf2f(pr[(size_t)j * LDP + ck]); qv[j] = bf2f(pr[(size_t)j * LDP + cq]) * 0.17677669529663687f; }
            }
            float pj[16], sf[16];
            if (dir == 0) { float p = 1.f;
#pragma unroll
                for (int j = 0; j < 16; ++j) { p *= f[j]; pj[j] = p; }
                float s = 1.f;
#pragma unroll
                for (int j = 15; j >= 0; --j) { sf[j] = s; s *= f[j]; }
            } else { float p = 1.f;
#pragma unroll
                for (int j = 15; j >= 0; --j) { p *= f[j]; pj[j] = p; }
                float s = 1.f;
#pragma unroll
                for (int j = 0; j < 16; ++j) { sf[j] = s; s *= f[j]; }
            }
            EB[pc * 64 + pk] = dir ? pj[0] : pj[15];
#pragma unroll
            for (int j = 0; j < 16; ++j) { const int t = 16 * pc + j;
                QT[t * SC_LD + pk] = (bf16)(pk2(qv[j] * pj[j], 0.f) & 0xffffu);
                KH[t * SC_LD + pk] = (bf16)(pk2(kv[j] * __builtin_amdgcn_rcpf(fmaxf(pj[j], 1e-30f)), 0.f) & 0xffffu); }
#pragma unroll
            for (int j = 0; j < 16; j += 2) *(LAS unsigned*)(KBT + pk * SC_LD + 16 * pc + j) = pk2(kv[j] * sf[j], kv[j + 1] * sf[j + 1]);
        }
        {
            const int t = htid >> 2, vc = htid & 3;
            const bf16* vp = P + (row0 + T0 + t) * LDP + (HG ? C_HGI : C_GLV) + h * 64 + 16 * vc;
            const u32x4 v0 = *(const u32x4*)vp, v1 = *(const u32x4*)(vp + 8);
            LAS bf16* d = VT + (16 * vc) * SC_LD + t;
            d[0 * SC_LD] = (bf16)(v0.x & 0xffffu); d[1 * SC_LD] = (bf16)(v0.x >> 16); d[2 * SC_LD] = (bf16)(v0.y & 0xffffu); d[3 * SC_LD] = (bf16)(v0.y >> 16);
            d[4 * SC_LD] = (bf16)(v0.z & 0xffffu); d[5 * SC_LD] = (bf16)(v0.z >> 16); d[6 * SC_LD] = (bf16)(v0.w & 0xffffu); d[7 * SC_LD] = (bf16)(v0.w >> 16);
            d[8 * SC_LD] = (bf16)(v1.x & 0xffffu); d[9 * SC_LD] = (bf16)(v1.x >> 16); d[10 * SC_LD] = (bf16)(v1.y & 0xffffu); d[11 * SC_LD] = (bf16)(v1.y >> 16);
            d[12 * SC_LD] = (bf16)(v1.z & 0xffffu); d[13 * SC_LD] = (bf16)(v1.z >> 16); d[14 * SC_LD] = (bf16)(v1.w & 0xffffu); d[15 * SC_LD] = (bf16)(v1.w >> 16);
        }
        __syncthreads();
        if (!passB && htid < DK) Dk *= (EB[htid] * EB[64 + htid]) * (EB[128 + htid] * EB[192 + htid]);
        for (int ci = 0; ci < 4; ++ci) {
            const int c = dir ? 3 - ci : ci;
            const bf16x4 vb = *(const LAS bf16x4*)(VT + (16 * slab + fr) * SC_LD + 16 * c + 4 * fq);
            if (passB) {
                f32x4 at = (f32x4){0.f, 0.f, 0.f, 0.f};
                bf16x8 qa[NKS];
#pragma unroll
                for (int ks = 0; ks < NKS; ++ks) {
                    const LAS bf16* qp = QT + (16 * c + fr) * SC_LD + 32 * ks + 4 * fq; const LAS bf16* kp = KH + (16 * c + fr) * SC_LD + 32 * ks + 4 * fq;
                    const u32x2 q0 = *(const LAS u32x2*)qp, q1 = *(const LAS u32x2*)(qp + 16), k0 = *(const LAS u32x2*)kp, k1 = *(const LAS u32x2*)(kp + 16);
                    u32x4 qw; qw.x = q0.x; qw.y = q0.y; qw.z = q1.x; qw.w = q1.y; u32x4 kw; kw.x = k0.x; kw.y = k0.y; kw.z = k1.x; kw.w = k1.y;
                    qa[ks] = __builtin_bit_cast(bf16x8, qw);
                    at = __builtin_amdgcn_mfma_f32_16x16x32_bf16(__builtin_bit_cast(bf16x8, kw), qa[ks], at, 0, 0, 0);
                }
                asm volatile("s_nop 15\n\ts_nop 15" : "+v"(at));
#pragma unroll
                for (int j = 0; j < 4; ++j) { const int sidx = 4 * fq + j; const bool keep = dir ? (sidx >= fr) : (sidx <= fr); at[j] = keep ? at[j] : 0.f; }
                u32x2 pw; pw.x = pk2(at[0], at[1]); pw.y = pk2(at[2], at[3]);
                f32x4 o = __builtin_amdgcn_mfma_f32_16x16x16bf16_1k(__builtin_bit_cast(bf16x4, pw), vb, (f32x4){0.f, 0.f, 0.f, 0.f}, 0, 0, 0);
                asm volatile("s_nop 15\n\ts_nop 15" : "+v"(o));
#pragma unroll
                for (int ks = 0; ks < NKS; ++ks) { u32x4 sw; sw.x = pk2(S[2 * ks][0], S[2 * ks][1]); sw.y = pk2(S[2 * ks][2], S[2 * ks][3]); sw.z = pk2(S[2 * ks + 1][0], S[2 * ks + 1][1]); sw.w = pk2(S[2 * ks + 1][2], S[2 * ks + 1][3]);
                    o = __builtin_amdgcn_mfma_f32_16x16x32_bf16(qa[ks], __builtin_bit_cast(bf16x8, sw), o, 0, 0, 0); }
                asm volatile("s_nop 15\n\ts_nop 15" : "+v"(o));
                LAS bf16* op = OS + (T0 + 16 * c + 4 * fq) * 64 + 16 * slab + fr;
#pragma unroll
                for (int j = 0; j < 4; ++j) op[j * 64] = (bf16)(pk2(bf2f(op[j * 64]) + o[j], 0.f) & 0xffffu);
            }
#pragma unroll
            for (int m = 0; m < NM; ++m) { const f32x4 eb = *(const LAS f32x4*)(EB + c * 64 + 16 * m + 4 * fq);
                const bf16x4 kb = *(const LAS bf16x4*)(KBT + (16 * m + fr) * SC_LD + 16 * c + 4 * fq);
                S[m] = __builtin_amdgcn_mfma_f32_16x16x16bf16_1k(kb, vb, S[m] * eb, 0, 0, 0); asm volatile("s_nop 15\n\ts_nop 15" : "+v"(S[m])); }
        }
    }
    if (!passB) {
        float* sp = SEGS + ((size_t)(ch * NBLK + blk) * DK + 4 * fq) * 64 + 16 * slab + fr;
#pragma unroll
        for (int m = 0; m < NM; ++m)
#pragma unroll
            for (int j = 0; j < 4; ++j) sp[(16 * m + j) * 64] = S[m][j];
        if (htid < DK) SEGD[(size_t)(ch * NBLK + blk) * DK + htid] = Dk;
    } else {
        __syncthreads();
        const float* ng = ap->in[HG ? I_HGNG : I_GLNG] + l * 256 + h * 64; const int gcol = (HG ? C_HGG : C_GLG) + h * 64, ycol = (HG ? 256 : 512) + h * 64;
        const float gn = ng[lane];
        for (int q = 0; q < 32; ++q) { const int tok = wave * 32 + q; const float o = bf2f(OS[tok * 64 + lane]);
            const float ss = wave_sum(o * o); const float gt = bf2f(P[(row0 + tok) * LDP + gcol + lane]);
            const float y = o * rsqrtf(ss * (1.f / 64.f) + EPS) * gn * siluf_(gt);
            Y[(row0 + tok) * DM + ycol + lane] = (bf16)(pk2(y, 0.f) & 0xffffu); }
    }
}

#define IN(k) (lo <= (k) && (k) < hi)
#if MK_N_LAUNCHES == 1
#define SEAM(k) do { if (IN(k) && IN((k) + 1)) xcd_barrier(bar); } while (0)
#else
#define SEAM(k) do { } while (0)
#endif
#define PHASE_BEGIN \
    int lane; asm volatile("v_mbcnt_lo_u32_b32 %0, -1, 0\n\tv_mbcnt_hi_u32_b32 %0, -1, %0" : "=v"(lane)); const int wave = wave0; const int tid = wave * 64 + lane; \
    const int gw = bid * NWAVES + wave, NGW = G * NWAVES; (void)gw; (void)NGW; (void)lane; \
    ArgP ap = (ArgP)__builtin_amdgcn_kernarg_segment_ptr(); asm volatile("" : "+s"(ap)); \
    unsigned char* ws = ap->ws; \
    float* XL = (float*)(ws + WS_XL); bf16* H = (bf16*)(ws + WS_H); bf16* Y = (bf16*)(ws + WS_Y); bf16* P = (bf16*)(ws + WS_P); \
    float* MP = (float*)(ws + WS_MP); float* MOD = (float*)(ws + WS_MOD); float* LB = (float*)(ws + WS_LB); \
    float* COS = (float*)(ws + WS_ROPE); float* SIN = COS + SEQ * 32; \
    int* RL = (int*)(ws + WS_RL); float* SG = (float*)(ws + WS_SG); \
    bf16* XS = (bf16*)(ws + WS_XS); bf16* ACT = (bf16*)(ws + WS_ACT); bf16* YS = (bf16*)(ws + WS_YS); \
    (void)XL; (void)H; (void)Y; (void)P; (void)MP; (void)MOD; (void)LB; (void)COS; (void)SIN; (void)RL; (void)SG; (void)XS; (void)ACT; (void)YS;


template <int l>
__device__ __forceinline__ void layer_phases(const int lo, const int hi, LAS unsigned char* lds, const int bid, const int G, const int wave0, const XcdBarrier& bar) {
        constexpr int pb = 3 + 10 * l;
        if (IN(pb + 0)) for (int rep = 0; rep < REP(0); ++rep) {
            PHASE_BEGIN
            const float* MODL = MOD + (size_t)l * 3 * 6144; unsigned* cnt = (unsigned*)(ws + WS_CTL) + CW_CNT + l * 16 * 64; (void)MODL; (void)cnt;
            pg8::Gemm g{H, (const bf16*)(ws + WS_WIN), DM, DM, DM}; pg8::StaticOrder S; S.init(R, LDP, G, bid);
            pg8::EpiStoreBf16 E{P, LDP};
            pg8::gemm_phase<pg8::EpiStoreBf16, pg8::StaticOrder, true, true>(lds, g, S, E, tid);
        }
        SEAM(pb + 0);
        if (IN(pb + 1)) for (int rep = 0; rep < REP(1); ++rep) {
            PHASE_BEGIN
            const float* MODL = MOD + (size_t)l * 3 * 6144; unsigned* cnt = (unsigned*)(ws + WS_CTL) + CW_CNT + l * 16 * 64; (void)MODL; (void)cnt;
            const int n_att = 256 + (l == 0 ? 8 : 0), n_scan = 2 * 2 * 4 * NBLK, n_conv = R / 32;
            for (int it = bid; it < n_att; it += G) {
                if (it < 256) { const int b = it >> 7, kvh = (it >> 6) & 1, qb = it & 63; attn_unit(P, Y, COS, SIN, ap->in[I_SINK] + l * 4, b, kvh, qb, false, lds, tid, wave, lane); }
                else { const int q = it - 256; attn_unit(P, Y, COS, SIN, ap->in[I_SINK] + l * 4, q >> 2, (q >> 1) & 1, q & 1, true, lds, tid, wave, lane); }
            }
            for (int q = (bid + G - n_att % G) % G; q < n_scan; q += G) {
                const int kind = q / (2 * 4 * NBLK), r = q % (2 * 4 * NBLK); const int b = r / (4 * NBLK), h = (r / NBLK) & 3, blk = r % NBLK;
                if (kind == 0) scan_mfma<true>(ap, l, 0, b, h, blk, lds, tid, wave, lane); else scan_mfma<false>(ap, l, 0, b, h, blk, lds, tid, wave, lane);
            }
            for (int cu = (bid + 2 * G - (n_att + n_scan) % G) % G; cu < n_conv; cu += G)
                conv_unit(P, Y, ap->in[I_CONVW] + l * 31 * 256, ap->in[I_CONVB] + l * 256, ap->in[I_CLNG] + l * 256, ap->in[I_CLNB] + l * 256, cu, lds, tid, wave, lane);
        }
        SEAM(pb + 1);
        if (IN(pb + 2)) for (int rep = 0; rep < REP(2); ++rep) {
            PHASE_BEGIN
            const float* MODL = MOD + (size_t)l * 3 * 6144; unsigned* cnt = (unsigned*)(ws + WS_CTL) + CW_CNT + l * 16 * 64; (void)MODL; (void)cnt;
            const int n_scan = 2 * 2 * 4 * NBLK;
            for (int it = bid; it < n_scan; it += G) {
                const int kind = it / (2 * 4 * NBLK), r = it % (2 * 4 * NBLK); const int b = r / (4 * NBLK), h = (r / NBLK) & 3, blk = r % NBLK;
                if (kind == 0) scan_mfma<true>(ap, l, 1, b, h, blk, lds, tid, wave, lane); else scan_mfma<false>(ap, l, 1, b, h, blk, lds, tid, wave, lane);
            }
        }
        SEAM(pb + 2);
        if (IN(pb + 3)) for (int rep = 0; rep < REP(3); ++rep) {
            PHASE_BEGIN
            const float* MODL = MOD + (size_t)l * 3 * 6144; unsigned* cnt = (unsigned*)(ws + WS_CTL) + CW_CNT + l * 16 * 64; (void)MODL; (void)cnt;
            pg8::MergeOrder S; S.S.init(R, DM, G, bid);
            pg8::Gemm g{Y, (const bf16*)(ws + WS_WBR), DM, DM, 256}; pg8::EpiMerge E{P, H};
            pg8::gemm_phase<pg8::EpiMerge, pg8::MergeOrder, true, true>(lds, g, S, E, tid);
        }
        SEAM(pb + 3);
        if (IN(pb + 4)) for (int rep = 0; rep < REP(4); ++rep) {
            PHASE_BEGIN
            const float* MODL = MOD + (size_t)l * 3 * 6144; unsigned* cnt = (unsigned*)(ws + WS_CTL) + CW_CNT + l * 16 * 64; (void)MODL; (void)cnt;
            pg8::Gemm g{H, (const bf16*)(ws + WS_WOUT), DM, DM, DM}; pg8::StaticOrder S; S.init(R, DM, G, bid);
            pg8::EpiOut E{XL, MODL};
            pg8::gemm_phase<pg8::EpiOut, pg8::StaticOrder, true, true>(lds, g, S, E, tid);
        }
        SEAM(pb + 4);
        if (IN(pb + 5)) for (int rep = 0; rep < REP(5); ++rep) {
            PHASE_BEGIN
            const float* MODL = MOD + (size_t)l * 3 * 6144; unsigned* cnt = (unsigned*)(ws + WS_CTL) + CW_CNT + l * 16 * 64; (void)MODL; (void)cnt;
            LAS float* RW = (LAS float*)lds;
            __syncthreads();
            for (int idx = tid; idx < 16 * DM; idx += NTHREADS) { const int e = idx >> 10, d = idx & 1023; RW[idx] = ap->in[I_RW][d * 16 + e]; }
            __syncthreads();
            for (int row = gw; row < R; row += NGW) { const int cond = row_cond(row); if (l == 1 && cond == 2) continue;
                asm volatile("" ::: "memory");
                const f32x4* x4 = (const f32x4*)(XL + (size_t)row * DM); f32x4 v[4]; float ss = 0.f;
#pragma unroll
                for (int q = 0; q < 4; ++q) { v[q] = x4[lane + 64 * q]; ss += (v[q].x * v[q].x + v[q].y * v[q].y) + (v[q].z * v[q].z + v[q].w * v[q].w); }
                const float rstd = rsqrtf(wave_sum(ss) * (1.f / DM) + EPS);
                const float* md = MODL + (size_t)cond * 6144; const float* gf = ap->in[I_GFFN] + l * DM;
#pragma unroll
                for (int q = 0; q < 4; ++q) { const int c = 4 * lane + 256 * q; const f32x4 gg = *(const f32x4*)(gf + c), sh = *(const f32x4*)(md + 3 * DM + c), sc = *(const f32x4*)(md + 4 * DM + c);
                    v[q] = (v[q] * rstd) * gg * (sc + 1.0f) + sh; u32x2 w; w.x = pk2(v[q].x, v[q].y); w.y = pk2(v[q].z, v[q].w); *(u32x2*)(H + (size_t)row * DM + c) = w; }
                float af[16];
#pragma unroll
                for (int e = 0; e < 16; ++e) { float s = 0.f;
#pragma unroll
                    for (int q = 0; q < 4; ++q) { const f32x4 w = *(const LAS f32x4*)(RW + e * DM + 4 * lane + 256 * q); s += (v[q].x * w.x + v[q].y * w.y) + (v[q].z * w.z + v[q].w * w.w); }
                    af[e] = sigmoidf_(wave_sum(s)); }
                float bestsum = -1e30f; int e0 = 0, e1 = 1; float a0 = 0.f, a1 = 0.f;
#pragma unroll
                for (int gI = 0; gI < 4; ++gI) { float m1 = -1e30f, m2 = -1e30f; int i1 = 0, i2 = 0; float f1 = 0.f, f2 = 0.f;
#pragma unroll
                    for (int i = 0; i < 4; ++i) { const float bv = af[gI * 4 + i] + ap->in[I_RB][gI * 4 + i];
                        if (bv > m1) { m2 = m1; i2 = i1; f2 = f1; m1 = bv; i1 = gI * 4 + i; f1 = af[gI * 4 + i]; } else if (bv > m2) { m2 = bv; i2 = gI * 4 + i; f2 = af[gI * 4 + i]; } }
                    const float gs = m1 + m2; if (gs > bestsum) { bestsum = gs; e0 = i1; e1 = i2; a0 = f1; a1 = f2; } }
                if (lane == 0) { const float inv = 1.f / (a0 + a1);
                    const unsigned r0 = atomicAdd(cnt + e0 * 64, 1u); RL[(size_t)e0 * RLCAP + r0] = row * 2; SG[row * 2] = a0 * inv;
                    const unsigned r1 = atomicAdd(cnt + e1 * 64, 1u); RL[(size_t)e1 * RLCAP + r1] = row * 2 + 1; SG[row * 2 + 1] = a1 * inv; }
            }
        }
        SEAM(pb + 5);
        if (IN(pb + 6)) for (int rep = 0; rep < REP(6); ++rep) {
            PHASE_BEGIN
            const float* MODL = MOD + (size_t)l * 3 * 6144; unsigned* cnt = (unsigned*)(ws + WS_CTL) + CW_CNT + l * 16 * 64; (void)MODL; (void)cnt;
            int bs[NEXP + 1]; bs[0] = 0;
#pragma unroll
            for (int e = 0; e < NEXP; ++e) bs[e + 1] = bs[e] + (int)((cnt[e * 64] + 255u) >> 8);
            const int nrows = bs[NEXP] * 256;
            for (int cr = gw; cr < nrows; cr += NGW) { const int cb = cr >> 8; int e = 0, jb = 0;
#pragma unroll
                for (int q = 1; q < NEXP; ++q) if (cb >= bs[q]) { e = q; jb = bs[q]; }
                const int rank = (cb - jb) * 256 + (cr & 255);
                u32x4 v0 = {0u, 0u, 0u, 0u}, v1 = v0;
                if (rank < (int)cnt[e * 64]) { const int tok = RL[(size_t)e * RLCAP + rank] >> 1; const u32x4* s = (const u32x4*)(H + (size_t)tok * DM); v0 = s[lane]; v1 = s[lane + 64]; }
                u32x4* d = (u32x4*)(XS + (size_t)cr * DM); d[lane] = v0; d[lane + 64] = v1; }
        }
        SEAM(pb + 6);
        if (IN(pb + 7)) for (int rep = 0; rep < REP(7); ++rep) {
            PHASE_BEGIN
            const float* MODL = MOD + (size_t)l * 3 * 6144; unsigned* cnt = (unsigned*)(ws + WS_CTL) + CW_CNT + l * 16 * 64; (void)MODL; (void)cnt;
            pg8::Gemm g{XS, (const bf16*)(ws + WS_W13), DM, DM, DM}; pg8::MoeOrder S; S.init(cnt, 8, G, bid);
            pg8::EpiMoe1 E{ACT};
            pg8::gemm_phase<pg8::EpiMoe1, pg8::MoeOrder, true, true>(lds, g, S, E, tid);
        }
        SEAM(pb + 7);
        if (IN(pb + 8)) for (int rep = 0; rep < REP(8); ++rep) {
            PHASE_BEGIN
            const float* MODL = MOD + (size_t)l * 3 * 6144; unsigned* cnt = (unsigned*)(ws + WS_CTL) + CW_CNT + l * 16 * 64; (void)MODL; (void)cnt;
            pg8::Gemm g{ACT, (const bf16*)(ws + WS_W2), DM, DM, DM}; pg8::MoeOrder S; S.init(cnt, 4, G, bid);
            pg8::EpiMoe2 E{YS, RL, cnt};
            pg8::gemm_phase<pg8::EpiMoe2, pg8::MoeOrder, true, true>(lds, g, S, E, tid);
        }
        SEAM(pb + 8);
        if (IN(pb + 9)) for (int rep = 0; rep < REP(9); ++rep) {
            PHASE_BEGIN
            const float* MODL = MOD + (size_t)l * 3 * 6144; unsigned* cnt = (unsigned*)(ws + WS_CTL) + CW_CNT + l * 16 * 64; (void)MODL; (void)cnt;
            for (int row = gw; row < R; row += NGW) { const int cond = row_cond(row); if (l == 1 && cond == 2) continue;
                const float g0 = SG[row * 2], g1 = SG[row * 2 + 1];
                const f32x4* x4 = (const f32x4*)(XL + (size_t)row * DM); const float* gm = MODL + (size_t)cond * 6144 + 5 * DM; f32x4 v[4];
#pragma unroll
                for (int q = 0; q < 4; ++q) { const int c = 4 * lane + 256 * q; const u32x2 y0 = *(const u32x2*)(YS + (size_t)(row * 2) * DM + c), y1 = *(const u32x2*)(YS + (size_t)(row * 2 + 1) * DM + c);
                    f32x4 y; y.x = g0 * bflo(y0.x) + g1 * bflo(y1.x); y.y = g0 * bfhi(y0.x) + g1 * bfhi(y1.x); y.z = g0 * bflo(y0.y) + g1 * bflo(y1.y); y.w = g0 * bfhi(y0.y) + g1 * bfhi(y1.y);
                    v[q] = x4[lane + 64 * q] + *(const f32x4*)(gm + c) * y; }
                if (l == 0) {
                    f32x4* xo = (f32x4*)(XL + (size_t)row * DM);
#pragma unroll
                    for (int q = 0; q < 4; ++q) xo[lane + 64 * q] = v[q];
                    const float* md = MOD + (size_t)(1 * 3 + cond) * 6144;
                    modnorm_store(v, ap->in[I_GMIX] + DM, md, md + DM, H + (size_t)row * DM, lane);
                } else {
                    float ss = 0.f;
#pragma unroll
                    for (int q = 0; q < 4; ++q) ss += (v[q].x * v[q].x + v[q].y * v[q].y) + (v[q].z * v[q].z + v[q].w * v[q].w);
                    const float rstd = rsqrtf(wave_sum(ss) * (1.f / DM) + EPS);
                    const int b = row / RB, t = row - b * RB - CTXL; f32x4* o4 = (f32x4*)(ap->out + ((size_t)b * SEQ + t) * DM);
#pragma unroll
                    for (int q = 0; q < 4; ++q) o4[lane + 64 * q] = v[q] * rstd * *(const f32x4*)(ap->in[I_FINALG] + 4 * lane + 256 * q);
                }
            }
            if (l == 0) { __syncthreads(); convert_weights(ap, 1, lds, gw, NGW, wave, lane); }
        }
        SEAM(pb + 9);
}

__global__ void __launch_bounds__(NTHREADS, 2) fwd(Args a) {
    extern __shared__ __attribute__((aligned(16))) unsigned char lds_raw[];
    LAS unsigned char* lds = (LAS unsigned char*)lds_raw;
    volatile LAS unsigned* MISC = (volatile LAS unsigned*)(lds + MISC_OFF);
    const int tid0 = threadIdx.x; const int wave0 = __builtin_amdgcn_readfirstlane(tid0 >> 6);
    const int G = gridDim.x, bid = blockIdx.x;
    unsigned* ctl = (unsigned*)(a.ws + WS_CTL);
    for (int u = tid0; u < (LDS_BYTES - RING_BYTES) / 4; u += NTHREADS) ((LAS unsigned*)(lds + RING_BYTES))[u] = 0u;
    __syncthreads();
    XcdBarrier bar; bar.bar = ctl + CW_BAR; bar.x = 0; bar.st = nullptr;
#if MK_N_LAUNCHES == 1
    bar = xcd_barrier_post(ctl + CW_BAR, MISC + 8);
#endif
    const int lo = a.ph_lo, hi = a.ph_hi;
    if (IN(0)) for (int rep = 0; rep < REP(10); ++rep) {
        PHASE_BEGIN
        for (int row = gw; row < R; row += NGW) { const int b = row / RB, j = row - b * RB;
            const float* src = (j < CTXL) ? ap->in[I_CTX] + ((size_t)b * CTXL + j) * DM : ap->in[I_X] + ((size_t)b * SEQ + (j - CTXL)) * DM;
            const f32x4* s4 = (const f32x4*)src; f32x4* d4 = (f32x4*)(XL + (size_t)row * DM);
#pragma unroll
            for (int q = 0; q < 4; ++q) d4[lane + 64 * q] = s4[lane + 64 * q]; }
        for (int it = gw; it < 384; it += NGW) { const int l = it / 192, r = it % 192, kc = r / 24, jb = r % 24;
            f32x4 a0 = {0.f, 0.f, 0.f, 0.f}, a1 = a0, a2 = a0;
            const float* wp = ap->in[I_WMOD] + ((size_t)l * DM + kc * 128) * 6144 + jb * 256 + lane * 4;
            for (int k = 0; k < 128; ++k) { const f32x4 w = *(const f32x4*)(wp + (size_t)k * 6144); const int kk = kc * 128 + k;
                const float s0 = siluf_(ap->in[I_C][kk]), s1 = siluf_(ap->in[I_C][DM + kk]), s2 = siluf_(ap->in[I_CCTX][kk]);
                a0 += w * s0; a1 += w * s1; a2 += w * s2; }
            float* mp = MP + ((size_t)(l * 8 + kc) * 3) * 6144 + jb * 256 + lane * 4;
            *(f32x4*)(mp) = a0; *(f32x4*)(mp + 6144) = a1; *(f32x4*)(mp + 2 * 6144) = a2; }
        if (bid == 0) { for (int i = tid; i < 512; i += NTHREADS) { const float x0 = ap->in[I_LBLOG][i], x1 = ap->in[I_LBLOG][512 + i]; const float m = fmaxf(x0, x1);
            const float e0 = expf(x0 - m), e1 = expf(x1 - m); LB[i] = 0.f; LB[512 + i] = e1 / (e0 + e1); } }
        for (int idx = bid * NTHREADS + tid; idx < SEQ * 32; idx += G * NTHREADS) { const int t = idx >> 5, ai = idx & 31; const int ax = ai >> 4, i = ai & 15;
            const float inv = powf(10000.0f, -(float)i / 16.0f); const float pos = (float)(ax == 0 ? (t >> 6) : (t & 63)); const float ang = pos * inv;
            COS[idx] = cosf(ang); SIN[idx] = sinf(ang); }
        convert_weights(ap, 0, lds, gw, NGW, wave, lane);
    }
    SEAM(0);
    if (IN(1)) for (int rep = 0; rep < REP(11); ++rep) {
        PHASE_BEGIN
        for (int idx = bid * NTHREADS + tid; idx < 2 * 3 * 6144; idx += G * NTHREADS) { const int l = idx / (3 * 6144), r = idx % (3 * 6144), cond = r / 6144, j = r % 6144;
            float s = ap->in[I_BMOD][l * 6144 + j];
#pragma unroll
            for (int kc = 0; kc < 8; ++kc) s += MP[((size_t)(l * 8 + kc) * 3 + cond) * 6144 + j];
            MOD[idx] = s; }
    }
    SEAM(1);
    if (IN(2)) for (int rep = 0; rep < REP(12); ++rep) {
        PHASE_BEGIN
        for (int row = gw; row < R; row += NGW) { const int cond = row_cond(row); const f32x4* x4 = (const f32x4*)(XL + (size_t)row * DM); f32x4 v[4];
#pragma unroll
            for (int q = 0; q < 4; ++q) v[q] = x4[lane + 64 * q];
            const float* md = MOD + (size_t)(0 * 3 + cond) * 6144;
            modnorm_store(v, ap->in[I_GMIX], md, md + DM, H + (size_t)row * DM, lane); }
    }
    SEAM(2);

    layer_phases<0>(lo, hi, lds, bid, G, wave0, bar);
    layer_phases<1>(lo, hi, lds, bid, G, wave0, bar);
}

constexpr int NPHASES = 23;
extern "C" void kernel_launch(void* const* d_in, const int* in_sizes, int n_in, void* d_out, int out_size, void* d_ws, size_t ws_size, hipStream_t stream) {
    static int grid = 0;
    if (grid == 0) {
        int dev = 0, cus = 0, per_cu = 0;
        if (hipGetDevice(&dev) != hipSuccess || hipDeviceGetAttribute(&cus, hipDeviceAttributeMultiprocessorCount, dev) != hipSuccess) { grid = -1; return; }
        if (hipFuncSetAttribute((const void*)fwd, hipFuncAttributeMaxDynamicSharedMemorySize, LDS_BYTES) != hipSuccess) { grid = -1; return; }
        if (hipOccupancyMaxActiveBlocksPerMultiprocessor(&per_cu, (const void*)fwd, NTHREADS, LDS_BYTES) != hipSuccess || per_cu < 1) per_cu = 1;
        (void)hipGetLastError();
        grid = cus;
        if (ws_size < WS_END) fprintf(stderr, "kernel_launch: workspace too small: %zu < %zu\n", ws_size, (size_t)WS_END);
    }
    if (grid < 0) return;
    (void)hipMemsetAsync((char*)d_ws + WS_CTL, 0, CTL_ZERO_BYTES, stream);
    Args a{};
    for (int i = 0; i < 30; ++i) a.in[i] = (const float*)d_in[i];
    a.out = (float*)d_out; a.ws = (unsigned char*)d_ws;
#if MK_N_LAUNCHES == 1
    a.ph_lo = 0; a.ph_hi = NPHASES;
    hipLaunchKernelGGL(fwd, dim3(grid), dim3(NTHREADS), LDS_BYTES, stream, a);
#else
    for (int ph = 0; ph < NPHASES; ++ph) { a.ph_lo = ph; a.ph_hi = ph + 1; hipLaunchKernelGGL(fwd, dim3(grid), dim3(NTHREADS), LDS_BYTES, stream, a); }
#endif
}
```

```cpp
#include <hip/hip_runtime.h>
#include <cstdio>
#include <cstdint>

#ifndef PROBE_REP
#define PROBE_REP 0
#endif
#define REP(j) ((((PROBE_REP) >> (j)) & 1) + 1)
#ifndef PROBE_UNIT
#define PROBE_UNIT 0
#endif
#define UREP(j) ((((PROBE_UNIT) >> (j)) & 1) + 1)
#ifndef MK_N_LAUNCHES
#define MK_N_LAUNCHES 1
#endif

#define GAS __attribute__((address_space(1)))
#define LAS __attribute__((address_space(3)))
typedef unsigned short bf16;
typedef short bf16x8 __attribute__((ext_vector_type(8)));
typedef short s16x4 __attribute__((ext_vector_type(4)));
typedef float f32x4 __attribute__((ext_vector_type(4)));
typedef float f32x2 __attribute__((ext_vector_type(2)));
typedef unsigned u32x4 __attribute__((ext_vector_type(4)));
typedef unsigned u32x2 __attribute__((ext_vector_type(2)));
typedef __bf16 bf16x2_t __attribute__((ext_vector_type(2)));

__device__ __forceinline__ unsigned pk2(float lo, float hi) { f32x2 v = {lo, hi}; bf16x2_t b = __builtin_convertvector(v, bf16x2_t); return __builtin_bit_cast(unsigned, b); }
__device__ __forceinline__ float bflo(unsigned w) { return __uint_as_float(w << 16); }
__device__ __forceinline__ float bfhi(unsigned w) { return __uint_as_float(w & 0xffff0000u); }
__device__ __forceinline__ float bf2f(bf16 v) { return __uint_as_float(((unsigned)v) << 16); }
__device__ __forceinline__ float sigmoidf_(float x) { return __builtin_amdgcn_rcpf(1.0f + __expf(-x)); }
__device__ __forceinline__ float siluf_(float x) { return x * __builtin_amdgcn_rcpf(1.0f + __expf(-x)); }
__device__ __forceinline__ float wave_sum(float v) {
#pragma unroll
    for (int o = 1; o < 64; o <<= 1) v += __shfl_xor(v, o);
    return v;
}

constexpr int DM = 1024, NBATCH = 2, SEQ = 8192, CTXL = 256, RB = SEQ + CTXL, R = NBATCH * RB;
constexpr int NBLK = RB / 256;
constexpr int LDP = 7424;
constexpr int C_CONV = 0, C_HGQ = 512, C_HGFF = 768, C_HGFB = 1024, C_HGI = 1280, C_HGG = 1536, C_GLQ = 1792, C_GLK = 1920, C_GLV = 2048,
              C_GLG = 2304, C_ATQ = 2560, C_ATK = 2816, C_ATV = 2944, C_BG = 3072, C_GLU = 7168, W_IN_COLS = 7200, W_IN_A = 2304;
constexpr float EPS = 1e-6f;
constexpr int NEXP = 16, RLCAP = 2 * R;
constexpr int NWAVES = 8, NTHREADS = 512;

constexpr size_t MiB = 1u << 20;
constexpr size_t WS_CTL = 0, CTL_ZERO_BYTES = 1 * MiB;
constexpr size_t WS_MP = 1 * MiB;
constexpr size_t WS_MOD = WS_MP + 1280 * 1024;
constexpr size_t WS_LB = WS_MOD + 256 * 1024;
constexpr size_t WS_ROPE = 3 * MiB;
constexpr size_t WS_RL = 5 * MiB;
constexpr size_t WS_SG = WS_RL + (size_t)NEXP * RLCAP * 4;
constexpr size_t WS_SEGH = 8 * MiB;
constexpr size_t WS_SEGG = WS_SEGH + (size_t)16 * NBLK * 4096 * 4;
constexpr size_t WS_SEGDH = WS_SEGG + (size_t)16 * NBLK * 2048 * 4;
constexpr size_t WS_SEGDG = WS_SEGDH + (size_t)16 * NBLK * 64 * 4;
constexpr size_t WS_WIN = 21 * MiB;
constexpr size_t WS_WBR = 36 * MiB;
constexpr size_t WS_WOUT = 38 * MiB;
constexpr size_t WS_W13 = 40 * MiB;
constexpr size_t WS_W2 = 104 * MiB;
constexpr size_t WS_XL = 136 * MiB;
constexpr size_t WS_H = 202 * MiB;
constexpr size_t WS_Y = 235 * MiB;
constexpr size_t WS_P = 268 * MiB;
constexpr size_t WS_XS = WS_P, WS_ACT = WS_P + 74 * MiB, WS_YS = WS_P + 148 * MiB;
constexpr size_t WS_END = WS_P + (size_t)R * LDP * 2;
static_assert(WS_SEGDG + 16 * NBLK * 32 * 4 <= WS_WIN && WS_END <= 508 * MiB, "ws map");
static_assert((size_t)(2 * R + 16 * 256) * 2048 <= 74 * MiB, "XS fits");
constexpr int CW_BAR = 4096;
constexpr int CW_Q = 8192;
constexpr int CW_CNT = 16384;

constexpr int RING_BYTES = 131072;
constexpr int MISC_OFF = RING_BYTES + 320;
constexpr int LDS_BYTES = 147456;

namespace pg8 {
#define PG8_LAS __attribute__((address_space(3)))
typedef unsigned short bf16_t;
constexpr int BM = 256, BK = 64, HALF = 128, HTB = HALF * BK * 2, STAGE_BYTES = 8 * HTB, NXCD = 8, WGM = 8;
__host__ __device__ __forceinline__ int lds_byte(int r, int c) { const int st = (r >> 4) * 2 + (c >> 5), rr = r & 15, cc = c & 31, ob = rr * 64 + cc * 2; return st * 1024 + (ob ^ (((ob >> 9) & 1) << 5)); }
__host__ __device__ __forceinline__ void stage_rc(int b, int& R_, int& C) { const int st = b / 1024, sb = b % 1024, swz = sb ^ (((sb >> 9) & 1) << 5); R_ = (st >> 1) * 16 + swz / 64; C = (st & 1) * 32 + (swz % 64) / 2; }
__host__ __device__ __forceinline__ int perm32(int rho) { const int n = rho >> 4, i = rho & 15; return 8 * (i >> 2) + 4 * n + (i & 3); }

struct Unit { int pm, pn, pb, aux, kofs; };
struct Gemm { const bf16_t* A; const bf16_t* Bt; int lda, ldb, K; };

struct StaticOrder {
    int nM, nN, nwg, G, c;
    __host__ __device__ void init(int M, int N, int G_, int c_) { nM = M / BM; nN = N / BM; nwg = nM * nN; G = G_; c = c_; }
    __host__ __device__ bool next(int i, Unit& u) const {
        const long L = (long)i * G + c; if (L >= nwg) return false;
        int wgid = (int)L; { const int q = nwg / NXCD, r = nwg % NXCD, xcd = wgid % NXCD, off = wgid / NXCD; wgid = (xcd < r ? xcd * (q + 1) : r * (q + 1) + (xcd - r) * q) + off; }
        const int nig = WGM * nN, gid = wgid / nig, fm = gid * WGM, gsz = (nM - fm) < WGM ? (nM - fm) : WGM;
        u.pm = fm + ((wgid % nig) % gsz); u.pn = (wgid % nig) / gsz; u.pb = u.pn; u.aux = 0; u.kofs = 0; return true;
    }
};
struct MoeOrder {
    int bs[NEXP + 1]; int ncol, G, c;
    __device__ __forceinline__ void init(const unsigned* cnt, int ncol_, int G_, int c_) {
        ncol = ncol_; G = G_; c = c_; bs[0] = 0;
#pragma unroll
        for (int e = 0; e < NEXP; ++e) bs[e + 1] = bs[e] + __builtin_amdgcn_readfirstlane((int)((cnt[e * 64] + 255u) >> 8));
    }
    __device__ __forceinline__ bool next(int i, Unit& u) const {
        const long L = (long)i * G + c; if (L >= (long)bs[NEXP] * ncol) return false;
        const int cb = (int)(L / ncol), pn = (int)(L % ncol); int e = 0, jb = 0;
#pragma unroll
        for (int q = 1; q < NEXP; ++q) if (cb >= bs[q]) { e = q; jb = bs[q]; }
        u.pm = cb; u.pn = pn; u.pb = e * ncol + pn; u.aux = (e << 16) | (cb - jb); u.kofs = 0; return true;
    }
};
struct MergeOrder {
    StaticOrder S;
    __device__ __forceinline__ bool next(int i, Unit& u) const { if (!S.next(i >> 2, u)) return false; u.aux = i & 3; u.kofs = 256 * (i & 3); return true; }
};

template <class Epi, class Sched, bool ALIGN_EPI = false, bool SP2 = false>
__device__ __forceinline__ void gemm_phase(PG8_LAS unsigned char* lds, const Gemm g, const Sched& S, const Epi& E, const int tid) {
    const int wid = __builtin_amdgcn_readfirstlane(tid >> 6), lane = tid & 63, wr = wid >> 2, wc = wid & 3, fr = lane & 15, fq = lane >> 4;
    const int K = g.K, nt = K / BK;
    unsigned voffA[2], voffB[2];
#pragma unroll
    for (int i = 0; i < 2; ++i) { int R_, C; stage_rc(tid * 16 + i * 8192, R_, C); const int Rb = Epi::PERM ? ((R_ & ~31) + perm32(R_ & 31)) : R_;
        voffA[i] = (unsigned)(R_ * g.lda + C) * 2u; voffB[i] = (unsigned)(Rb * g.ldb + C) * 2u; }
    const size_t kstep = (size_t)(BK * 2);
    const size_t hstepA = (size_t)HALF * g.lda * 2, hstepB = (size_t)HALF * g.ldb * 2;
    const size_t tstepA = 2 * hstepA, tstepB = 2 * hstepB;
    const unsigned ldsw = (unsigned)wid * 1024u;
    const int aoff = lds_byte(wr * 64 + fr, fq * 8), boff = lds_byte(wc * 32 + fr, fq * 8);
#define PG8_SA(b, h) (((b) * 2 + (h)) * HTB)
#define PG8_SB(b, h) ((4 + (b) * 2 + (h)) * HTB)
#define PG8_STAGE(bufoff, gbase, voff) do { _Pragma("unroll") for (int _i = 0; _i < 2; ++_i) \
        __builtin_amdgcn_global_load_lds((const unsigned*)((const char*)(gbase) + (voff)[_i]), (PG8_LAS unsigned*)(lds + (bufoff) + ldsw + _i * 8192), 16, 0, 0); } while (0)
#define PG8_LDA(dst, b, h) do { _Pragma("unroll") for (int m = 0; m < 4; ++m) _Pragma("unroll") for (int k = 0; k < 2; ++k) dst[m][k] = *(const PG8_LAS bf16x8*)(lds + PG8_SA(b, h) + aoff + m * 2048 + k * 1024); } while (0)
#define PG8_LDB(dst, b, h) do { _Pragma("unroll") for (int n = 0; n < 2; ++n) _Pragma("unroll") for (int k = 0; k < 2; ++k) dst[n][k] = *(const PG8_LAS bf16x8*)(lds + PG8_SB(b, h) + boff + n * 2048 + k * 1024); } while (0)
#define PG8_MMA(ai, bj, At, Bt) do { __builtin_amdgcn_s_setprio(1); _Pragma("unroll") for (int m = 0; m < 4; ++m) _Pragma("unroll") for (int n = 0; n < 2; ++n) _Pragma("unroll") for (int k = 0; k < 2; ++k) \
        acc[ai][bj][m][n] = __builtin_amdgcn_mfma_f32_16x16x32_bf16(Bt[n][k], At[m][k], acc[ai][bj][m][n], 0, 0, 0); __builtin_amdgcn_s_setprio(0); } while (0)
#define PG8_WAIT_V(n) asm volatile("s_waitcnt vmcnt(" #n ")" ::: "memory")
#define PG8_WAIT_L(n) asm volatile("s_waitcnt lgkmcnt(" #n ")" ::: "memory")
#define PG8_BAR __builtin_amdgcn_s_barrier()
#define PG8_SCHED __builtin_amdgcn_sched_barrier(0)
    Unit cur, nxt; int ui = 0;
    if (!S.next(0, cur)) return;
    f32x4 acc[2][2][4][2];
#pragma unroll
    for (int a = 0; a < 2; ++a)
#pragma unroll
        for (int b = 0; b < 2; ++b)
#pragma unroll
            for (int m = 0; m < 4; ++m)
#pragma unroll
                for (int n = 0; n < 2; ++n) acc[a][b][m][n] = (f32x4){0.f, 0.f, 0.f, 0.f};
    bf16x8 At[4][2], B0[2][2], B1[2][2];
    const char* cA = (const char*)g.A + (size_t)cur.pm * tstepA + cur.kofs * 2; const char* cB = (const char*)g.Bt + (size_t)cur.pb * tstepB + cur.kofs * 2;
    if constexpr (SP2) {
        PG8_STAGE(PG8_SB(0, 0), cB, voffB); PG8_STAGE(PG8_SB(0, 1), cB + hstepB, voffB); PG8_STAGE(PG8_SA(0, 0), cA, voffA); PG8_STAGE(PG8_SA(0, 1), cA + hstepA, voffA);
        if (wr == 1) PG8_BAR;
        PG8_WAIT_V(2); PG8_BAR;
        PG8_STAGE(PG8_SB(1, 0), cB + kstep, voffB); PG8_STAGE(PG8_SA(1, 0), cA + kstep, voffA); PG8_STAGE(PG8_SB(1, 1), cB + hstepB + kstep, voffB);
        PG8_WAIT_V(6); PG8_BAR;
    } else {
        PG8_STAGE(PG8_SB(0, 0), cB, voffB); PG8_STAGE(PG8_SA(0, 0), cA, voffA); PG8_STAGE(PG8_SB(0, 1), cB + hstepB, voffB); PG8_STAGE(PG8_SA(0, 1), cA + hstepA, voffA);
        if (wr == 1) PG8_BAR;
        PG8_WAIT_V(4); PG8_BAR;
        PG8_STAGE(PG8_SB(1, 0), cB + kstep, voffB); PG8_STAGE(PG8_SA(1, 0), cA + kstep, voffA); PG8_STAGE(PG8_SB(1, 1), cB + hstepB + kstep, voffB);
        PG8_WAIT_V(6); PG8_BAR;
    }
    for (;;) {
        const bool has_next = S.next(ui + 1, nxt);
        const char* nA = has_next ? (const char*)g.A + (size_t)nxt.pm * tstepA + nxt.kofs * 2 : cA; const char* nB = has_next ? (const char*)g.Bt + (size_t)nxt.pb * tstepB + nxt.kofs * 2 : cB;
        for (int t = 0; t < nt; t += 2) {
            const bool last = (t == nt - 2);
            const char* a1 = cA + (size_t)(t + 1) * kstep;
            const char* a2 = last ? nA : cA + (size_t)(t + 2) * kstep; const char* b2 = last ? nB : cB + (size_t)(t + 2) * kstep;
            const char* a3 = a2 + kstep; const char* b3 = b2 + kstep;
            if constexpr (SP2) {
            PG8_LDB(B0, 0, 0); PG8_LDB(B1, 0, 1); PG8_SCHED; PG8_LDA(At, 0, 0); PG8_STAGE(PG8_SA(1, 1), a1 + hstepA, voffA);
            PG8_WAIT_V(8); PG8_WAIT_L(0); PG8_BAR; PG8_MMA(0, 0, At, B0); PG8_MMA(0, 1, At, B1); PG8_BAR; PG8_SCHED;
            PG8_LDA(At, 0, 1); PG8_STAGE(PG8_SB(0, 0), b2, voffB); PG8_STAGE(PG8_SB(0, 1), b2 + hstepB, voffB); PG8_STAGE(PG8_SA(0, 0), a2, voffA);
            PG8_WAIT_V(8); PG8_WAIT_L(0); PG8_BAR; PG8_MMA(1, 0, At, B0); PG8_MMA(1, 1, At, B1); PG8_BAR; PG8_SCHED;
            PG8_LDB(B0, 1, 0); PG8_LDB(B1, 1, 1); PG8_SCHED; PG8_LDA(At, 1, 0); PG8_STAGE(PG8_SA(0, 1), a2 + hstepA, voffA);
            PG8_WAIT_V(8); PG8_WAIT_L(0); PG8_BAR; PG8_MMA(0, 0, At, B0); PG8_MMA(0, 1, At, B1); PG8_BAR; PG8_SCHED;
            PG8_LDA(At, 1, 1); PG8_STAGE(PG8_SB(1, 0), b3, voffB); PG8_STAGE(PG8_SB(1, 1), b3 + hstepB, voffB); PG8_STAGE(PG8_SA(1, 0), a3, voffA);
            PG8_WAIT_V(8); PG8_WAIT_L(0); PG8_BAR; PG8_MMA(1, 0, At, B0); PG8_MMA(1, 1, At, B1); PG8_BAR; PG8_SCHED;
            } else {
            PG8_LDB(B0, 0, 0); PG8_SCHED; PG8_LDA(At, 0, 0); PG8_STAGE(PG8_SA(1, 1), a1 + hstepA, voffA);
            PG8_WAIT_L(8); PG8_BAR; PG8_WAIT_L(0); PG8_MMA(0, 0, At, B0); PG8_BAR; PG8_SCHED;
            PG8_LDB(B1, 0, 1); PG8_STAGE(PG8_SB(0, 0), b2, voffB);
            PG8_BAR; PG8_WAIT_L(0); PG8_MMA(0, 1, At, B1); PG8_BAR;
            PG8_LDA(At, 0, 1); PG8_STAGE(PG8_SA(0, 0), a2, voffA);
            PG8_BAR; PG8_WAIT_L(0); PG8_MMA(1, 0, At, B0); PG8_BAR; PG8_SCHED;
            PG8_STAGE(PG8_SB(0, 1), b2 + hstepB, voffB);
            PG8_WAIT_V(6); PG8_BAR; PG8_MMA(1, 1, At, B1); PG8_BAR;
            PG8_LDB(B0, 1, 0); PG8_SCHED; PG8_LDA(At, 1, 0); PG8_STAGE(PG8_SA(0, 1), a2 + hstepA, voffA);
            PG8_WAIT_L(8); PG8_BAR; PG8_WAIT_L(0); PG8_MMA(0, 0, At, B0); PG8_BAR; PG8_SCHED;
            PG8_LDB(B1, 1, 1); PG8_STAGE(PG8_SB(1, 0), b3, voffB);
            PG8_BAR; PG8_WAIT_L(0); PG8_MMA(0, 1, At, B1); PG8_BAR;
            PG8_LDA(At, 1, 1); PG8_STAGE(PG8_SA(1, 0), a3, voffA);
            PG8_BAR; PG8_WAIT_L(0); PG8_MMA(1, 0, At, B0); PG8_BAR; PG8_SCHED;
            PG8_STAGE(PG8_SB(1, 1), b3 + hstepB, voffB);
            PG8_WAIT_V(6); PG8_BAR; PG8_MMA(1, 1, At, B1); PG8_BAR;
            }
        }
        if constexpr (ALIGN_EPI) { if (wr == 0) PG8_BAR; }
        E(acc, cur, wr, wc, fr, fq);
        if (!has_next) break;
#pragma unroll
        for (int a = 0; a < 2; ++a)
#pragma unroll
            for (int b = 0; b < 2; ++b)
#pragma unroll
                for (int m = 0; m < 4; ++m)
#pragma unroll
                    for (int n = 0; n < 2; ++n) acc[a][b][m][n] = (f32x4){0.f, 0.f, 0.f, 0.f};
        cur = nxt; cA = nA; cB = nB; ++ui;
        if constexpr (ALIGN_EPI) { if (wr == 1) PG8_BAR; }
    }
    PG8_WAIT_V(0);
    if constexpr (!ALIGN_EPI) { if (wr == 0) PG8_BAR; }
    PG8_BAR;
#undef PG8_SA
#undef PG8_SB
#undef PG8_STAGE
#undef PG8_LDA
#undef PG8_LDB
#undef PG8_MMA
#undef PG8_WAIT_V
#undef PG8_WAIT_L
#undef PG8_BAR
#undef PG8_SCHED
}

struct EpiStoreBf16 {
    static constexpr bool PERM = true;
    bf16_t* O; int ldc;
    __device__ __forceinline__ void operator()(const f32x4 (&acc)[2][2][4][2], const Unit& u, int wr, int wc, int fr, int fq) const {
        const int row0 = u.pm * BM + wr * 64 + fr, col0 = u.pn * BM + wc * 32 + 8 * fq;
#pragma unroll
        for (int ai = 0; ai < 2; ++ai)
#pragma unroll
            for (int m = 0; m < 4; ++m) { bf16_t* rowp = O + (size_t)(row0 + ai * HALF + m * 16) * ldc + col0;
#pragma unroll
                for (int bj = 0; bj < 2; ++bj) { const f32x4 v0 = acc[ai][bj][m][0], v1 = acc[ai][bj][m][1];
                    u32x4 w; w.x = pk2(v0[0], v0[1]); w.y = pk2(v0[2], v0[3]); w.z = pk2(v1[0], v1[1]); w.w = pk2(v1[2], v1[3]);
                    *(u32x4*)(rowp + bj * HALF) = w; } }
    }
};
struct EpiMerge {
    static constexpr bool PERM = true;
    const bf16_t* P; bf16_t* MG;
    __device__ __forceinline__ void operator()(const f32x4 (&acc)[2][2][4][2], const Unit& u, int wr, int wc, int fr, int fq) const {
        const int row0 = u.pm * BM + wr * 64 + fr, col0 = u.pn * BM + wc * 32 + 8 * fq; const int br = u.aux;
        const bf16_t* gp = P + C_BG + br * 1024 + col0;
#pragma unroll
        for (int ai = 0; ai < 2; ++ai)
#pragma unroll
            for (int m = 0; m < 4; ++m) { const int row = row0 + ai * HALF + m * 16;
#pragma unroll
                for (int bj = 0; bj < 2; ++bj) { const int col = col0 + bj * HALF;
                    const u32x4 gw = *(const u32x4*)(gp + (size_t)row * LDP + bj * HALF);
                    u32x4 ow = {0u, 0u, 0u, 0u}; if (br > 0) ow = *(const u32x4*)(MG + (size_t)row * DM + col);
                    const f32x4 v0 = acc[ai][bj][m][0], v1 = acc[ai][bj][m][1];
                    u32x4 w;
                    w.x = pk2(bflo(ow.x) + sigmoidf_(bflo(gw.x)) * v0[0], bfhi(ow.x) + sigmoidf_(bfhi(gw.x)) * v0[1]);
                    w.y = pk2(bflo(ow.y) + sigmoidf_(bflo(gw.y)) * v0[2], bfhi(ow.y) + sigmoidf_(bfhi(gw.y)) * v0[3]);
                    w.z = pk2(bflo(ow.z) + sigmoidf_(bflo(gw.z)) * v1[0], bfhi(ow.z) + sigmoidf_(bfhi(gw.z)) * v1[1]);
                    w.w = pk2(bflo(ow.w) + sigmoidf_(bflo(gw.w)) * v1[2], bfhi(ow.w) + sigmoidf_(bfhi(gw.w)) * v1[3]);
                    *(u32x4*)(MG + (size_t)row * DM + col) = w; }
                asm volatile("" ::: "memory"); }
    }
};
struct EpiOut {
    static constexpr bool PERM = false;
    float* XL; const float* MODL;
    __device__ __forceinline__ void operator()(const f32x4 (&acc)[2][2][4][2], const Unit& u, int wr, int wc, int fr, int fq) const {
        const int row0 = u.pm * BM + wr * 64 + fr, col0 = u.pn * BM + wc * 32 + 4 * fq;
        const int cond = (u.pm % NBLK == 0) ? 2 : (u.pm / NBLK);
        const float* gp = MODL + (cond * 6 + 2) * DM + col0;
        f32x4 gv[2][2];
#pragma unroll
        for (int bj = 0; bj < 2; ++bj)
#pragma unroll
            for (int n = 0; n < 2; ++n) gv[bj][n] = *(const f32x4*)(gp + bj * HALF + n * 16);
#pragma unroll
        for (int ai = 0; ai < 2; ++ai)
#pragma unroll
            for (int m = 0; m < 4; ++m) { float* rowp = XL + (size_t)(row0 + ai * HALF + m * 16) * DM + col0;
#pragma unroll
                for (int bj = 0; bj < 2; ++bj)
#pragma unroll
                    for (int n = 0; n < 2; ++n) { const f32x4 x = *(const f32x4*)(rowp + bj * HALF + n * 16); *(f32x4*)(rowp + bj * HALF + n * 16) = x + gv[bj][n] * acc[ai][bj][m][n]; } }
    }
};
struct EpiMoe1 {
    static constexpr bool PERM = true;
    bf16_t* ACT;
    __device__ __forceinline__ void operator()(const f32x4 (&acc)[2][2][4][2], const Unit& u, int wr, int wc, int fr, int fq) const {
        const int row0 = u.pm * BM + wr * 64 + fr, col0 = u.pn * HALF + wc * 32 + 8 * fq;
#pragma unroll
        for (int ai = 0; ai < 2; ++ai)
#pragma unroll
            for (int m = 0; m < 4; ++m) { bf16_t* rowp = ACT + (size_t)(row0 + ai * HALF + m * 16) * DM + col0;
                const f32x4 a0 = acc[ai][0][m][0], a1 = acc[ai][0][m][1], b0 = acc[ai][1][m][0], b1 = acc[ai][1][m][1];
                u32x4 w; w.x = pk2(siluf_(a0[0]) * b0[0], siluf_(a0[1]) * b0[1]); w.y = pk2(siluf_(a0[2]) * b0[2], siluf_(a0[3]) * b0[3]);
                w.z = pk2(siluf_(a1[0]) * b1[0], siluf_(a1[1]) * b1[1]); w.w = pk2(siluf_(a1[2]) * b1[2], siluf_(a1[3]) * b1[3]);
                *(u32x4*)rowp = w; }
    }
};
struct EpiMoe2 {
    static constexpr bool PERM = true;
    bf16_t* YS; const int* RL; const unsigned* cnt;
    __device__ __forceinline__ void operator()(const f32x4 (&acc)[2][2][4][2], const Unit& u, int wr, int wc, int fr, int fq) const {
        const int e = u.aux >> 16, jb = u.aux & 0xffff; const int n_e = __builtin_amdgcn_readfirstlane((int)cnt[e * 64]);
        const int col0 = u.pn * BM + wc * 32 + 8 * fq;
#pragma unroll
        for (int ai = 0; ai < 2; ++ai)
#pragma unroll
            for (int m = 0; m < 4; ++m) { const int rank = jb * BM + ai * HALF + wr * 64 + m * 16 + fr;
                if (rank < n_e) { const int slot = RL[(size_t)e * RLCAP + rank]; bf16_t* rowp = YS + (size_t)slot * DM + col0;
#pragma unroll
                    for (int bj = 0; bj < 2; ++bj) { const f32x4 v0 = acc[ai][bj][m][0], v1 = acc[ai][bj][m][1];
                        u32x4 w; w.x = pk2(v0[0], v0[1]); w.y = pk2(v0[2], v0[3]); w.z = pk2(v1[0], v1[1]); w.w = pk2(v1[2], v1[3]);
                        *(u32x4*)(rowp + bj * HALF) = w; } } }
    }
};
}

#define XB_TMO      128
#define XB_XCNT(j)  (256  + 64 * (j))
#define XB_XSUB(j)  (1280 + 64 * (j))
#define XB_XGEN(j)  (2304 + 64 * (j))
#define XB_TOP      3328
#define XB_TOPGEN   3392
#define XCD_BAR_WORDS 3456
#define XB_SPIN_CAP (1u << 18)
__device__ __forceinline__ unsigned xb_ld(unsigned* p)              { return __hip_atomic_load(p, __ATOMIC_RELAXED, __HIP_MEMORY_SCOPE_AGENT); }
__device__ __forceinline__ unsigned xb_add(unsigned* p, unsigned v) { return __hip_atomic_fetch_add(p, v, __ATOMIC_RELAXED, __HIP_MEMORY_SCOPE_AGENT); }
__device__ __forceinline__ unsigned xb_xcc_id() { return (unsigned)__builtin_amdgcn_s_getreg((3 << 11) | 20) & 0xFu; }
#define XB_SPIN(cond, bar) do { unsigned _sp = 0; while (cond) { __builtin_amdgcn_s_sleep(1); \
    if ((++_sp & 255u) == 0u) { if (xb_ld(&(bar)[XB_TMO])) break; if (_sp > XB_SPIN_CAP) { atomicAdd(&(bar)[XB_TMO], 1u); break; } } } } while (0)
struct XcdBarrier { unsigned* bar; unsigned x; volatile LAS unsigned* st; };
__device__ __forceinline__ XcdBarrier xcd_barrier_post(unsigned* bar, volatile LAS unsigned* st) {
    XcdBarrier b; b.bar = bar; b.x = xb_xcc_id(); b.st = st;
    if (threadIdx.x == 0) (void)xb_add(&bar[XB_XCNT(b.x)], 1u);
    return b;
}
__device__ __forceinline__ void xcd_barrier_complete(unsigned* bar, unsigned x, unsigned& nloc, unsigned& nx) {
    const unsigned G = gridDim.x * gridDim.y * gridDim.z;
    unsigned sum, cnt, mine, sp = 0u;
    for (;;) {
        sum = 0u; cnt = 0u; mine = 0u;
#pragma unroll
        for (unsigned j = 0; j < 16; ++j) { const unsigned c = xb_ld(&bar[XB_XCNT(j)]); sum += c; cnt += (c > 0u) ? 1u : 0u; mine = (j == x) ? c : mine; }
        if (sum == G) break;
        __builtin_amdgcn_s_sleep(1);
        if ((++sp & 255u) == 0u) { if (xb_ld(&bar[XB_TMO])) break; if (sp > XB_SPIN_CAP) { atomicAdd(&bar[XB_TMO], 1u); break; } }
    }
    nloc = mine > 0u ? mine : 1u; nx = cnt > 0u ? cnt : 1u;
}
__device__ __forceinline__ void xcd_barrier(const XcdBarrier& b) {
    asm volatile("s_waitcnt vmcnt(0)" ::: "memory");
    __syncthreads();
    if (threadIdx.x == 0) {
        unsigned* bar = b.bar;
        __builtin_amdgcn_s_waitcnt(0);
        unsigned nloc = b.st[0], nx = b.st[1];
        if (nloc == 0u) { xcd_barrier_complete(bar, b.x, nloc, nx); b.st[0] = nloc; b.st[1] = nx; }
        const unsigned old = xb_add(&bar[XB_XSUB(b.x)], 1u);
        const unsigned gen = old / nloc;
        if (old + 1u == (gen + 1u) * nloc) {
            __builtin_amdgcn_fence(__ATOMIC_RELEASE, "agent");
            asm volatile("s_waitcnt vmcnt(0)" ::: "memory");
            const unsigned og = xb_add(&bar[XB_TOP], 1u);
            const unsigned tg = og / nx;
            if (og + 1u == (tg + 1u) * nx) xb_add(&bar[XB_TOPGEN], 1u);
            else XB_SPIN(xb_ld(&bar[XB_TOPGEN]) == tg, bar);
            __builtin_amdgcn_fence(__ATOMIC_ACQUIRE, "agent");
            xb_add(&bar[XB_XGEN(b.x)], 1u);
            asm volatile("s_waitcnt vmcnt(0)" ::: "memory");
        } else {
            XB_SPIN(xb_ld(&bar[XB_XGEN(b.x)]) == gen, bar);
            __builtin_amdgcn_fence(__ATOMIC_ACQUIRE, "agent");
            asm volatile("s_waitcnt vmcnt(0)" ::: "memory");
        }
    }
    __syncthreads();
}

struct Args { const float* in[30]; float* out; unsigned char* ws; int ph_lo, ph_hi; };
typedef const __attribute__((address_space(4))) Args* ArgP;
enum { I_X = 0, I_C, I_CTX, I_CCTX, I_LBLOG, I_RW, I_RB, I_FINALG, I_WMOD, I_BMOD, I_GMIX, I_GFFN, I_WIN, I_CONVW, I_CONVB, I_CLNG, I_CLNB, I_HGNG,
       I_GLW2, I_GLB2, I_GLNG, I_SINK, I_WBRC, I_WBRH, I_WBRG, I_WBRA, I_WOUT, I_W1, I_W3, I_W2 };

__device__ __forceinline__ int row_cond(int row) { const int b = row / RB, j = row - b * RB; return j < CTXL ? 2 : b; }

__device__ __forceinline__ void transpose_item(const float* W, int N, bf16* WT, int ldt, int koff, int mode, LAS float* scr, int kb, int nb, int lane) {
    const int k0 = 64 * kb, n0 = 32 * nb;
#pragma unroll 8
    for (int i = 0; i < 32; ++i) { const int kk = 2 * i + (lane >> 5); scr[kk * 33 + (lane & 31)] = W[(size_t)(k0 + kk) * N + n0 + (lane & 31)]; }
    asm volatile("s_waitcnt lgkmcnt(0)" ::: "memory");
    const int c = lane & 7;
    const int nd0 = (mode == 0) ? n0 : ((n0 >> 7) * 256 + (mode == 2 ? 128 : 0) + (n0 & 127));
#pragma unroll
    for (int j = 0; j < 4; ++j) { const int n = (lane >> 3) + 8 * j; const LAS float* s = scr + (8 * c) * 33 + n;
        u32x4 o; o.x = pk2(s[0 * 33], s[1 * 33]); o.y = pk2(s[2 * 33], s[3 * 33]); o.z = pk2(s[4 * 33], s[5 * 33]); o.w = pk2(s[6 * 33], s[7 * 33]);
        *(u32x4*)(WT + (size_t)(nd0 + n) * ldt + koff + k0 + 8 * c) = o; }
    asm volatile("s_waitcnt lgkmcnt(0)" ::: "memory");
}
__device__ __forceinline__ void convert_weights(ArgP ap, int l, LAS unsigned char* lds, int gw, int NGW, int wave, int lane) {
    LAS float* scr = (LAS float*)(lds + wave * 16384);
    unsigned char* ws = ap->ws;
    bf16* WIN = (bf16*)(ws + WS_WIN); bf16* WBR = (bf16*)(ws + WS_WBR); bf16* WOUT = (bf16*)(ws + WS_WOUT); bf16* W13 = (bf16*)(ws + WS_W13); bf16* W2 = (bf16*)(ws + WS_W2);
    constexpr int I_IN = 16 * 225, I_BR = 4 * 32, I_O = 16 * 32, I_E = 16 * 32;
    constexpr int NITEMS = I_IN + 4 * I_BR + I_O + 48 * I_E;
    for (int it = gw; it < NITEMS; it += NGW) {
        int r = it;
        if (r < I_IN) { const int nb = r % 225; if (nb == W_IN_A / 32) continue; transpose_item(ap->in[I_WIN] + (size_t)l * DM * W_IN_COLS, W_IN_COLS, nb > W_IN_A / 32 ? WIN - 32 * DM : WIN, DM, 0, 0, scr, r / 225, nb, lane); continue; } r -= I_IN;
        if (r < 4 * I_BR) { const int br = r / I_BR, q = r % I_BR; transpose_item(ap->in[I_WBRC + br] + (size_t)l * 256 * DM, DM, WBR, DM, 256 * br, 0, scr, q / 32, q % 32, lane); continue; } r -= 4 * I_BR;
        if (r < I_O) { transpose_item(ap->in[I_WOUT] + (size_t)l * DM * DM, DM, WOUT, DM, 0, 0, scr, r / 32, r % 32, lane); continue; } r -= I_O;
        const int mat = r / I_E, q = r % I_E;
        const int e = mat / 3, wh = mat % 3;
        const size_t eoff = ((size_t)l * NEXP + e) * DM * DM;
        if (wh == 0) transpose_item(ap->in[I_W1] + eoff, DM, W13 + (size_t)e * 2048 * DM, DM, 0, 1, scr, q / 32, q % 32, lane);
        else if (wh == 1) transpose_item(ap->in[I_W3] + eoff, DM, W13 + (size_t)e * 2048 * DM, DM, 0, 2, scr, q / 32, q % 32, lane);
        else transpose_item(ap->in[I_W2] + eoff, DM, W2 + (size_t)e * DM * DM, DM, 0, 0, scr, q / 32, q % 32, lane);
    }
    for (int it = gw; it < 256 * 16; it += NGW) { const int n = it >> 4, k = (it & 15) * 64 + lane, dir = n >> 7, c = n & 127;
        const float* wa = ap->in[I_WIN] + ((size_t)l * DM + k) * W_IN_COLS + W_IN_A + 16 * dir; const float* w2 = ap->in[I_GLW2] + (size_t)(l * 2 + dir) * 16 * 128 + c;
        float s = 0.f;
#pragma unroll
        for (int q = 0; q < 4; ++q) { const f32x4 a4 = *(const f32x4*)(wa + 4 * q); s += a4.x * w2[(4 * q) * 128] + a4.y * w2[(4 * q + 1) * 128] + a4.z * w2[(4 * q + 2) * 128] + a4.w * w2[(4 * q + 3) * 128]; }
        WIN[(size_t)(C_GLU + n) * DM + k] = (bf16)(pk2(s, 0.f) & 0xffffu); }
}

__device__ __forceinline__ void modnorm_store(const f32x4 (&v)[4], const float* g, const float* shift, const float* scale, bf16* orow, int lane) {
    float ss = 0.f;
#pragma unroll
    for (int j = 0; j < 4; ++j) ss += (v[j].x * v[j].x + v[j].y * v[j].y) + (v[j].z * v[j].z + v[j].w * v[j].w);
    const float rstd = rsqrtf(wave_sum(ss) * (1.f / DM) + EPS);
#pragma unroll
    for (int j = 0; j < 4; ++j) { const int c = 4 * lane + 256 * j;
        const f32x4 gg = *(const f32x4*)(g + c), sh = *(const f32x4*)(shift + c), sc = *(const f32x4*)(scale + c);
        const f32x4 y = (v[j] * rstd) * gg * (sc + 1.0f) + sh;
        u32x2 w; w.x = pk2(y.x, y.y); w.y = pk2(y.z, y.w); *(u32x2*)(orow + c) = w; }
}

__device__ __forceinline__ void attn_unit(const bf16* P, bf16* Y, const float* COS, const float* SIN, const float* sinkp, int b, int kvh, int qblk, bool ctxq, LAS unsigned char* lds, int tid, int wave, int lane) {
    LAS bf16* KS = (LAS bf16*)lds;
    LAS bf16* VT = (LAS bf16*)(lds + 64 * 72 * 2);
    const int fr = lane & 15, fq = lane >> 4;
    const int hq = kvh * 2 + (wave >> 2);
    const int t0 = qblk * 128, tq0 = t0 + (wave & 3) * 32;
    const size_t rowbase = (size_t)b * RB + (ctxq ? 0 : CTXL);
    bf16x8 qf[2][2];
#pragma unroll
    for (int qt = 0; qt < 2; ++qt)
#pragma unroll
        for (int ks = 0; ks < 2; ++ks) {
            const int tq = tq0 + 16 * qt + fr, dch = 4 * ks + fq;
            const bf16* qp = P + (rowbase + tq) * LDP + C_ATQ + hq * 64;
            const u32x4 own = *(const u32x4*)(qp + 8 * dch), oth = *(const u32x4*)(qp + 8 * (dch ^ 2));
            float o[8], p[8], r[8];
            o[0] = bflo(own.x); o[1] = bfhi(own.x); o[2] = bflo(own.y); o[3] = bfhi(own.y); o[4] = bflo(own.z); o[5] = bfhi(own.z); o[6] = bflo(own.w); o[7] = bfhi(own.w);
            p[0] = bflo(oth.x); p[1] = bfhi(oth.x); p[2] = bflo(oth.y); p[3] = bfhi(oth.y); p[4] = bflo(oth.z); p[5] = bfhi(oth.z); p[6] = bflo(oth.w); p[7] = bfhi(oth.w);
            if (!ctxq) {
                const int ci = tq * 32 + (dch >> 2) * 16 + (dch & 1) * 8;
#pragma unroll
                for (int j = 0; j < 8; ++j) { const float c = COS[ci + j], s = SIN[ci + j]; r[j] = (dch & 2) ? (p[j] * s + o[j] * c) : (o[j] * c - p[j] * s); }
            } else {
#pragma unroll
                for (int j = 0; j < 8; ++j) r[j] = o[j];
            }
            u32x4 w; w.x = pk2(r[0] * 0.125f, r[1] * 0.125f); w.y = pk2(r[2] * 0.125f, r[3] * 0.125f); w.z = pk2(r[4] * 0.125f, r[5] * 0.125f); w.w = pk2(r[6] * 0.125f, r[7] * 0.125f);
            qf[qt][ks] = __builtin_bit_cast(bf16x8, w);
        }
    f32x4 ot[4][2];
#pragma unroll
    for (int dt = 0; dt < 4; ++dt)
#pragma unroll
        for (int qt = 0; qt < 2; ++qt) ot[dt][qt] = (f32x4){0.f, 0.f, 0.f, 0.f};
    float mrun[2] = {-1e30f, -1e30f}, lrun[2] = {0.f, 0.f};
    const int ntile = ctxq ? 4 : 10;
    for (int ti = 0; ti < ntile; ++ti) {
        const bool band = (!ctxq) && ti < 6;
        const int s0 = band ? (t0 - 128 + 64 * ti) : 64 * (ctxq ? ti : ti - 6);
        if (band && (s0 < 0 || s0 >= SEQ)) continue;
        __syncthreads();
        {
            const int key = tid >> 3, dch = tid & 7;
            const bf16* kp = P + ((size_t)b * RB + (band ? CTXL : 0) + s0 + key) * LDP;
            const u32x4 own = *(const u32x4*)(kp + C_ATK + kvh * 64 + 8 * dch);
            u32x4 kw = own;
            if (band) {
                const u32x4 oth = *(const u32x4*)(kp + C_ATK + kvh * 64 + 8 * (dch ^ 2));
                float o[8], p[8], r[8];
                o[0] = bflo(own.x); o[1] = bfhi(own.x); o[2] = bflo(own.y); o[3] = bfhi(own.y); o[4] = bflo(own.z); o[5] = bfhi(own.z); o[6] = bflo(own.w); o[7] = bfhi(own.w);
                p[0] = bflo(oth.x); p[1] = bfhi(oth.x); p[2] = bflo(oth.y); p[3] = bfhi(oth.y); p[4] = bflo(oth.z); p[5] = bfhi(oth.z); p[6] = bflo(oth.w); p[7] = bfhi(oth.w);
                const int ci = (s0 + key) * 32 + (dch >> 2) * 16 + (dch & 1) * 8;
#pragma unroll
                for (int j = 0; j < 8; ++j) { const float c = COS[ci + j], s = SIN[ci + j]; r[j] = (dch & 2) ? (p[j] * s + o[j] * c) : (o[j] * c - p[j] * s); }
                kw.x = pk2(r[0], r[1]); kw.y = pk2(r[2], r[3]); kw.z = pk2(r[4], r[5]); kw.w = pk2(r[6], r[7]);
            }
            *(LAS u32x4*)(KS + key * 72 + 8 * dch) = kw;
            const u32x4 vw = *(const u32x4*)(kp + C_ATV + kvh * 64 + 8 * dch);
            LAS bf16* vp = VT + (8 * dch) * 72 + key;
            vp[0 * 72] = (bf16)(vw.x & 0xffffu); vp[1 * 72] = (bf16)(vw.x >> 16); vp[2 * 72] = (bf16)(vw.y & 0xffffu); vp[3 * 72] = (bf16)(vw.y >> 16);
            vp[4 * 72] = (bf16)(vw.z & 0xffffu); vp[5 * 72] = (bf16)(vw.z >> 16); vp[6 * 72] = (bf16)(vw.w & 0xffffu); vp[7 * 72] = (bf16)(vw.w >> 16);
        }
        __syncthreads();
        f32x4 st[4][2];
#pragma unroll
        for (int kt = 0; kt < 4; ++kt) {
            const bf16x8 ka0 = *(const LAS bf16x8*)(KS + (16 * kt + fr) * 72 + 8 * fq), ka1 = *(const LAS bf16x8*)(KS + (16 * kt + fr) * 72 + 32 + 8 * fq);
#pragma unroll
            for (int qt = 0; qt < 2; ++qt) { f32x4 c = (f32x4){0.f, 0.f, 0.f, 0.f};
                c = __builtin_amdgcn_mfma_f32_16x16x32_bf16(ka0, qf[qt][0], c, 0, 0, 0);
                c = __builtin_amdgcn_mfma_f32_16x16x32_bf16(ka1, qf[qt][1], c, 0, 0, 0);
                st[kt][qt] = c; }
        }
#pragma unroll
        for (int qt = 0; qt < 2; ++qt) {
            const int tq = tq0 + 16 * qt + fr;
            float mx = -1e30f;
#pragma unroll
            for (int kt = 0; kt < 4; ++kt)
#pragma unroll
                for (int j = 0; j < 4; ++j) { const int s = s0 + 16 * kt + 4 * fq + j; const int dd = tq - s; const bool ok = (!band) || (dd <= 128 && dd >= -128);
                    st[kt][qt][j] = ok ? st[kt][qt][j] : -1e30f; mx = fmaxf(mx, st[kt][qt][j]); }
            mx = fmaxf(mx, __shfl_xor(mx, 16)); mx = fmaxf(mx, __shfl_xor(mx, 32));
            const float mnew = fmaxf(mrun[qt], mx), alpha = __expf(mrun[qt] - mnew);
            mrun[qt] = mnew;
            float ps = 0.f;
#pragma unroll
            for (int kt = 0; kt < 4; ++kt)
#pragma unroll
                for (int j = 0; j < 4; ++j) { const float sv = st[kt][qt][j]; const float pv = (sv > -1e29f) ? __expf(sv - mnew) : 0.f; st[kt][qt][j] = pv; ps += pv; }
            lrun[qt] = lrun[qt] * alpha + ps;
#pragma unroll
            for (int dt = 0; dt < 4; ++dt) ot[dt][qt] = ot[dt][qt] * alpha;
        }
#pragma unroll
        for (int kk = 0; kk < 2; ++kk) {
            bf16x8 pb[2];
#pragma unroll
            for (int qt = 0; qt < 2; ++qt) { u32x4 w; w.x = pk2(st[2 * kk][qt][0], st[2 * kk][qt][1]); w.y = pk2(st[2 * kk][qt][2], st[2 * kk][qt][3]);
                w.z = pk2(st[2 * kk + 1][qt][0], st[2 * kk + 1][qt][1]); w.w = pk2(st[2 * kk + 1][qt][2], st[2 * kk + 1][qt][3]); pb[qt] = __builtin_bit_cast(bf16x8, w); }
#pragma unroll
            for (int dt = 0; dt < 4; ++dt) {
                const u32x2 v0 = *(const LAS u32x2*)(VT + (16 * dt + fr) * 72 + 32 * kk + 4 * fq), v1 = *(const LAS u32x2*)(VT + (16 * dt + fr) * 72 + 32 * kk + 16 + 4 * fq);
                u32x4 vw; vw.x = v0.x; vw.y = v0.y; vw.z = v1.x; vw.w = v1.y; const bf16x8 va = __builtin_bit_cast(bf16x8, vw);
#pragma unroll
                for (int qt = 0; qt < 2; ++qt) ot[dt][qt] = __builtin_amdgcn_mfma_f32_16x16x32_bf16(va, pb[qt], ot[dt][qt], 0, 0, 0);
            }
        }
    }
    const float sk = sinkp[hq];
#pragma unroll
    for (int qt = 0; qt < 2; ++qt) {
        float l = lrun[qt]; l += __shfl_xor(l, 16); l += __shfl_xor(l, 32);
        const float mf = fmaxf(mrun[qt], sk); const float a = __expf(mrun[qt] - mf); const float denom = l * a + __expf(sk - mf); const float sc = a / denom;
        const int tq = tq0 + 16 * qt + fr;
        bf16* yp = Y + (rowbase + tq) * DM + 768 + hq * 64 + 4 * fq;
#pragma unroll
        for (int dt = 0; dt < 4; ++dt) { const f32x4 o = ot[dt][qt] * sc; u32x2 w; w.x = pk2(o.x, o.y); w.y = pk2(o.z, o.w); *(u32x2*)(yp + 16 * dt) = w; }
    }
}

__device__ __forceinline__ void conv_unit(const bf16* P, bf16* Y, const float* cw, const float* cb, const float* lng, const float* lnb, int cu, LAS unsigned char* lds, int tid, int wave, int lane) {
    LAS float* Z = (LAS float*)lds;
    LAS float* CO = (LAS float*)(lds + 62 * 256 * 4);
    const int row0 = cu * 32; const int b = row0 / RB, j0 = row0 - b * RB;
    const int seg0 = b * RB + (j0 < CTXL ? 0 : CTXL), seg1 = b * RB + (j0 < CTXL ? CTXL : RB);
    __syncthreads();
    for (int idx = tid; idx < 62 * 32; idx += NTHREADS) { const int tt = idx >> 5, c8 = (idx & 31) * 8; const int row = row0 - 15 + tt; f32x4 z0 = {0.f, 0.f, 0.f, 0.f}, z1 = z0;
        if (row >= seg0 && row < seg1) { const u32x4 av = *(const u32x4*)(P + (size_t)row * LDP + C_CONV + c8), bv = *(const u32x4*)(P + (size_t)row * LDP + C_CONV + 256 + c8);
            z0.x = bflo(av.x) * sigmoidf_(bflo(bv.x)); z0.y = bfhi(av.x) * sigmoidf_(bfhi(bv.x)); z0.z = bflo(av.y) * sigmoidf_(bflo(bv.y)); z0.w = bfhi(av.y) * sigmoidf_(bfhi(bv.y));
            z1.x = bflo(av.z) * sigmoidf_(bflo(bv.z)); z1.y = bfhi(av.z) * sigmoidf_(bfhi(bv.z)); z1.z = bflo(av.w) * sigmoidf_(bflo(bv.w)); z1.w = bfhi(av.w) * sigmoidf_(bfhi(bv.w)); }
        *(LAS f32x4*)(Z + tt * 256 + c8) = z0; *(LAS f32x4*)(Z + tt * 256 + c8 + 4) = z1; }
    __syncthreads();
    { const int c = tid & 255, hf = tid >> 8; float w[31], zr[46];
#pragma unroll
      for (int j = 0; j < 31; ++j) w[j] = cw[j * 256 + c];
#pragma unroll
      for (int i = 0; i < 46; ++i) zr[i] = Z[(hf * 16 + i) * 256 + c];
      const float bias = cb[c];
#pragma unroll
      for (int t = 0; t < 16; ++t) { float s = bias;
#pragma unroll
          for (int j = 0; j < 31; ++j) s += zr[t + j] * w[j];
          CO[(hf * 16 + t) * 256 + c] = s; } }
    __syncthreads();
#pragma unroll
    for (int q = 0; q < 4; ++q) { const int t = wave * 4 + q; const f32x4 x = *(const LAS f32x4*)(CO + t * 256 + 4 * lane);
        const float mu = wave_sum((x.x + x.y) + (x.z + x.w)) * (1.f / 256.f); const f32x4 d = x - mu;
        const float var = wave_sum((d.x * d.x + d.y * d.y) + (d.z * d.z + d.w * d.w)) * (1.f / 256.f); const float rstd = rsqrtf(var + EPS);
        const f32x4 g = *(const f32x4*)(lng + 4 * lane), bb = *(const f32x4*)(lnb + 4 * lane); const f32x4 zn = d * rstd * g + bb;
        u32x2 w; w.x = pk2(siluf_(zn.x), siluf_(zn.y)); w.y = pk2(siluf_(zn.z), siluf_(zn.w));
        *(u32x2*)(Y + (size_t)(row0 + t) * DM + 4 * lane) = w; }
}

typedef short bf16x4 __attribute__((ext_vector_type(4)));
constexpr int SC_LD = 72;
constexpr int SC_DIRB = 4 * 64 * SC_LD * 2 + 4 * 64 * 4;
template <bool HG>
__device__ __forceinline__ void scan_mfma(ArgP ap, int l, int passB, int b, int h, int blk, LAS unsigned char* lds, int tid, int wave, int lane) {
    constexpr int DK = HG ? 64 : 32, NM = DK / 16, NKS = DK / 32;
    unsigned char* ws = ap->ws;
    const bf16* P = (const bf16*)(ws + WS_P); bf16* Y = (bf16*)(ws + WS_Y);
    float* SEGS = (float*)(ws + (HG ? WS_SEGH : WS_SEGG)); float* SEGD = (float*)(ws + (HG ? WS_SEGDH : WS_SEGDG));
    const int dir = wave >> 2, slab = wave & 3, htid = tid & 255, fr = lane & 15, fq = lane >> 4;
    LAS unsigned char* dbase = lds + dir * SC_DIRB;
    LAS bf16* QT = (LAS bf16*)dbase; LAS bf16* KH = QT + 64 * SC_LD; LAS bf16* KBT = KH + 64 * SC_LD; LAS bf16* VT = KBT + 64 * SC_LD; LAS float* EB = (LAS float*)(VT + 64 * SC_LD);
    LAS bf16* OS = (LAS bf16*)(lds + 2 * SC_DIRB);
    const size_t row0 = (size_t)b * RB + blk * 256;
    const int ch = (b * 2 + dir) * 4 + h;
    f32x4 S[NM];
#pragma unroll
    for (int m = 0; m < NM; ++m) S[m] = (f32x4){0.f, 0.f, 0.f, 0.f};
    __syncthreads();
    if (passB) {
        const int npre = (dir == 0) ? blk : (blk == 0 ? 0 : (1 + (NBLK - 1 - blk)));
#pragma unroll 4
        for (int q = 0; q < npre; ++q) { const int i = (dir == 0) ? q : (q == 0 ? 0 : (NBLK - q));
            const float* sp = SEGS + ((size_t)(ch * NBLK + i) * DK + 4 * fq) * 64 + 16 * slab + fr; const float* dp = SEGD + (size_t)(ch * NBLK + i) * DK + 4 * fq;
#pragma unroll
            for (int m = 0; m < NM; ++m) { const f32x4 d = *(const f32x4*)(dp + 16 * m);
#pragma unroll
                for (int j = 0; j < 4; ++j) S[m][j] = d[j] * S[m][j] + sp[(16 * m + j) * 64]; } }
        for (int i = tid; i < 256 * 64 / 2; i += NTHREADS) ((LAS unsigned*)OS)[i] = 0u;
    }
    float Dk = 1.f;
    const int pc = htid >> 6, pk = htid & 63;
    bf16 rz[16], rq[16], ru[16]; u32x4 rv0, rv1;
    const int cu = C_GLU + dir * 128 + h * 32 + pk;
    const int cz = HG ? ((dir ? C_HGFB : C_HGFF) + h * 64 + pk) : (C_GLK + h * 32 + pk), cq = HG ? (C_HGQ + h * 64 + pk) : (C_GLQ + h * 32 + pk);
#define SCAN_LOAD_RAW(gi_) do { const int T0_ = 64 * (dir ? 3 - (gi_) : (gi_)); \
        if (pk < DK) { const bf16* pr_ = P + (row0 + T0_ + 16 * pc) * LDP; \
            _Pragma("unroll") for (int j = 0; j < 16; ++j) { rz[j] = pr_[(size_t)j * LDP + cz]; rq[j] = pr_[(size_t)j * LDP + cq]; if (!HG) ru[j] = pr_[(size_t)j * LDP + cu]; } } \
        { const bf16* vp_ = P + (row0 + T0_ + (htid >> 2)) * LDP + (HG ? C_HGI : C_GLV) + h * 64 + 16 * (htid & 3); rv0 = *(const u32x4*)vp_; rv1 = *(const u32x4*)(vp_ + 8); } } while (0)
    SCAN_LOAD_RAW(0);
    for (int gi = 0; gi < 4; ++gi) {
        const int T0 = 64 * (dir ? 3 - gi : gi);
        __syncthreads();
        if (pk < DK) {
            float f[16], qv[16], kv[16];
            if (HG) {
                const float lbv = ((const float*)(ws + WS_LB))[l * 512 + dir * 256 + h * 64 + pk];
#pragma unroll
                for (int j = 0; j < 16; ++j) { const float z = bf2f(rz[j]); qv[j] = bf2f(rq[j]); const float sg = sigmoidf_(z);
                    f[j] = fmaxf(lbv + (1.f - lbv) * sg, 1e-30f); kv[j] = (1.f - lbv) * (1.f - sg); }
            } else {
                const float b2 = ap->in[I_GLB2][(l * 2 + dir) * 128 + h * 32 + pk];
#pragma unroll
                for (int j = 0; j < 16; ++j) { const float u = bf2f(ru[j]) + b2;
                    const float ls = fminf(u, 0.f) - __logf(1.f + __expf(-fabsf(u)));
                    f[j] = __expf(ls * (1.f / 16.f)); kv[j] = bf2f(rz[j]); qv[j] = bf2f(rq[j]) * 0.17677669529663687f; }
            }
            float pj[16], sf[16];
            if (dir == 0) { float p = 1.f;
#pragma unroll
                for (int j = 0; j < 16; ++j) { p *= f[j]; pj[j] = p; }
                float s = 1.f;
#pragma unroll
                for (int j = 15; j >= 0; --j) { sf[j] = s; s *= f[j]; }
            } else { float p = 1.f;
#pragma unroll
                for (int j = 15; j >= 0; --j) { p *= f[j]; pj[j] = p; }
                float s = 1.f;
#pragma unroll
                for (int j = 0; j < 16; ++j) { sf[j] = s; s *= f[j]; }
            }
            EB[pc * 64 + pk] = dir ? pj[0] : pj[15];
#pragma unroll
            for (int j = 0; j < 16; ++j) { const int t = 16 * pc + j;
                QT[t * SC_LD + pk] = (bf16)(pk2(qv[j] * pj[j], 0.f) & 0xffffu);
                KH[t * SC_LD + pk] = (bf16)(pk2(kv[j] * __builtin_amdgcn_rcpf(fmaxf(pj[j], 1e-30f)), 0.f) & 0xffffu); }
#pragma unroll
            for (int j = 0; j < 16; j += 2) *(LAS unsigned*)(KBT + pk * SC_LD + 16 * pc + j) = pk2(kv[j] * sf[j], kv[j + 1] * sf[j + 1]);
        }
        {
            const int t = htid >> 2, vc = htid & 3;
            const u32x4 v0 = rv0, v1 = rv1;
            LAS bf16* d = VT + (16 * vc) * SC_LD + t;
            d[0 * SC_LD] = (bf16)(v0.x & 0xffffu); d[1 * SC_LD] = (bf16)(v0.x >> 16); d[2 * SC_LD] = (bf16)(v0.y & 0xffffu); d[3 * SC_LD] = (bf16)(v0.y >> 16);
            d[4 * SC_LD] = (bf16)(v0.z & 0xffffu); d[5 * SC_LD] = (bf16)(v0.z >> 16); d[6 * SC_LD] = (bf16)(v0.w & 0xffffu); d[7 * SC_LD] = (bf16)(v0.w >> 16);
            d[8 * SC_LD] = (bf16)(v1.x & 0xffffu); d[9 * SC_LD] = (bf16)(v1.x >> 16); d[10 * SC_LD] = (bf16)(v1.y & 0xffffu); d[11 * SC_LD] = (bf16)(v1.y >> 16);
            d[12 * SC_LD] = (bf16)(v1.z & 0xffffu); d[13 * SC_LD] = (bf16)(v1.z >> 16); d[14 * SC_LD] = (bf16)(v1.w & 0xffffu); d[15 * SC_LD] = (bf16)(v1.w >> 16);
        }
        __syncthreads();
        if (gi < 3) SCAN_LOAD_RAW(gi + 1);
        if (!passB && htid < DK) Dk *= (EB[htid] * EB[64 + htid]) * (EB[128 + htid] * EB[192 + htid]);
        for (int ci = 0; ci < 4; ++ci) {
            const int c = dir ? 3 - ci : ci;
            const bf16x4 vb = *(const LAS bf16x4*)(VT + (16 * slab + fr) * SC_LD + 16 * c + 4 * fq);
            if (passB) {
                f32x4 at = (f32x4){0.f, 0.f, 0.f, 0.f};
                bf16x8 qa[NKS];
#pragma unroll
                for (int ks = 0; ks < NKS; ++ks) {
                    const LAS bf16* qp = QT + (16 * c + fr) * SC_LD + 32 * ks + 4 * fq; const LAS bf16* kp = KH + (16 * c + fr) * SC_LD + 32 * ks + 4 * fq;
                    const u32x2 q0 = *(const LAS u32x2*)qp, q1 = *(const LAS u32x2*)(qp + 16), k0 = *(const LAS u32x2*)kp, k1 = *(const LAS u32x2*)(kp + 16);
                    u32x4 qw; qw.x = q0.x; qw.y = q0.y; qw.z = q1.x; qw.w = q1.y; u32x4 kw; kw.x = k0.x; kw.y = k0.y; kw.z = k1.x; kw.w = k1.y;
                    qa[ks] = __builtin_bit_cast(bf16x8, qw);
                    at = __builtin_amdgcn_mfma_f32_16x16x32_bf16(__builtin_bit_cast(bf16x8, kw), qa[ks], at, 0, 0, 0);
                }
                asm volatile("s_nop 15\n\ts_nop 15" : "+v"(at));
#pragma unroll
                for (int j = 0; j < 4; ++j) { const int sidx = 4 * fq + j; const bool keep = dir ? (sidx >= fr) : (sidx <= fr); at[j] = keep ? at[j] : 0.f; }
                u32x2 pw; pw.x = pk2(at[0], at[1]); pw.y = pk2(at[2], at[3]);
                f32x4 o = __builtin_amdgcn_mfma_f32_16x16x16bf16_1k(__builtin_bit_cast(bf16x4, pw), vb, (f32x4){0.f, 0.f, 0.f, 0.f}, 0, 0, 0);
                asm volatile("s_nop 15\n\ts_nop 15" : "+v"(o));
#pragma unroll
                for (int ks = 0; ks < NKS; ++ks) { u32x4 sw; sw.x = pk2(S[2 * ks][0], S[2 * ks][1]); sw.y = pk2(S[2 * ks][2], S[2 * ks][3]); sw.z = pk2(S[2 * ks + 1][0], S[2 * ks + 1][1]); sw.w = pk2(S[2 * ks + 1][2], S[2 * ks + 1][3]);
                    o = __builtin_amdgcn_mfma_f32_16x16x32_bf16(qa[ks], __builtin_bit_cast(bf16x8, sw), o, 0, 0, 0); }
                asm volatile("s_nop 15\n\ts_nop 15" : "+v"(o));
                LAS bf16* op = OS + (T0 + 16 * c + 4 * fq) * 64 + 16 * slab + fr;
#pragma unroll
                for (int j = 0; j < 4; ++j) op[j * 64] = (bf16)(pk2(bf2f(op[j * 64]) + o[j], 0.f) & 0xffffu);
            }
#pragma unroll
            for (int m = 0; m < NM; ++m) { const f32x4 eb = *(const LAS f32x4*)(EB + c * 64 + 16 * m + 4 * fq);
                const bf16x4 kb = *(const LAS bf16x4*)(KBT + (16 * m + fr) * SC_LD + 16 * c + 4 * fq);
                S[m] = __builtin_amdgcn_mfma_f32_16x16x16bf16_1k(kb, vb, S[m] * eb, 0, 0, 0); asm volatile("s_nop 15\n\ts_nop 15" : "+v"(S[m])); }
        }
    }
    if (!passB) {
        float* sp = SEGS + ((size_t)(ch * NBLK + blk) * DK + 4 * fq) * 64 + 16 * slab + fr;
#pragma unroll
        for (int m = 0; m < NM; ++m)
#pragma unroll
            for (int j = 0; j < 4; ++j) sp[(16 * m + j) * 64] = S[m][j];
        if (htid < DK) SEGD[(size_t)(ch * NBLK + blk) * DK + htid] = Dk;
    } else {
        __syncthreads();
        const float* ng = ap->in[HG ? I_HGNG : I_GLNG] + l * 256 + h * 64; const int gcol = (HG ? C_HGG : C_GLG) + h * 64, ycol = (HG ? 256 : 512) + h * 64;
        const float gn = ng[lane];
#pragma unroll 8
        for (int q = 0; q < 32; ++q) { const int tok = wave * 32 + q; const float o = bf2f(OS[tok * 64 + lane]);
            const float ss = wave_sum(o * o); const float gt = bf2f(P[(row0 + tok) * LDP + gcol + lane]);
            const float y = o * rsqrtf(ss * (1.f / 64.f) + EPS) * gn * siluf_(gt);
            Y[(row0 + tok) * DM + ycol + lane] = (bf16)(pk2(y, 0.f) & 0xffffu); }
    }
}

#define IN(k) (lo <= (k) && (k) < hi)
#if MK_N_LAUNCHES == 1
#define SEAM(k) do { if (IN(k) && IN((k) + 1)) xcd_barrier(bar); } while (0)
#else
#define SEAM(k) do { } while (0)
#endif
#define PHASE_BEGIN \
    int lane; asm volatile("v_mbcnt_lo_u32_b32 %0, -1, 0\n\tv_mbcnt_hi_u32_b32 %0, -1, %0" : "=v"(lane)); const int wave = wave0; const int tid = wave * 64 + lane; \
    const int gw = bid * NWAVES + wave, NGW = G * NWAVES; (void)gw; (void)NGW; (void)lane; \
    ArgP ap = (ArgP)__builtin_amdgcn_kernarg_segment_ptr(); asm volatile("" : "+s"(ap)); \
    unsigned char* ws = ap->ws; \
    float* XL = (float*)(ws + WS_XL); bf16* H = (bf16*)(ws + WS_H); bf16* Y = (bf16*)(ws + WS_Y); bf16* P = (bf16*)(ws + WS_P); \
    float* MP = (float*)(ws + WS_MP); float* MOD = (float*)(ws + WS_MOD); float* LB = (float*)(ws + WS_LB); \
    float* COS = (float*)(ws + WS_ROPE); float* SIN = COS + SEQ * 32; \
    int* RL = (int*)(ws + WS_RL); float* SG = (float*)(ws + WS_SG); \
    bf16* XS = (bf16*)(ws + WS_XS); bf16* ACT = (bf16*)(ws + WS_ACT); bf16* YS = (bf16*)(ws + WS_YS); \
    (void)XL; (void)H; (void)Y; (void)P; (void)MP; (void)MOD; (void)LB; (void)COS; (void)SIN; (void)RL; (void)SG; (void)XS; (void)ACT; (void)YS;


template <int l>
__device__ __forceinline__ void layer_phases(const int lo, const int hi, LAS unsigned char* lds, const int bid, const int G, const int wave0, const XcdBarrier& bar) {
        constexpr int pb = 3 + 10 * l;
        if (IN(pb + 0)) for (int rep = 0; rep < REP(0); ++rep) {
            PHASE_BEGIN
            const float* MODL = MOD + (size_t)l * 3 * 6144; unsigned* cnt = (unsigned*)(ws + WS_CTL) + CW_CNT + l * 16 * 64; (void)MODL; (void)cnt;
            pg8::Gemm g{H, (const bf16*)(ws + WS_WIN), DM, DM, DM}; pg8::StaticOrder S; S.init(R, LDP, G, bid);
            pg8::EpiStoreBf16 E{P, LDP};
            pg8::gemm_phase<pg8::EpiStoreBf16, pg8::StaticOrder, true, true>(lds, g, S, E, tid);
        }
        SEAM(pb + 0);
        if (IN(pb + 1)) for (int rep = 0; rep < REP(1); ++rep) {
            PHASE_BEGIN
            const float* MODL = MOD + (size_t)l * 3 * 6144; unsigned* cnt = (unsigned*)(ws + WS_CTL) + CW_CNT + l * 16 * 64; (void)MODL; (void)cnt;
            constexpr int n_hg = 2 * 4 * NBLK, n_ctxatt = (l == 0 ? 8 : 0), total = 256 + n_hg + n_ctxatt + n_hg;
            unsigned* qctr = (unsigned*)(ws + WS_CTL) + CW_Q + ((l * 2 + 0) * 2 + rep) * 64;
            volatile LAS unsigned* MQ = (volatile LAS unsigned*)(lds + MISC_OFF) + 16;
            for (;;) {
                __syncthreads(); if (tid == 0) MQ[0] = atomicAdd(qctr, 1u); __syncthreads();
                int it = (int)MQ[0]; if (it >= total) break;
                if (it < 256) { const int b = it >> 7, kvh = (it >> 6) & 1, qb = it & 63; for (int ur = 0; ur < UREP(0); ++ur) attn_unit(P, Y, COS, SIN, ap->in[I_SINK] + l * 4, b, kvh, qb, false, lds, tid, wave, lane); continue; }
                it -= 256;
                if (it < n_hg) { for (int ur = 0; ur < UREP(1); ++ur) scan_mfma<true>(ap, l, 0, it / (4 * NBLK), (it / NBLK) & 3, it % NBLK, lds, tid, wave, lane); continue; }
                it -= n_hg;
                if (it < n_ctxatt) { attn_unit(P, Y, COS, SIN, ap->in[I_SINK] + l * 4, it >> 2, (it >> 1) & 1, it & 1, true, lds, tid, wave, lane); continue; }
                it -= n_ctxatt;
                for (int ur = 0; ur < UREP(1); ++ur) scan_mfma<false>(ap, l, 0, it / (4 * NBLK), (it / NBLK) & 3, it % NBLK, lds, tid, wave, lane);
            }
        }
        SEAM(pb + 1);
        if (IN(pb + 2)) for (int rep = 0; rep < REP(2); ++rep) {
            PHASE_BEGIN
            const float* MODL = MOD + (size_t)l * 3 * 6144; unsigned* cnt = (unsigned*)(ws + WS_CTL) + CW_CNT + l * 16 * 64; (void)MODL; (void)cnt;
            constexpr int n_hg = 2 * 4 * NBLK, n_conv = R / 32, total = 2 * n_hg + n_conv;
            unsigned* qctr = (unsigned*)(ws + WS_CTL) + CW_Q + ((l * 2 + 1) * 2 + rep) * 64;
            volatile LAS unsigned* MQ = (volatile LAS unsigned*)(lds + MISC_OFF) + 16;
            for (;;) {
                __syncthreads(); if (tid == 0) MQ[0] = atomicAdd(qctr, 1u); __syncthreads();
                int it = (int)MQ[0]; if (it >= total) break;
                if (it < n_hg) { for (int ur = 0; ur < UREP(2); ++ur) scan_mfma<true>(ap, l, 1, it / (4 * NBLK), (it / NBLK) & 3, it % NBLK, lds, tid, wave, lane); continue; }
                it -= n_hg;
                if (it < n_hg) { for (int ur = 0; ur < UREP(2); ++ur) scan_mfma<false>(ap, l, 1, it / (4 * NBLK), (it / NBLK) & 3, it % NBLK, lds, tid, wave, lane); continue; }
                it -= n_hg;
                for (int ur = 0; ur < UREP(3); ++ur) conv_unit(P, Y, ap->in[I_CONVW] + l * 31 * 256, ap->in[I_CONVB] + l * 256, ap->in[I_CLNG] + l * 256, ap->in[I_CLNB] + l * 256, it, lds, tid, wave, lane);
            }
        }
        SEAM(pb + 2);
        if (IN(pb + 3)) for (int rep = 0; rep < REP(3); ++rep) {
            PHASE_BEGIN
            const float* MODL = MOD + (size_t)l * 3 * 6144; unsigned* cnt = (unsigned*)(ws + WS_CTL) + CW_CNT + l * 16 * 64; (void)MODL; (void)cnt;
            pg8::MergeOrder S; S.S.init(R, DM, G, bid);
            pg8::Gemm g{Y, (const bf16*)(ws + WS_WBR), DM, DM, 256}; pg8::EpiMerge E{P, H};
            pg8::gemm_phase<pg8::EpiMerge, pg8::MergeOrder, true, true>(lds, g, S, E, tid);
        }
        SEAM(pb + 3);
        if (IN(pb + 4)) for (int rep = 0; rep < REP(4); ++rep) {
            PHASE_BEGIN
            const float* MODL = MOD + (size_t)l * 3 * 6144; unsigned* cnt = (unsigned*)(ws + WS_CTL) + CW_CNT + l * 16 * 64; (void)MODL; (void)cnt;
            pg8::Gemm g{H, (const bf16*)(ws + WS_WOUT), DM, DM, DM}; pg8::StaticOrder S; S.init(R, DM, G, bid);
            pg8::EpiOut E{XL, MODL};
            pg8::gemm_phase<pg8::EpiOut, pg8::StaticOrder, true, true>(lds, g, S, E, tid);
        }
        SEAM(pb + 4);
        if (IN(pb + 5)) for (int rep = 0; rep < REP(5); ++rep) {
            PHASE_BEGIN
            const float* MODL = MOD + (size_t)l * 3 * 6144; unsigned* cnt = (unsigned*)(ws + WS_CTL) + CW_CNT + l * 16 * 64; (void)MODL; (void)cnt;
            LAS float* RW = (LAS float*)lds;
            __syncthreads();
            for (int idx = tid; idx < 16 * DM; idx += NTHREADS) { const int e = idx >> 10, d = idx & 1023; RW[idx] = ap->in[I_RW][d * 16 + e]; }
            __syncthreads();
            LAS unsigned* LC = (LAS unsigned*)(lds + 65536);
            LAS unsigned* LR = LC + 32;
            const int rpw = (R + G - 1) / G, rbeg = bid * rpw, rend = (rbeg + rpw < R) ? rbeg + rpw : R;
            if (tid < 32) LC[tid] = 0u;
            __syncthreads();
            for (int row = rbeg + wave; row < rend; row += NWAVES) { const int cond = row_cond(row); if (l == 1 && cond == 2) continue;
                asm volatile("" ::: "memory");
                const f32x4* x4 = (const f32x4*)(XL + (size_t)row * DM); f32x4 v[4]; float ss = 0.f;
#pragma unroll
                for (int q = 0; q < 4; ++q) { v[q] = x4[lane + 64 * q]; ss += (v[q].x * v[q].x + v[q].y * v[q].y) + (v[q].z * v[q].z + v[q].w * v[q].w); }
                const float rstd = rsqrtf(wave_sum(ss) * (1.f / DM) + EPS);
                const float* md = MODL + (size_t)cond * 6144; const float* gf = ap->in[I_GFFN] + l * DM;
#pragma unroll
                for (int q = 0; q < 4; ++q) { const int c = 4 * lane + 256 * q; const f32x4 gg = *(const f32x4*)(gf + c), sh = *(const f32x4*)(md + 3 * DM + c), sc = *(const f32x4*)(md + 4 * DM + c);
                    v[q] = (v[q] * rstd) * gg * (sc + 1.0f) + sh; u32x2 w; w.x = pk2(v[q].x, v[q].y); w.y = pk2(v[q].z, v[q].w); *(u32x2*)(H + (size_t)row * DM + c) = w; }
                float af[16];
#pragma unroll
                for (int e = 0; e < 16; ++e) { float s = 0.f;
#pragma unroll
                    for (int q = 0; q < 4; ++q) { const f32x4 w = *(const LAS f32x4*)(RW + e * DM + 4 * lane + 256 * q); s += (v[q].x * w.x + v[q].y * w.y) + (v[q].z * w.z + v[q].w * w.w); }
                    af[e] = sigmoidf_(wave_sum(s)); }
                float bestsum = -1e30f; int e0 = 0, e1 = 1; float a0 = 0.f, a1 = 0.f;
#pragma unroll
                for (int gI = 0; gI < 4; ++gI) { float m1 = -1e30f, m2 = -1e30f; int i1 = 0, i2 = 0; float f1 = 0.f, f2 = 0.f;
#pragma unroll
                    for (int i = 0; i < 4; ++i) { const float bv = af[gI * 4 + i] + ap->in[I_RB][gI * 4 + i];
                        if (bv > m1) { m2 = m1; i2 = i1; f2 = f1; m1 = bv; i1 = gI * 4 + i; f1 = af[gI * 4 + i]; } else if (bv > m2) { m2 = bv; i2 = gI * 4 + i; f2 = af[gI * 4 + i]; } }
                    const float gs = m1 + m2; if (gs > bestsum) { bestsum = gs; e0 = i1; e1 = i2; a0 = f1; a1 = f2; } }
                if (lane == 0) { const float inv = 1.f / (a0 + a1);
                    const unsigned r0 = __hip_atomic_fetch_add(LC + e0, 1u, __ATOMIC_RELAXED, __HIP_MEMORY_SCOPE_WORKGROUP), r1 = __hip_atomic_fetch_add(LC + e1, 1u, __ATOMIC_RELAXED, __HIP_MEMORY_SCOPE_WORKGROUP);
                    LR[(row - rbeg) * 2] = ((unsigned)e0 << 24) | r0; LR[(row - rbeg) * 2 + 1] = ((unsigned)e1 << 24) | r1;
                    SG[row * 2] = a0 * inv; SG[row * 2 + 1] = a1 * inv; }
            }
            __syncthreads();
            if (tid < 16) LC[16 + tid] = atomicAdd(cnt + tid * 64, LC[tid]);
            __syncthreads();
            for (int i = tid; i < (rend - rbeg) * 2; i += NTHREADS) { const int row = rbeg + (i >> 1); if (l == 1 && row_cond(row) == 2) continue;
                const unsigned w = LR[i]; const unsigned e = w >> 24; RL[(size_t)e * RLCAP + LC[16 + e] + (w & 0xffffffu)] = row * 2 + (i & 1); }
        }
        SEAM(pb + 5);
        if (IN(pb + 6)) for (int rep = 0; rep < REP(6); ++rep) {
            PHASE_BEGIN
            const float* MODL = MOD + (size_t)l * 3 * 6144; unsigned* cnt = (unsigned*)(ws + WS_CTL) + CW_CNT + l * 16 * 64; (void)MODL; (void)cnt;
            int bs[NEXP + 1]; bs[0] = 0;
#pragma unroll
            for (int e = 0; e < NEXP; ++e) bs[e + 1] = bs[e] + (int)((cnt[e * 64] + 255u) >> 8);
            const int nrows = bs[NEXP] * 256;
            for (int cr = gw; cr < nrows; cr += NGW) { const int cb = cr >> 8; int e = 0, jb = 0;
#pragma unroll
                for (int q = 1; q < NEXP; ++q) if (cb >= bs[q]) { e = q; jb = bs[q]; }
                const int rank = (cb - jb) * 256 + (cr & 255);
                u32x4 v0 = {0u, 0u, 0u, 0u}, v1 = v0;
                if (rank < (int)cnt[e * 64]) { const int tok = RL[(size_t)e * RLCAP + rank] >> 1; const u32x4* s = (const u32x4*)(H + (size_t)tok * DM); v0 = s[lane]; v1 = s[lane + 64]; }
                u32x4* d = (u32x4*)(XS + (size_t)cr * DM); d[lane] = v0; d[lane + 64] = v1; }
        }
        SEAM(pb + 6);
        if (IN(pb + 7)) for (int rep = 0; rep < REP(7); ++rep) {
            PHASE_BEGIN
            const float* MODL = MOD + (size_t)l * 3 * 6144; unsigned* cnt = (unsigned*)(ws + WS_CTL) + CW_CNT + l * 16 * 64; (void)MODL; (void)cnt;
            pg8::Gemm g{XS, (const bf16*)(ws + WS_W13), DM, DM, DM}; pg8::MoeOrder S; S.init(cnt, 8, G, bid);
            pg8::EpiMoe1 E{ACT};
            pg8::gemm_phase<pg8::EpiMoe1, pg8::MoeOrder, true, true>(lds, g, S, E, tid);
        }
        SEAM(pb + 7);
        if (IN(pb + 8)) for (int rep = 0; rep < REP(8); ++rep) {
            PHASE_BEGIN
            const float* MODL = MOD + (size_t)l * 3 * 6144; unsigned* cnt = (unsigned*)(ws + WS_CTL) + CW_CNT + l * 16 * 64; (void)MODL; (void)cnt;
            pg8::Gemm g{ACT, (const bf16*)(ws + WS_W2), DM, DM, DM}; pg8::MoeOrder S; S.init(cnt, 4, G, bid);
            pg8::EpiMoe2 E{YS, RL, cnt};
            pg8::gemm_phase<pg8::EpiMoe2, pg8::MoeOrder, true, true>(lds, g, S, E, tid);
        }
        SEAM(pb + 8);
        if (IN(pb + 9)) for (int rep = 0; rep < REP(9); ++rep) {
            PHASE_BEGIN
            const float* MODL = MOD + (size_t)l * 3 * 6144; unsigned* cnt = (unsigned*)(ws + WS_CTL) + CW_CNT + l * 16 * 64; (void)MODL; (void)cnt;
            for (int row = gw; row < R; row += NGW) { const int cond = row_cond(row); if (l == 1 && cond == 2) continue;
                const float g0 = SG[row * 2], g1 = SG[row * 2 + 1];
                const f32x4* x4 = (const f32x4*)(XL + (size_t)row * DM); const float* gm = MODL + (size_t)cond * 6144 + 5 * DM; f32x4 v[4];
#pragma unroll
                for (int q = 0; q < 4; ++q) { const int c = 4 * lane + 256 * q; const u32x2 y0 = *(const u32x2*)(YS + (size_t)(row * 2) * DM + c), y1 = *(const u32x2*)(YS + (size_t)(row * 2 + 1) * DM + c);
                    f32x4 y; y.x = g0 * bflo(y0.x) + g1 * bflo(y1.x); y.y = g0 * bfhi(y0.x) + g1 * bfhi(y1.x); y.z = g0 * bflo(y0.y) + g1 * bflo(y1.y); y.w = g0 * bfhi(y0.y) + g1 * bfhi(y1.y);
                    v[q] = x4[lane + 64 * q] + *(const f32x4*)(gm + c) * y; }
                if (l == 0) {
                    f32x4* xo = (f32x4*)(XL + (size_t)row * DM);
#pragma unroll
                    for (int q = 0; q < 4; ++q) xo[lane + 64 * q] = v[q];
                    const float* md = MOD + (size_t)(1 * 3 + cond) * 6144;
                    modnorm_store(v, ap->in[I_GMIX] + DM, md, md + DM, H + (size_t)row * DM, lane);
                } else {
                    float ss = 0.f;
#pragma unroll
                    for (int q = 0; q < 4; ++q) ss += (v[q].x * v[q].x + v[q].y * v[q].y) + (v[q].z * v[q].z + v[q].w * v[q].w);
                    const float rstd = rsqrtf(wave_sum(ss) * (1.f / DM) + EPS);
                    const int b = row / RB, t = row - b * RB - CTXL; f32x4* o4 = (f32x4*)(ap->out + ((size_t)b * SEQ + t) * DM);
#pragma unroll
                    for (int q = 0; q < 4; ++q) o4[lane + 64 * q] = v[q] * rstd * *(const f32x4*)(ap->in[I_FINALG] + 4 * lane + 256 * q);
                }
            }
            if (l == 0) { __syncthreads(); convert_weights(ap, 1, lds, gw, NGW, wave, lane); }
        }
        SEAM(pb + 9);
}

__global__ void __launch_bounds__(NTHREADS, 2) fwd(Args a) {
    extern __shared__ __attribute__((aligned(16))) unsigned char lds_raw[];
    LAS unsigned char* lds = (LAS unsigned char*)lds_raw;
    volatile LAS unsigned* MISC = (volatile LAS unsigned*)(lds + MISC_OFF);
    const int tid0 = threadIdx.x; const int wave0 = __builtin_amdgcn_readfirstlane(tid0 >> 6);
    const int G = gridDim.x, bid = blockIdx.x;
    unsigned* ctl = (unsigned*)(a.ws + WS_CTL);
    for (int u = tid0; u < (LDS_BYTES - RING_BYTES) / 4; u += NTHREADS) ((LAS unsigned*)(lds + RING_BYTES))[u] = 0u;
    __syncthreads();
    XcdBarrier bar; bar.bar = ctl + CW_BAR; bar.x = 0; bar.st = nullptr;
#if MK_N_LAUNCHES == 1
    bar = xcd_barrier_post(ctl + CW_BAR, MISC + 8);
#endif
    const int lo = a.ph_lo, hi = a.ph_hi;
    if (IN(0)) for (int rep = 0; rep < REP(10); ++rep) {
        PHASE_BEGIN
        for (int row = gw; row < R; row += NGW) { const int b = row / RB, j = row - b * RB;
            const float* src = (j < CTXL) ? ap->in[I_CTX] + ((size_t)b * CTXL + j) * DM : ap->in[I_X] + ((size_t)b * SEQ + (j - CTXL)) * DM;
            const f32x4* s4 = (const f32x4*)src; f32x4* d4 = (f32x4*)(XL + (size_t)row * DM);
#pragma unroll
            for (int q = 0; q < 4; ++q) d4[lane + 64 * q] = s4[lane + 64 * q]; }
        for (int it = gw; it < 384; it += NGW) { const int l = it / 192, r = it % 192, kc = r / 24, jb = r % 24;
            f32x4 a0 = {0.f, 0.f, 0.f, 0.f}, a1 = a0, a2 = a0;
            const float* wp = ap->in[I_WMOD] + ((size_t)l * DM + kc * 128) * 6144 + jb * 256 + lane * 4;
            for (int k = 0; k < 128; ++k) { const f32x4 w = *(const f32x4*)(wp + (size_t)k * 6144); const int kk = kc * 128 + k;
                const float s0 = siluf_(ap->in[I_C][kk]), s1 = siluf_(ap->in[I_C][DM + kk]), s2 = siluf_(ap->in[I_CCTX][kk]);
                a0 += w * s0; a1 += w * s1; a2 += w * s2; }
            float* mp = MP + ((size_t)(l * 8 + kc) * 3) * 6144 + jb * 256 + lane * 4;
            *(f32x4*)(mp) = a0; *(f32x4*)(mp + 6144) = a1; *(f32x4*)(mp + 2 * 6144) = a2; }
        if (bid == 0) { for (int i = tid; i < 512; i += NTHREADS) { const float x0 = ap->in[I_LBLOG][i], x1 = ap->in[I_LBLOG][512 + i]; const float m = fmaxf(x0, x1);
            const float e0 = expf(x0 - m), e1 = expf(x1 - m); LB[i] = 0.f; LB[512 + i] = e1 / (e0 + e1); } }
        for (int idx = bid * NTHREADS + tid; idx < SEQ * 32; idx += G * NTHREADS) { const int t = idx >> 5, ai = idx & 31; const int ax = ai >> 4, i = ai & 15;
            const float inv = powf(10000.0f, -(float)i / 16.0f); const float pos = (float)(ax == 0 ? (t >> 6) : (t & 63)); const float ang = pos * inv;
            COS[idx] = cosf(ang); SIN[idx] = sinf(ang); }
        convert_weights(ap, 0, lds, gw, NGW, wave, lane);
    }
    SEAM(0);
    if (IN(1)) for (int rep = 0; rep < REP(11); ++rep) {
        PHASE_BEGIN
        for (int idx = bid * NTHREADS + tid; idx < 2 * 3 * 6144; idx += G * NTHREADS) { const int l = idx / (3 * 6144), r = idx % (3 * 6144), cond = r / 6144, j = r % 6144;
            float s = ap->in[I_BMOD][l * 6144 + j];
#pragma unroll
            for (int kc = 0; kc < 8; ++kc) s += MP[((size_t)(l * 8 + kc) * 3 + cond) * 6144 + j];
            MOD[idx] = s; }
    }
    SEAM(1);
    if (IN(2)) for (int rep = 0; rep < REP(12); ++rep) {
        PHASE_BEGIN
        for (int row = gw; row < R; row += NGW) { const int cond = row_cond(row); const f32x4* x4 = (const f32x4*)(XL + (size_t)row * DM); f32x4 v[4];
#pragma unroll
            for (int q = 0; q < 4; ++q) v[q] = x4[lane + 64 * q];
            const float* md = MOD + (size_t)(0 * 3 + cond) * 6144;
            modnorm_store(v, ap->in[I_GMIX], md, md + DM, H + (size_t)row * DM, lane); }
    }
    SEAM(2);

    layer_phases<0>(lo, hi, lds, bid, G, wave0, bar);
    layer_phases<1>(lo, hi, lds, bid, G, wave0, bar);
}

constexpr int NPHASES = 23;
extern "C" void kernel_launch(void* const* d_in, const int* in_sizes, int n_in, void* d_out, int out_size, void* d_ws, size_t ws_size, hipStream_t stream) {
    static int grid = 0;
    if (grid == 0) {
        int dev = 0, cus = 0, per_cu = 0;
        if (hipGetDevice(&dev) != hipSuccess || hipDeviceGetAttribute(&cus, hipDeviceAttributeMultiprocessorCount, dev) != hipSuccess) { grid = -1; return; }
        if (hipFuncSetAttribute((const void*)fwd, hipFuncAttributeMaxDynamicSharedMemorySize, LDS_BYTES) != hipSuccess) { grid = -1; return; }
        if (hipOccupancyMaxActiveBlocksPerMultiprocessor(&per_cu, (const void*)fwd, NTHREADS, LDS_BYTES) != hipSuccess || per_cu < 1) per_cu = 1;
        (void)hipGetLastError();
        grid = cus;
        if (ws_size < WS_END) fprintf(stderr, "kernel_launch: workspace too small: %zu < %zu\n", ws_size, (size_t)WS_END);
    }
    if (grid < 0) return;
    (void)hipMemsetAsync((char*)d_ws + WS_CTL, 0, CTL_ZERO_BYTES, stream);
    Args a{};
    for (int i = 0; i < 30; ++i) a.in[i] = (const float*)d_in[i];
    a.out = (float*)d_out; a.ws = (unsigned char*)d_ws;
#if MK_N_LAUNCHES == 1
    a.ph_lo = 0; a.ph_hi = NPHASES;
    hipLaunchKernelGGL(fwd, dim3(grid), dim3(NTHREADS), LDS_BYTES, stream, a);
#else
    for (int ph = 0; ph < NPHASES; ++ph) { a.ph_lo = ph; a.ph_hi = ph + 1; hipLaunchKernelGGL(fwd, dim3(grid), dim3(NTHREADS), LDS_BYTES, stream, a); }
#endif
}
```

```cpp
#include <hip/hip_runtime.h>
#include <cstdio>
#include <cstdint>

#ifndef PROBE_REP
#define PROBE_REP 0
#endif
#define REP(j) ((((PROBE_REP) >> (j)) & 1) + 1)
#ifndef PROBE_UNIT
#define PROBE_UNIT 0
#endif
#define UREP(j) ((((PROBE_UNIT) >> (j)) & 1) + 1)
#ifndef MK_N_LAUNCHES
#define MK_N_LAUNCHES 1
#endif

#define GAS __attribute__((address_space(1)))
#define LAS __attribute__((address_space(3)))
typedef unsigned short bf16;
typedef short bf16x8 __attribute__((ext_vector_type(8)));
typedef short s16x4 __attribute__((ext_vector_type(4)));
typedef float f32x4 __attribute__((ext_vector_type(4)));
typedef float f32x2 __attribute__((ext_vector_type(2)));
typedef unsigned u32x4 __attribute__((ext_vector_type(4)));
typedef unsigned u32x2 __attribute__((ext_vector_type(2)));
typedef __bf16 bf16x2_t __attribute__((ext_vector_type(2)));

__device__ __forceinline__ unsigned pk2(float lo, float hi) { f32x2 v = {lo, hi}; bf16x2_t b = __builtin_convertvector(v, bf16x2_t); return __builtin_bit_cast(unsigned, b); }
__device__ __forceinline__ float bflo(unsigned w) { return __uint_as_float(w << 16); }
__device__ __forceinline__ float bfhi(unsigned w) { return __uint_as_float(w & 0xffff0000u); }
__device__ __forceinline__ float bf2f(bf16 v) { return __uint_as_float(((unsigned)v) << 16); }
__device__ __forceinline__ float sigmoidf_(float x) { return __builtin_amdgcn_rcpf(1.0f + __expf(-x)); }
__device__ __forceinline__ float siluf_(float x) { return x * __builtin_amdgcn_rcpf(1.0f + __expf(-x)); }
__device__ __forceinline__ float wave_sum(float v) {
#pragma unroll
    for (int o = 1; o < 64; o <<= 1) v += __shfl_xor(v, o);
    return v;
}

constexpr int DM = 1024, NBATCH = 2, SEQ = 8192, CTXL = 256, RB = SEQ + CTXL, R = NBATCH * RB;
constexpr int NBLK = RB / 256;
constexpr int LDP = 7424;
constexpr int C_CONV = 0, C_HGQ = 512, C_HGFF = 768, C_HGFB = 1024, C_HGI = 1280, C_HGG = 1536, C_GLQ = 1792, C_GLK = 1920, C_GLV = 2048,
              C_GLG = 2304, C_ATQ = 2560, C_ATK = 2816, C_ATV = 2944, C_BG = 3072, C_GLU = 7168, W_IN_COLS = 7200, W_IN_A = 2304;
constexpr float EPS = 1e-6f;
constexpr int NEXP = 16, RLCAP = 2 * R;
constexpr int NWAVES = 8, NTHREADS = 512;

constexpr size_t MiB = 1u << 20;
constexpr size_t WS_CTL = 0, CTL_ZERO_BYTES = 1 * MiB;
constexpr size_t WS_MP = 1 * MiB;
constexpr size_t WS_MOD = WS_MP + 1280 * 1024;
constexpr size_t WS_LB = WS_MOD + 256 * 1024;
constexpr size_t WS_ROPE = 3 * MiB;
constexpr size_t WS_RL = 5 * MiB;
constexpr size_t WS_SG = WS_RL + (size_t)NEXP * RLCAP * 4;
constexpr size_t WS_SEGH = 8 * MiB;
constexpr size_t WS_SEGG = WS_SEGH + (size_t)16 * NBLK * 4096 * 4;
constexpr size_t WS_SEGDH = WS_SEGG + (size_t)16 * NBLK * 2048 * 4;
constexpr size_t WS_SEGDG = WS_SEGDH + (size_t)16 * NBLK * 64 * 4;
constexpr size_t WS_WIN = 21 * MiB;
constexpr size_t WS_WBR = 36 * MiB;
constexpr size_t WS_WOUT = 38 * MiB;
constexpr size_t WS_W13 = 40 * MiB;
constexpr size_t WS_W2 = 104 * MiB;
constexpr size_t WS_XL = 136 * MiB;
constexpr size_t WS_H = 202 * MiB;
constexpr size_t WS_Y = 235 * MiB;
constexpr size_t WS_P = 268 * MiB;
constexpr size_t WS_XS = WS_P, WS_ACT = WS_P + 74 * MiB, WS_YS = WS_P + 148 * MiB;
constexpr size_t WS_END = WS_P + (size_t)R * LDP * 2;
static_assert(WS_SEGDG + 16 * NBLK * 32 * 4 <= WS_WIN && WS_END <= 508 * MiB, "ws map");
static_assert((size_t)(2 * R + 16 * 256) * 2048 <= 74 * MiB, "XS fits");
constexpr int CW_BAR = 4096;
constexpr int CW_Q = 8192;
constexpr int CW_CNT = 16384;

constexpr int RING_BYTES = 131072;
constexpr int MISC_OFF = RING_BYTES + 320;
constexpr int LDS_BYTES = 147456;

namespace pg8 {
#define PG8_LAS __attribute__((address_space(3)))
typedef unsigned short bf16_t;
constexpr int BM = 256, BK = 64, HALF = 128, HTB = HALF * BK * 2, STAGE_BYTES = 8 * HTB, NXCD = 8, WGM = 8;
__host__ __device__ __forceinline__ int lds_byte(int r, int c) { const int st = (r >> 4) * 2 + (c >> 5), rr = r & 15, cc = c & 31, ob = rr * 64 + cc * 2; return st * 1024 + (ob ^ (((ob >> 9) & 1) << 5)); }
__host__ __device__ __forceinline__ void stage_rc(int b, int& R_, int& C) { const int st = b / 1024, sb = b % 1024, swz = sb ^ (((sb >> 9) & 1) << 5); R_ = (st >> 1) * 16 + swz / 64; C = (st & 1) * 32 + (swz % 64) / 2; }
__host__ __device__ __forceinline__ int perm32(int rho) { const int n = rho >> 4, i = rho & 15; return 8 * (i >> 2) + 4 * n + (i & 3); }

struct Unit { int pm, pn, pb, aux, kofs; };
struct Gemm { const bf16_t* A; const bf16_t* Bt; int lda, ldb, K; const int* RL; const unsigned* cnt; };

struct StaticOrder {
    int nM, nN, nwg, G, c, skip;
    __host__ __device__ void init(int M, int N, int G_, int c_, int skip_ = 0) { nM = M / BM; nN = N / BM; nwg = nM * nN; G = G_; c = c_; skip = skip_; }
    __host__ __device__ bool next(int i, Unit& u) const {
        const long L = (long)i * G + c; if (L >= nwg) return false;
        int wgid = (int)L; { const int q = nwg / NXCD, r = nwg % NXCD, xcd = wgid % NXCD, off = wgid / NXCD; wgid = (xcd < r ? xcd * (q + 1) : r * (q + 1) + (xcd - r) * q) + off; }
        const int nig = WGM * nN, gid = wgid / nig, fm = gid * WGM, gsz = (nM - fm) < WGM ? (nM - fm) : WGM;
        u.pm = fm + ((wgid % nig) % gsz); u.pn = (wgid % nig) / gsz; u.pb = u.pn; u.aux = 0; u.kofs = 0;
        if (skip) u.pm += 1 + (u.pm >= NBLK - 1 ? 1 : 0);
        return true;
    }
};
struct MoeOrder {
    int bs[NEXP + 1]; int ncol, G, c;
    __device__ __forceinline__ void init(const unsigned* cnt, int ncol_, int G_, int c_) {
        ncol = ncol_; G = G_; c = c_; bs[0] = 0;
#pragma unroll
        for (int e = 0; e < NEXP; ++e) bs[e + 1] = bs[e] + __builtin_amdgcn_readfirstlane((int)((cnt[e * 64] + 255u) >> 8));
    }
    __device__ __forceinline__ bool next(int i, Unit& u) const {
        const int bpr = G / ncol, bpx = bpr >> 3, x = c & 7, j = c >> 3;
        const int cb = i * bpr + x * bpx + j / ncol, pn = j % ncol; if (cb >= bs[NEXP]) return false;
        int e = 0, jb = 0;
#pragma unroll
        for (int q = 1; q < NEXP; ++q) if (cb >= bs[q]) { e = q; jb = bs[q]; }
        u.pm = cb; u.pn = pn; u.pb = e * ncol + pn; u.aux = (e << 16) | (cb - jb); u.kofs = 0; return true;
    }
};
struct MergeOrder {
    StaticOrder S;
    __device__ __forceinline__ bool next(int i, Unit& u) const { if (!S.next(i >> 2, u)) return false; u.aux = i & 3; u.kofs = 256 * (i & 3); return true; }
};

template <class Epi, class Sched, bool GATHER = false>
__device__ __forceinline__ void gemm_phase(PG8_LAS unsigned char* lds, const Gemm g, const Sched& S, const Epi& E, const int tid) {
    constexpr bool ALIGN_EPI = true;
    const int wid = __builtin_amdgcn_readfirstlane(tid >> 6), lane = tid & 63, wr = wid >> 2, wc = wid & 3, fr = lane & 15, fq = lane >> 4;
    const int K = g.K, nt = K / BK;
    const size_t kstep = (size_t)(BK * 2);
    const size_t hstepA = (size_t)HALF * g.lda * 2, hstepB = (size_t)HALF * g.ldb * 2;
    const size_t tstepA = 2 * hstepA, tstepB = 2 * hstepB;
    unsigned voffA[2][2], nvoffA[2][2], voffB[2]; int Rr[2], Cc[2];
#pragma unroll
    for (int i = 0; i < 2; ++i) { int R_, C; stage_rc(tid * 16 + i * 8192, R_, C); const int Rb = Epi::PERM ? ((R_ & ~31) + perm32(R_ & 31)) : R_; Rr[i] = R_; Cc[i] = C;
        voffB[i] = (unsigned)(Rb * g.ldb + C) * 2u;
#pragma unroll
        for (int h = 0; h < 2; ++h) { voffA[h][i] = (unsigned)(R_ * g.lda + C) * 2u + (unsigned)(h * hstepA); nvoffA[h][i] = voffA[h][i]; } }
#define PG8_GATHER(u_, dst_) do { const int e_ = (u_).aux >> 16, jb_ = (u_).aux & 0xffff; const int ne_ = __builtin_amdgcn_readfirstlane((int)g.cnt[e_ * 64]); \
        _Pragma("unroll") for (int h_ = 0; h_ < 2; ++h_) _Pragma("unroll") for (int i_ = 0; i_ < 2; ++i_) { const int rk_ = jb_ * BM + h_ * HALF + Rr[i_]; \
            int tok_ = 0; if (rk_ < ne_) tok_ = g.RL[(size_t)e_ * RLCAP + rk_] >> 1; dst_[h_][i_] = (unsigned)(tok_ * g.lda + Cc[i_]) * 2u; } \
        asm volatile("" : "+v"(dst_[0][0]), "+v"(dst_[0][1]), "+v"(dst_[1][0]), "+v"(dst_[1][1])); } while (0)
    const unsigned ldsw = (unsigned)wid * 1024u;
    const int aoff = lds_byte(wr * 64 + fr, fq * 8), boff = lds_byte(wc * 32 + fr, fq * 8);
#define PG8_SA(b, h) (((b) * 2 + (h)) * HTB)
#define PG8_SB(b, h) ((4 + (b) * 2 + (h)) * HTB)
#define PG8_STAGE(bufoff, gbase, voff) do { _Pragma("unroll") for (int _i = 0; _i < 2; ++_i) \
        __builtin_amdgcn_global_load_lds((const unsigned*)((const char*)(gbase) + (voff)[_i]), (PG8_LAS unsigned*)(lds + (bufoff) + ldsw + _i * 8192), 16, 0, 0); } while (0)
#define PG8_LDA(dst, b, h) do { _Pragma("unroll") for (int m = 0; m < 4; ++m) _Pragma("unroll") for (int k = 0; k < 2; ++k) dst[m][k] = *(const PG8_LAS bf16x8*)(lds + PG8_SA(b, h) + aoff + m * 2048 + k * 1024); } while (0)
#define PG8_LDB(dst, b, h) do { _Pragma("unroll") for (int n = 0; n < 2; ++n) _Pragma("unroll") for (int k = 0; k < 2; ++k) dst[n][k] = *(const PG8_LAS bf16x8*)(lds + PG8_SB(b, h) + boff + n * 2048 + k * 1024); } while (0)
#define PG8_MMA(ai, bj, At, Bt) do { __builtin_amdgcn_s_setprio(1); _Pragma("unroll") for (int m = 0; m < 4; ++m) _Pragma("unroll") for (int n = 0; n < 2; ++n) _Pragma("unroll") for (int k = 0; k < 2; ++k) \
        acc[ai][bj][m][n] = __builtin_amdgcn_mfma_f32_16x16x32_bf16(Bt[n][k], At[m][k], acc[ai][bj][m][n], 0, 0, 0); __builtin_amdgcn_s_setprio(0); } while (0)
#define PG8_WAIT_V(n) asm volatile("s_waitcnt vmcnt(" #n ")" ::: "memory")
#define PG8_WAIT_L(n) asm volatile("s_waitcnt lgkmcnt(" #n ")" ::: "memory")
#define PG8_BAR __builtin_amdgcn_s_barrier()
#define PG8_SCHED __builtin_amdgcn_sched_barrier(0)
    Unit cur, nxt; int ui = 0;
    if (!S.next(0, cur)) return;
    f32x4 acc[2][2][4][2];
#pragma unroll
    for (int a = 0; a < 2; ++a)
#pragma unroll
        for (int b = 0; b < 2; ++b)
#pragma unroll
            for (int m = 0; m < 4; ++m)
#pragma unroll
                for (int n = 0; n < 2; ++n) acc[a][b][m][n] = (f32x4){0.f, 0.f, 0.f, 0.f};
    bf16x8 At[4][2], B0[2][2], B1[2][2];
    const char* cA = (const char*)g.A + (GATHER ? (size_t)0 : (size_t)cur.pm * tstepA) + cur.kofs * 2; const char* cB = (const char*)g.Bt + (size_t)cur.pb * tstepB + cur.kofs * 2;
    if constexpr (GATHER) PG8_GATHER(cur, voffA);
    PG8_STAGE(PG8_SB(0, 0), cB, voffB); PG8_STAGE(PG8_SB(0, 1), cB + hstepB, voffB); PG8_STAGE(PG8_SA(0, 0), cA, voffA[0]); PG8_STAGE(PG8_SA(0, 1), cA, voffA[1]);
    if (wr == 1) PG8_BAR;
    PG8_WAIT_V(2); PG8_BAR;
    PG8_STAGE(PG8_SB(1, 0), cB + kstep, voffB); PG8_STAGE(PG8_SA(1, 0), cA + kstep, voffA[0]); PG8_STAGE(PG8_SB(1, 1), cB + hstepB + kstep, voffB);
    PG8_WAIT_V(6); PG8_BAR;
    for (;;) {
        const bool has_next = S.next(ui + 1, nxt);
        const char* nA = has_next ? (const char*)g.A + (GATHER ? (size_t)0 : (size_t)nxt.pm * tstepA) + nxt.kofs * 2 : cA; const char* nB = has_next ? (const char*)g.Bt + (size_t)nxt.pb * tstepB + nxt.kofs * 2 : cB;
        if constexpr (GATHER) { if (has_next) PG8_GATHER(nxt, nvoffA); else {
#pragma unroll
            for (int h = 0; h < 2; ++h)
#pragma unroll
                for (int i = 0; i < 2; ++i) nvoffA[h][i] = voffA[h][i]; } }
        for (int t = 0; t < nt; t += 2) {
            const bool last = (t == nt - 2);
            const char* a1 = cA + (size_t)(t + 1) * kstep;
            const char* a2 = last ? nA : cA + (size_t)(t + 2) * kstep; const char* b2 = last ? nB : cB + (size_t)(t + 2) * kstep;
            const char* a3 = a2 + kstep; const char* b3 = b2 + kstep;
            unsigned sv[2][2];
#pragma unroll
            for (int h = 0; h < 2; ++h)
#pragma unroll
                for (int i = 0; i < 2; ++i) sv[h][i] = (GATHER && last) ? nvoffA[h][i] : voffA[h][i];
            PG8_LDB(B0, 0, 0); PG8_LDB(B1, 0, 1); PG8_SCHED; PG8_LDA(At, 0, 0); PG8_STAGE(PG8_SA(1, 1), a1, voffA[1]);
            PG8_WAIT_V(8); PG8_WAIT_L(0); PG8_BAR; PG8_MMA(0, 0, At, B0); PG8_MMA(0, 1, At, B1); PG8_BAR; PG8_SCHED;
            PG8_LDA(At, 0, 1); PG8_STAGE(PG8_SB(0, 0), b2, voffB); PG8_STAGE(PG8_SB(0, 1), b2 + hstepB, voffB); PG8_STAGE(PG8_SA(0, 0), a2, sv[0]);
            PG8_WAIT_V(8); PG8_WAIT_L(0); PG8_BAR; PG8_MMA(1, 0, At, B0); PG8_MMA(1, 1, At, B1); PG8_BAR; PG8_SCHED;
            PG8_LDB(B0, 1, 0); PG8_LDB(B1, 1, 1); PG8_SCHED; PG8_LDA(At, 1, 0); PG8_STAGE(PG8_SA(0, 1), a2, sv[1]);
            PG8_WAIT_V(8); PG8_WAIT_L(0); PG8_BAR; PG8_MMA(0, 0, At, B0); PG8_MMA(0, 1, At, B1); PG8_BAR; PG8_SCHED;
            PG8_LDA(At, 1, 1); PG8_STAGE(PG8_SB(1, 0), b3, voffB); PG8_STAGE(PG8_SB(1, 1), b3 + hstepB, voffB); PG8_STAGE(PG8_SA(1, 0), a3, sv[0]);
            PG8_WAIT_V(8); PG8_WAIT_L(0); PG8_BAR; PG8_MMA(1, 0, At, B0); PG8_MMA(1, 1, At, B1); PG8_BAR; PG8_SCHED;
        }
        if constexpr (ALIGN_EPI) { if (wr == 0) PG8_BAR; }
        E(acc, cur, wr, wc, fr, fq);
        if (!has_next) break;
#pragma unroll
        for (int a = 0; a < 2; ++a)
#pragma unroll
            for (int b = 0; b < 2; ++b)
#pragma unroll
                for (int m = 0; m < 4; ++m)
#pragma unroll
                    for (int n = 0; n < 2; ++n) acc[a][b][m][n] = (f32x4){0.f, 0.f, 0.f, 0.f};
        cur = nxt; cA = nA; cB = nB; ++ui;
        if constexpr (GATHER) {
#pragma unroll
            for (int h = 0; h < 2; ++h)
#pragma unroll
                for (int i = 0; i < 2; ++i) voffA[h][i] = nvoffA[h][i]; }
        if constexpr (ALIGN_EPI) { if (wr == 1) PG8_BAR; }
    }
    PG8_WAIT_V(0);
    PG8_BAR;
#undef PG8_GATHER
#undef PG8_SA
#undef PG8_SB
#undef PG8_STAGE
#undef PG8_LDA
#undef PG8_LDB
#undef PG8_MMA
#undef PG8_WAIT_V
#undef PG8_WAIT_L
#undef PG8_BAR
#undef PG8_SCHED
}

struct EpiStoreBf16 {
    static constexpr bool PERM = true;
    bf16_t* O; int ldc;
    __device__ __forceinline__ void operator()(const f32x4 (&acc)[2][2][4][2], const Unit& u, int wr, int wc, int fr, int fq) const {
        const int row0 = u.pm * BM + wr * 64 + fr, col0 = u.pn * BM + wc * 32 + 8 * fq;
#pragma unroll
        for (int ai = 0; ai < 2; ++ai)
#pragma unroll
            for (int m = 0; m < 4; ++m) { bf16_t* rowp = O + (size_t)(row0 + ai * HALF + m * 16) * ldc + col0;
#pragma unroll
                for (int bj = 0; bj < 2; ++bj) { const f32x4 v0 = acc[ai][bj][m][0], v1 = acc[ai][bj][m][1];
                    u32x4 w; w.x = pk2(v0[0], v0[1]); w.y = pk2(v0[2], v0[3]); w.z = pk2(v1[0], v1[1]); w.w = pk2(v1[2], v1[3]);
                    *(u32x4*)(rowp + bj * HALF) = w; } }
    }
};
struct EpiMerge {
    static constexpr bool PERM = true;
    const bf16_t* P; bf16_t* MG;
    __device__ __forceinline__ void operator()(const f32x4 (&acc)[2][2][4][2], const Unit& u, int wr, int wc, int fr, int fq) const {
        const int row0 = u.pm * BM + wr * 64 + fr, col0 = u.pn * BM + wc * 32 + 8 * fq; const int br = u.aux;
        const bf16_t* gp = P + C_BG + br * 1024 + col0;
#pragma unroll
        for (int ai = 0; ai < 2; ++ai)
#pragma unroll
            for (int m = 0; m < 4; ++m) { const int row = row0 + ai * HALF + m * 16;
#pragma unroll
                for (int bj = 0; bj < 2; ++bj) { const int col = col0 + bj * HALF;
                    const u32x4 gw = *(const u32x4*)(gp + (size_t)row * LDP + bj * HALF);
                    u32x4 ow = {0u, 0u, 0u, 0u}; if (br > 0) ow = *(const u32x4*)(MG + (size_t)row * DM + col);
                    const f32x4 v0 = acc[ai][bj][m][0], v1 = acc[ai][bj][m][1];
                    u32x4 w;
                    w.x = pk2(bflo(ow.x) + sigmoidf_(bflo(gw.x)) * v0[0], bfhi(ow.x) + sigmoidf_(bfhi(gw.x)) * v0[1]);
                    w.y = pk2(bflo(ow.y) + sigmoidf_(bflo(gw.y)) * v0[2], bfhi(ow.y) + sigmoidf_(bfhi(gw.y)) * v0[3]);
                    w.z = pk2(bflo(ow.z) + sigmoidf_(bflo(gw.z)) * v1[0], bfhi(ow.z) + sigmoidf_(bfhi(gw.z)) * v1[1]);
                    w.w = pk2(bflo(ow.w) + sigmoidf_(bflo(gw.w)) * v1[2], bfhi(ow.w) + sigmoidf_(bfhi(gw.w)) * v1[3]);
                    *(u32x4*)(MG + (size_t)row * DM + col) = w; }
                asm volatile("" ::: "memory"); }
    }
};
struct EpiOut {
    static constexpr bool PERM = false;
    float* XL; const float* MODL;
    __device__ __forceinline__ void operator()(const f32x4 (&acc)[2][2][4][2], const Unit& u, int wr, int wc, int fr, int fq) const {
        const int row0 = u.pm * BM + wr * 64 + fr, col0 = u.pn * BM + wc * 32 + 4 * fq;
        const int cond = (u.pm % NBLK == 0) ? 2 : (u.pm / NBLK);
        const float* gp = MODL + (cond * 6 + 2) * DM + col0;
        f32x4 gv[2][2];
#pragma unroll
        for (int bj = 0; bj < 2; ++bj)
#pragma unroll
            for (int n = 0; n < 2; ++n) gv[bj][n] = *(const f32x4*)(gp + bj * HALF + n * 16);
#pragma unroll
        for (int ai = 0; ai < 2; ++ai)
#pragma unroll
            for (int m = 0; m < 4; ++m) { float* rowp = XL + (size_t)(row0 + ai * HALF + m * 16) * DM + col0;
#pragma unroll
                for (int bj = 0; bj < 2; ++bj)
#pragma unroll
                    for (int n = 0; n < 2; ++n) { const f32x4 x = *(const f32x4*)(rowp + bj * HALF + n * 16); *(f32x4*)(rowp + bj * HALF + n * 16) = x + gv[bj][n] * acc[ai][bj][m][n]; } }
    }
};
struct EpiMoe1 {
    static constexpr bool PERM = true;
    bf16_t* ACT;
    __device__ __forceinline__ void operator()(const f32x4 (&acc)[2][2][4][2], const Unit& u, int wr, int wc, int fr, int fq) const {
        const int row0 = u.pm * BM + wr * 64 + fr, col0 = u.pn * HALF + wc * 32 + 8 * fq;
#pragma unroll
        for (int ai = 0; ai < 2; ++ai)
#pragma unroll
            for (int m = 0; m < 4; ++m) { bf16_t* rowp = ACT + (size_t)(row0 + ai * HALF + m * 16) * DM + col0;
                const f32x4 a0 = acc[ai][0][m][0], a1 = acc[ai][0][m][1], b0 = acc[ai][1][m][0], b1 = acc[ai][1][m][1];
                u32x4 w; w.x = pk2(siluf_(a0[0]) * b0[0], siluf_(a0[1]) * b0[1]); w.y = pk2(siluf_(a0[2]) * b0[2], siluf_(a0[3]) * b0[3]);
                w.z = pk2(siluf_(a1[0]) * b1[0], siluf_(a1[1]) * b1[1]); w.w = pk2(siluf_(a1[2]) * b1[2], siluf_(a1[3]) * b1[3]);
                *(u32x4*)rowp = w; }
    }
};
struct EpiMoe2 {
    static constexpr bool PERM = true;
    bf16_t* YS; const int* RL; const unsigned* cnt;
    __device__ __forceinline__ void operator()(const f32x4 (&acc)[2][2][4][2], const Unit& u, int wr, int wc, int fr, int fq) const {
        const int e = u.aux >> 16, jb = u.aux & 0xffff; const int n_e = __builtin_amdgcn_readfirstlane((int)cnt[e * 64]);
        const int col0 = u.pn * BM + wc * 32 + 8 * fq;
#pragma unroll
        for (int ai = 0; ai < 2; ++ai)
#pragma unroll
            for (int m = 0; m < 4; ++m) { const int rank = jb * BM + ai * HALF + wr * 64 + m * 16 + fr;
                if (rank < n_e) { const int slot = RL[(size_t)e * RLCAP + rank]; bf16_t* rowp = YS + (size_t)slot * DM + col0;
#pragma unroll
                    for (int bj = 0; bj < 2; ++bj) { const f32x4 v0 = acc[ai][bj][m][0], v1 = acc[ai][bj][m][1];
                        u32x4 w; w.x = pk2(v0[0], v0[1]); w.y = pk2(v0[2], v0[3]); w.z = pk2(v1[0], v1[1]); w.w = pk2(v1[2], v1[3]);
                        *(u32x4*)(rowp + bj * HALF) = w; } } }
    }
};
}

template <int MODE>
__device__ __forceinline__ void ctx_tile(int tile, const bf16* A, const bf16* Bt, const bf16* P, bf16* MG, float* XL, const float* gatev, int wave, int lane) {
    const int fr = lane & 15, fq = lane >> 4;
    const int tr = tile >> 4, tc = tile & 15;
    const int cr = 32 * tr + 16 * (wave & 1) + fr;
    const size_t row = (size_t)(cr >> 8) * RB + (cr & 255);
    const int col0 = 64 * tc + 16 * (wave >> 1);
    f32x4 tot = (f32x4){0.f, 0.f, 0.f, 0.f};
    constexpr int NCH = 4;
#pragma unroll
    for (int ch = 0; ch < NCH; ++ch) {
        const bf16* ap_ = A + row * DM + 256 * ch + 8 * fq; const bf16* bp_ = Bt + (size_t)(col0 + fr) * DM + 256 * ch + 8 * fq;
        bf16x8 a[8], b[8];
#pragma unroll
        for (int ks = 0; ks < 8; ++ks) { a[ks] = *(const bf16x8*)(ap_ + 32 * ks); b[ks] = *(const bf16x8*)(bp_ + 32 * ks); }
        f32x4 acc = (MODE == 0) ? (f32x4){0.f, 0.f, 0.f, 0.f} : tot;
#pragma unroll
        for (int ks = 0; ks < 8; ++ks) acc = __builtin_amdgcn_mfma_f32_16x16x32_bf16(b[ks], a[ks], acc, 0, 0, 0);
        if (MODE == 0) { const u32x2 gw = *(const u32x2*)(P + row * LDP + C_BG + 1024 * ch + col0 + 4 * fq);
            tot.x += sigmoidf_(bflo(gw.x)) * acc.x; tot.y += sigmoidf_(bfhi(gw.x)) * acc.y; tot.z += sigmoidf_(bflo(gw.y)) * acc.z; tot.w += sigmoidf_(bfhi(gw.y)) * acc.w; }
        else tot = acc;
    }
    const int col = col0 + 4 * fq;
    if (MODE == 0) { u32x2 w; w.x = pk2(tot.x, tot.y); w.y = pk2(tot.z, tot.w); *(u32x2*)(MG + row * DM + col) = w; }
    else { float* xp = XL + row * DM + col; *(f32x4*)xp = *(const f32x4*)xp + *(const f32x4*)(gatev + col) * tot; }
}

#define XB_TMO      128
#define XB_XCNT(j)  (256  + 64 * (j))
#define XB_XSUB(j)  (1280 + 64 * (j))
#define XB_XGEN(j)  (2304 + 64 * (j))
#define XB_TOP      3328
#define XB_TOPGEN   3392
#define XCD_BAR_WORDS 3456
#define XB_SPIN_CAP (1u << 18)
__device__ __forceinline__ unsigned xb_ld(unsigned* p)              { return __hip_atomic_load(p, __ATOMIC_RELAXED, __HIP_MEMORY_SCOPE_AGENT); }
__device__ __forceinline__ unsigned xb_add(unsigned* p, unsigned v) { return __hip_atomic_fetch_add(p, v, __ATOMIC_RELAXED, __HIP_MEMORY_SCOPE_AGENT); }
__device__ __forceinline__ unsigned xb_xcc_id() { return (unsigned)__builtin_amdgcn_s_getreg((3 << 11) | 20) & 0xFu; }
#define XB_SPIN(cond, bar) do { unsigned _sp = 0; while (cond) { __builtin_amdgcn_s_sleep(1); \
    if ((++_sp & 255u) == 0u) { if (xb_ld(&(bar)[XB_TMO])) break; if (_sp > XB_SPIN_CAP) { atomicAdd(&(bar)[XB_TMO], 1u); break; } } } } while (0)
struct XcdBarrier { unsigned* bar; unsigned x; volatile LAS unsigned* st; };
__device__ __forceinline__ XcdBarrier xcd_barrier_post(unsigned* bar, volatile LAS unsigned* st) {
    XcdBarrier b; b.bar = bar; b.x = xb_xcc_id(); b.st = st;
    if (threadIdx.x == 0) (void)xb_add(&bar[XB_XCNT(b.x)], 1u);
    return b;
}
__device__ __forceinline__ void xcd_barrier_complete(unsigned* bar, unsigned x, unsigned& nloc, unsigned& nx) {
    const unsigned G = gridDim.x * gridDim.y * gridDim.z;
    unsigned sum, cnt, mine, sp = 0u;
    for (;;) {
        sum = 0u; cnt = 0u; mine = 0u;
#pragma unroll
        for (unsigned j = 0; j < 16; ++j) { const unsigned c = xb_ld(&bar[XB_XCNT(j)]); sum += c; cnt += (c > 0u) ? 1u : 0u; mine = (j == x) ? c : mine; }
        if (sum == G) break;
        __builtin_amdgcn_s_sleep(1);
        if ((++sp & 255u) == 0u) { if (xb_ld(&bar[XB_TMO])) break; if (sp > XB_SPIN_CAP) { atomicAdd(&bar[XB_TMO], 1u); break; } }
    }
    nloc = mine > 0u ? mine : 1u; nx = cnt > 0u ? cnt : 1u;
}
__device__ __forceinline__ void xcd_barrier(const XcdBarrier& b) {
    asm volatile("s_waitcnt vmcnt(0)" ::: "memory");
    __syncthreads();
    if (threadIdx.x == 0) {
        unsigned* bar = b.bar;
        __builtin_amdgcn_s_waitcnt(0);
        unsigned nloc = b.st[0], nx = b.st[1];
        if (nloc == 0u) { xcd_barrier_complete(bar, b.x, nloc, nx); b.st[0] = nloc; b.st[1] = nx; }
        const unsigned old = xb_add(&bar[XB_XSUB(b.x)], 1u);
        const unsigned gen = old / nloc;
        if (old + 1u == (gen + 1u) * nloc) {
            __builtin_amdgcn_fence(__ATOMIC_RELEASE, "agent");
            asm volatile("s_waitcnt vmcnt(0)" ::: "memory");
            const unsigned og = xb_add(&bar[XB_TOP], 1u);
            const unsigned tg = og / nx;
            if (og + 1u == (tg + 1u) * nx) xb_add(&bar[XB_TOPGEN], 1u);
            else XB_SPIN(xb_ld(&bar[XB_TOPGEN]) == tg, bar);
            __builtin_amdgcn_fence(__ATOMIC_ACQUIRE, "agent");
            xb_add(&bar[XB_XGEN(b.x)], 1u);
            asm volatile("s_waitcnt vmcnt(0)" ::: "memory");
        } else {
            XB_SPIN(xb_ld(&bar[XB_XGEN(b.x)]) == gen, bar);
            __builtin_amdgcn_fence(__ATOMIC_ACQUIRE, "agent");
            asm volatile("s_waitcnt vmcnt(0)" ::: "memory");
        }
    }
    __syncthreads();
}

struct Args { const float* in[30]; float* out; unsigned char* ws; int ph_lo, ph_hi; };
typedef const __attribute__((address_space(4))) Args* ArgP;
enum { I_X = 0, I_C, I_CTX, I_CCTX, I_LBLOG, I_RW, I_RB, I_FINALG, I_WMOD, I_BMOD, I_GMIX, I_GFFN, I_WIN, I_CONVW, I_CONVB, I_CLNG, I_CLNB, I_HGNG,
       I_GLW2, I_GLB2, I_GLNG, I_SINK, I_WBRC, I_WBRH, I_WBRG, I_WBRA, I_WOUT, I_W1, I_W3, I_W2 };

__device__ __forceinline__ int row_cond(int row) { const int b = row / RB, j = row - b * RB; return j < CTXL ? 2 : b; }

__device__ __forceinline__ void transpose_item(const float* W, int N, bf16* WT, int ldt, int koff, int mode, LAS float* scr, int kb, int nb, int lane) {
    const int k0 = 64 * kb, n0 = 32 * nb;
#pragma unroll 8
    for (int i = 0; i < 32; ++i) { const int kk = 2 * i + (lane >> 5); scr[kk * 33 + (lane & 31)] = W[(size_t)(k0 + kk) * N + n0 + (lane & 31)]; }
    asm volatile("s_waitcnt lgkmcnt(0)" ::: "memory");
    const int c = lane & 7;
    const int nd0 = (mode == 0) ? n0 : ((n0 >> 7) * 256 + (mode == 2 ? 128 : 0) + (n0 & 127));
#pragma unroll
    for (int j = 0; j < 4; ++j) { const int n = (lane >> 3) + 8 * j; const LAS float* s = scr + (8 * c) * 33 + n;
        u32x4 o; o.x = pk2(s[0 * 33], s[1 * 33]); o.y = pk2(s[2 * 33], s[3 * 33]); o.z = pk2(s[4 * 33], s[5 * 33]); o.w = pk2(s[6 * 33], s[7 * 33]);
        *(u32x4*)(WT + (size_t)(nd0 + n) * ldt + koff + k0 + 8 * c) = o; }
    asm volatile("s_waitcnt lgkmcnt(0)" ::: "memory");
}
__device__ __forceinline__ void convert_weights(ArgP ap, int l, LAS unsigned char* lds, int gw, int NGW, int wave, int lane) {
    LAS float* scr = (LAS float*)(lds + wave * 16384);
    unsigned char* ws = ap->ws;
    bf16* WIN = (bf16*)(ws + WS_WIN); bf16* WBR = (bf16*)(ws + WS_WBR); bf16* WOUT = (bf16*)(ws + WS_WOUT); bf16* W13 = (bf16*)(ws + WS_W13); bf16* W2 = (bf16*)(ws + WS_W2);
    constexpr int I_IN = 16 * 225, I_BR = 4 * 32, I_O = 16 * 32, I_E = 16 * 32;
    constexpr int NITEMS = I_IN + 4 * I_BR + I_O + 48 * I_E;
    for (int it = gw; it < NITEMS; it += NGW) {
        int r = it;
        if (r < I_IN) { const int nb = r % 225; if (nb == W_IN_A / 32) continue; transpose_item(ap->in[I_WIN] + (size_t)l * DM * W_IN_COLS, W_IN_COLS, nb > W_IN_A / 32 ? WIN - 32 * DM : WIN, DM, 0, 0, scr, r / 225, nb, lane); continue; } r -= I_IN;
        if (r < 4 * I_BR) { const int br = r / I_BR, q = r % I_BR; transpose_item(ap->in[I_WBRC + br] + (size_t)l * 256 * DM, DM, WBR, DM, 256 * br, 0, scr, q / 32, q % 32, lane); continue; } r -= 4 * I_BR;
        if (r < I_O) { transpose_item(ap->in[I_WOUT] + (size_t)l * DM * DM, DM, WOUT, DM, 0, 0, scr, r / 32, r % 32, lane); continue; } r -= I_O;
        const int mat = r / I_E, q = r % I_E;
        const int e = mat / 3, wh = mat % 3;
        const size_t eoff = ((size_t)l * NEXP + e) * DM * DM;
        if (wh == 0) transpose_item(ap->in[I_W1] + eoff, DM, W13 + (size_t)e * 2048 * DM, DM, 0, 1, scr, q / 32, q % 32, lane);
        else if (wh == 1) transpose_item(ap->in[I_W3] + eoff, DM, W13 + (size_t)e * 2048 * DM, DM, 0, 2, scr, q / 32, q % 32, lane);
        else transpose_item(ap->in[I_W2] + eoff, DM, W2 + (size_t)e * DM * DM, DM, 0, 0, scr, q / 32, q % 32, lane);
    }
    for (int it = gw; it < 256 * 16; it += NGW) { const int n = it >> 4, k = (it & 15) * 64 + lane, dir = n >> 7, c = n & 127;
        const float* wa = ap->in[I_WIN] + ((size_t)l * DM + k) * W_IN_COLS + W_IN_A + 16 * dir; const float* w2 = ap->in[I_GLW2] + (size_t)(l * 2 + dir) * 16 * 128 + c;
        float s = 0.f;
#pragma unroll
        for (int q = 0; q < 4; ++q) { const f32x4 a4 = *(const f32x4*)(wa + 4 * q); s += a4.x * w2[(4 * q) * 128] + a4.y * w2[(4 * q + 1) * 128] + a4.z * w2[(4 * q + 2) * 128] + a4.w * w2[(4 * q + 3) * 128]; }
        WIN[(size_t)(C_GLU + n) * DM + k] = (bf16)(pk2(s, 0.f) & 0xffffu); }
}

__device__ __forceinline__ void modnorm_store(const f32x4 (&v)[4], const float* g, const float* shift, const float* scale, bf16* orow, int lane) {
    float ss = 0.f;
#pragma unroll
    for (int j = 0; j < 4; ++j) ss += (v[j].x * v[j].x + v[j].y * v[j].y) + (v[j].z * v[j].z + v[j].w * v[j].w);
    const float rstd = rsqrtf(wave_sum(ss) * (1.f / DM) + EPS);
#pragma unroll
    for (int j = 0; j < 4; ++j) { const int c = 4 * lane + 256 * j;
        const f32x4 gg = *(const f32x4*)(g + c), sh = *(const f32x4*)(shift + c), sc = *(const f32x4*)(scale + c);
        const f32x4 y = (v[j] * rstd) * gg * (sc + 1.0f) + sh;
        u32x2 w; w.x = pk2(y.x, y.y); w.y = pk2(y.z, y.w); *(u32x2*)(orow + c) = w; }
}

__device__ __forceinline__ void attn_unit(const bf16* P, bf16* Y, const float* COS, const float* SIN, const float* sinkp, int b, int kvh, int qblk, bool ctxq, LAS unsigned char* lds, int tid, int wave, int lane) {
    LAS bf16* KS = (LAS bf16*)lds;
    LAS bf16* VT = (LAS bf16*)(lds + 64 * 72 * 2);
    const int fr = lane & 15, fq = lane >> 4;
    const int hq = kvh * 2 + (wave >> 2);
    const int t0 = qblk * 128, tq0 = t0 + (wave & 3) * 32;
    const size_t rowbase = (size_t)b * RB + (ctxq ? 0 : CTXL);
    bf16x8 qf[2][2];
#pragma unroll
    for (int qt = 0; qt < 2; ++qt)
#pragma unroll
        for (int ks = 0; ks < 2; ++ks) {
            const int tq = tq0 + 16 * qt + fr, dch = 4 * ks + fq;
            const bf16* qp = P + (rowbase + tq) * LDP + C_ATQ + hq * 64;
            const u32x4 own = *(const u32x4*)(qp + 8 * dch), oth = *(const u32x4*)(qp + 8 * (dch ^ 2));
            float o[8], p[8], r[8];
            o[0] = bflo(own.x); o[1] = bfhi(own.x); o[2] = bflo(own.y); o[3] = bfhi(own.y); o[4] = bflo(own.z); o[5] = bfhi(own.z); o[6] = bflo(own.w); o[7] = bfhi(own.w);
            p[0] = bflo(oth.x); p[1] = bfhi(oth.x); p[2] = bflo(oth.y); p[3] = bfhi(oth.y); p[4] = bflo(oth.z); p[5] = bfhi(oth.z); p[6] = bflo(oth.w); p[7] = bfhi(oth.w);
            if (!ctxq) {
                const int ci = tq * 32 + (dch >> 2) * 16 + (dch & 1) * 8;
#pragma unroll
                for (int j = 0; j < 8; ++j) { const float c = COS[ci + j], s = SIN[ci + j]; r[j] = (dch & 2) ? (p[j] * s + o[j] * c) : (o[j] * c - p[j] * s); }
            } else {
#pragma unroll
                for (int j = 0; j < 8; ++j) r[j] = o[j];
            }
            u32x4 w; w.x = pk2(r[0] * 0.125f, r[1] * 0.125f); w.y = pk2(r[2] * 0.125f, r[3] * 0.125f); w.z = pk2(r[4] * 0.125f, r[5] * 0.125f); w.w = pk2(r[6] * 0.125f, r[7] * 0.125f);
            qf[qt][ks] = __builtin_bit_cast(bf16x8, w);
        }
    f32x4 ot[4][2];
#pragma unroll
    for (int dt = 0; dt < 4; ++dt)
#pragma unroll
        for (int qt = 0; qt < 2; ++qt) ot[dt][qt] = (f32x4){0.f, 0.f, 0.f, 0.f};
    float mrun[2] = {-1e30f, -1e30f}, lrun[2] = {0.f, 0.f};
    const int ntile = ctxq ? 4 : 10;
    for (int ti = 0; ti < ntile; ++ti) {
        const bool band = (!ctxq) && ti < 6;
        const int s0 = band ? (t0 - 128 + 64 * ti) : 64 * (ctxq ? ti : ti - 6);
        if (band && (s0 < 0 || s0 >= SEQ)) continue;
        __syncthreads();
        {
            const int key = tid >> 3, dch = tid & 7;
            const bf16* kp = P + ((size_t)b * RB + (band ? CTXL : 0) + s0 + key) * LDP;
            const u32x4 own = *(const u32x4*)(kp + C_ATK + kvh * 64 + 8 * dch);
            u32x4 kw = own;
            if (band) {
                const u32x4 oth = *(const u32x4*)(kp + C_ATK + kvh * 64 + 8 * (dch ^ 2));
                float o[8], p[8], r[8];
                o[0] = bflo(own.x); o[1] = bfhi(own.x); o[2] = bflo(own.y); o[3] = bfhi(own.y); o[4] = bflo(own.z); o[5] = bfhi(own.z); o[6] = bflo(own.w); o[7] = bfhi(own.w);
                p[0] = bflo(oth.x); p[1] = bfhi(oth.x); p[2] = bflo(oth.y); p[3] = bfhi(oth.y); p[4] = bflo(oth.z); p[5] = bfhi(oth.z); p[6] = bflo(oth.w); p[7] = bfhi(oth.w);
                const int ci = (s0 + key) * 32 + (dch >> 2) * 16 + (dch & 1) * 8;
#pragma unroll
                for (int j = 0; j < 8; ++j) { const float c = COS[ci + j], s = SIN[ci + j]; r[j] = (dch & 2) ? (p[j] * s + o[j] * c) : (o[j] * c - p[j] * s); }
                kw.x = pk2(r[0], r[1]); kw.y = pk2(r[2], r[3]); kw.z = pk2(r[4], r[5]); kw.w = pk2(r[6], r[7]);
            }
            *(LAS u32x4*)(KS + key * 72 + 8 * dch) = kw;
            const u32x4 vw = *(const u32x4*)(kp + C_ATV + kvh * 64 + 8 * dch);
            LAS bf16* vp = VT + (8 * dch) * 72 + key;
            vp[0 * 72] = (bf16)(vw.x & 0xffffu); vp[1 * 72] = (bf16)(vw.x >> 16); vp[2 * 72] = (bf16)(vw.y & 0xffffu); vp[3 * 72] = (bf16)(vw.y >> 16);
            vp[4 * 72] = (bf16)(vw.z & 0xffffu); vp[5 * 72] = (bf16)(vw.z >> 16); vp[6 * 72] = (bf16)(vw.w & 0xffffu); vp[7 * 72] = (bf16)(vw.w >> 16);
        }
        __syncthreads();
        f32x4 st[4][2];
#pragma unroll
        for (int kt = 0; kt < 4; ++kt) {
            const bf16x8 ka0 = *(const LAS bf16x8*)(KS + (16 * kt + fr) * 72 + 8 * fq), ka1 = *(const LAS bf16x8*)(KS + (16 * kt + fr) * 72 + 32 + 8 * fq);
#pragma unroll
            for (int qt = 0; qt < 2; ++qt) { f32x4 c = (f32x4){0.f, 0.f, 0.f, 0.f};
                c = __builtin_amdgcn_mfma_f32_16x16x32_bf16(ka0, qf[qt][0], c, 0, 0, 0);
                c = __builtin_amdgcn_mfma_f32_16x16x32_bf16(ka1, qf[qt][1], c, 0, 0, 0);
                st[kt][qt] = c; }
        }
#pragma unroll
        for (int qt = 0; qt < 2; ++qt) {
            const int tq = tq0 + 16 * qt + fr;
            float mx = -1e30f;
#pragma unroll
            for (int kt = 0; kt < 4; ++kt)
#pragma unroll
                for (int j = 0; j < 4; ++j) { const int s = s0 + 16 * kt + 4 * fq + j; const int dd = tq - s; const bool ok = (!band) || (dd <= 128 && dd >= -128);
                    st[kt][qt][j] = ok ? st[kt][qt][j] : -1e30f; mx = fmaxf(mx, st[kt][qt][j]); }
            mx = fmaxf(mx, __shfl_xor(mx, 16)); mx = fmaxf(mx, __shfl_xor(mx, 32));
            const float mnew = fmaxf(mrun[qt], mx), alpha = __expf(mrun[qt] - mnew);
            mrun[qt] = mnew;
            float ps = 0.f;
#pragma unroll
            for (int kt = 0; kt < 4; ++kt)
#pragma unroll
                for (int j = 0; j < 4; ++j) { const float sv = st[kt][qt][j]; const float pv = (sv > -1e29f) ? __expf(sv - mnew) : 0.f; st[kt][qt][j] = pv; ps += pv; }
            lrun[qt] = lrun[qt] * alpha + ps;
#pragma unroll
            for (int dt = 0; dt < 4; ++dt) ot[dt][qt] = ot[dt][qt] * alpha;
        }
#pragma unroll
        for (int kk = 0; kk < 2; ++kk) {
            bf16x8 pb[2];
#pragma unroll
            for (int qt = 0; qt < 2; ++qt) { u32x4 w; w.x = pk2(st[2 * kk][qt][0], st[2 * kk][qt][1]); w.y = pk2(st[2 * kk][qt][2], st[2 * kk][qt][3]);
                w.z = pk2(st[2 * kk + 1][qt][0], st[2 * kk + 1][qt][1]); w.w = pk2(st[2 * kk + 1][qt][2], st[2 * kk + 1][qt][3]); pb[qt] = __builtin_bit_cast(bf16x8, w); }
#pragma unroll
            for (int dt = 0; dt < 4; ++dt) {
                const u32x2 v0 = *(const LAS u32x2*)(VT + (16 * dt + fr) * 72 + 32 * kk + 4 * fq), v1 = *(const LAS u32x2*)(VT + (16 * dt + fr) * 72 + 32 * kk + 16 + 4 * fq);
                u32x4 vw; vw.x = v0.x; vw.y = v0.y; vw.z = v1.x; vw.w = v1.y; const bf16x8 va = __builtin_bit_cast(bf16x8, vw);
#pragma unroll
                for (int qt = 0; qt < 2; ++qt) ot[dt][qt] = __builtin_amdgcn_mfma_f32_16x16x32_bf16(va, pb[qt], ot[dt][qt], 0, 0, 0);
            }
        }
    }
    const float sk = sinkp[hq];
#pragma unroll
    for (int qt = 0; qt < 2; ++qt) {
        float l = lrun[qt]; l += __shfl_xor(l, 16); l += __shfl_xor(l, 32);
        const float mf = fmaxf(mrun[qt], sk); const float a = __expf(mrun[qt] - mf); const float denom = l * a + __expf(sk - mf); const float sc = a / denom;
        const int tq = tq0 + 16 * qt + fr;
        bf16* yp = Y + (rowbase + tq) * DM + 768 + hq * 64 + 4 * fq;
#pragma unroll
        for (int dt = 0; dt < 4; ++dt) { const f32x4 o = ot[dt][qt] * sc; u32x2 w; w.x = pk2(o.x, o.y); w.y = pk2(o.z, o.w); *(u32x2*)(yp + 16 * dt) = w; }
    }
}

__device__ __forceinline__ void conv_unit(const bf16* P, bf16* Y, const float* cw, const float* cb, const float* lng, const float* lnb, int cu, LAS unsigned char* lds, int tid, int wave, int lane) {
    LAS float* Z = (LAS float*)lds;
    LAS float* CO = (LAS float*)(lds + 62 * 256 * 4);
    const int row0 = cu * 32; const int b = row0 / RB, j0 = row0 - b * RB;
    const int seg0 = b * RB + (j0 < CTXL ? 0 : CTXL), seg1 = b * RB + (j0 < CTXL ? CTXL : RB);
    __syncthreads();
    for (int idx = tid; idx < 62 * 32; idx += NTHREADS) { const int tt = idx >> 5, c8 = (idx & 31) * 8; const int row = row0 - 15 + tt; f32x4 z0 = {0.f, 0.f, 0.f, 0.f}, z1 = z0;
        if (row >= seg0 && row < seg1) { const u32x4 av = *(const u32x4*)(P + (size_t)row * LDP + C_CONV + c8), bv = *(const u32x4*)(P + (size_t)row * LDP + C_CONV + 256 + c8);
            z0.x = bflo(av.x) * sigmoidf_(bflo(bv.x)); z0.y = bfhi(av.x) * sigmoidf_(bfhi(bv.x)); z0.z = bflo(av.y) * sigmoidf_(bflo(bv.y)); z0.w = bfhi(av.y) * sigmoidf_(bfhi(bv.y));
            z1.x = bflo(av.z) * sigmoidf_(bflo(bv.z)); z1.y = bfhi(av.z) * sigmoidf_(bfhi(bv.z)); z1.z = bflo(av.w) * sigmoidf_(bflo(bv.w)); z1.w = bfhi(av.w) * sigmoidf_(bfhi(bv.w)); }
        *(LAS f32x4*)(Z + tt * 256 + c8) = z0; *(LAS f32x4*)(Z + tt * 256 + c8 + 4) = z1; }
    __syncthreads();
    { const int c = tid & 255, hf = tid >> 8; float w[31], zr[46];
#pragma unroll
      for (int j = 0; j < 31; ++j) w[j] = cw[j * 256 + c];
#pragma unroll
      for (int i = 0; i < 46; ++i) zr[i] = Z[(hf * 16 + i) * 256 + c];
      const float bias = cb[c];
#pragma unroll
      for (int t = 0; t < 16; ++t) { float s = bias;
#pragma unroll
          for (int j = 0; j < 31; ++j) s += zr[t + j] * w[j];
          CO[(hf * 16 + t) * 256 + c] = s; } }
    __syncthreads();
#pragma unroll
    for (int q = 0; q < 4; ++q) { const int t = wave * 4 + q; const f32x4 x = *(const LAS f32x4*)(CO + t * 256 + 4 * lane);
        const float mu = wave_sum((x.x + x.y) + (x.z + x.w)) * (1.f / 256.f); const f32x4 d = x - mu;
        const float var = wave_sum((d.x * d.x + d.y * d.y) + (d.z * d.z + d.w * d.w)) * (1.f / 256.f); const float rstd = rsqrtf(var + EPS);
        const f32x4 g = *(const f32x4*)(lng + 4 * lane), bb = *(const f32x4*)(lnb + 4 * lane); const f32x4 zn = d * rstd * g + bb;
        u32x2 w; w.x = pk2(siluf_(zn.x), siluf_(zn.y)); w.y = pk2(siluf_(zn.z), siluf_(zn.w));
        *(u32x2*)(Y + (size_t)(row0 + t) * DM + 4 * lane) = w; }
}

typedef short bf16x4 __attribute__((ext_vector_type(4)));
constexpr int SC_LD = 72;
constexpr int SC_DIRB = 4 * 64 * SC_LD * 2 + 4 * 64 * 4;
template <bool HG>
__device__ __forceinline__ void scan_mfma(ArgP ap, int l, int passB, int b, int h, int blk, LAS unsigned char* lds, int tid, int wave, int lane) {
    constexpr int DK = HG ? 64 : 32, NM = DK / 16, NKS = DK / 32;
    unsigned char* ws = ap->ws;
    const bf16* P = (const bf16*)(ws + WS_P); bf16* Y = (bf16*)(ws + WS_Y);
    float* SEGS = (float*)(ws + (HG ? WS_SEGH : WS_SEGG)); float* SEGD = (float*)(ws + (HG ? WS_SEGDH : WS_SEGDG));
    const int dir = wave >> 2, slab = wave & 3, htid = tid & 255, fr = lane & 15, fq = lane >> 4;
    LAS unsigned char* dbase = lds + dir * SC_DIRB;
    LAS bf16* QT = (LAS bf16*)dbase; LAS bf16* KH = QT + 64 * SC_LD; LAS bf16* KBT = KH + 64 * SC_LD; LAS bf16* VT = KBT + 64 * SC_LD; LAS float* EB = (LAS float*)(VT + 64 * SC_LD);
    LAS bf16* OS = (LAS bf16*)(lds + 2 * SC_DIRB);
    const size_t row0 = (size_t)b * RB + blk * 256;
    const int ch = (b * 2 + dir) * 4 + h;
    f32x4 S[NM];
#pragma unroll
    for (int m = 0; m < NM; ++m) S[m] = (f32x4){0.f, 0.f, 0.f, 0.f};
    __syncthreads();
    if (passB) {
        const int npre = (dir == 0) ? blk : (blk == 0 ? 0 : (1 + (NBLK - 1 - blk)));
#pragma unroll 4
        for (int q = 0; q < npre; ++q) { const int i = (dir == 0) ? q : (q == 0 ? 0 : (NBLK - q));
            const float* sp = SEGS + ((size_t)(ch * NBLK + i) * DK + 4 * fq) * 64 + 16 * slab + fr; const float* dp = SEGD + (size_t)(ch * NBLK + i) * DK + 4 * fq;
#pragma unroll
            for (int m = 0; m < NM; ++m) { const f32x4 d = *(const f32x4*)(dp + 16 * m);
#pragma unroll
                for (int j = 0; j < 4; ++j) S[m][j] = d[j] * S[m][j] + sp[(16 * m + j) * 64]; } }
        for (int i = tid; i < 256 * 64 / 2; i += NTHREADS) ((LAS unsigned*)OS)[i] = 0u;
    }
    float Dk = 1.f;
    const int pc = htid >> 6, pk = htid & 63;
    bf16 rz[16], rq[16], ru[16]; u32x4 rv0, rv1;
    const int cu = C_GLU + dir * 128 + h * 32 + pk;
    const int cz = HG ? ((dir ? C_HGFB : C_HGFF) + h * 64 + pk) : (C_GLK + h * 32 + pk), cq = HG ? (C_HGQ + h * 64 + pk) : (C_GLQ + h * 32 + pk);
#define SCAN_LOAD_RAW(gi_) do { const int T0_ = 64 * (dir ? 3 - (gi_) : (gi_)); \
        if (pk < DK) { const bf16* pr_ = P + (row0 + T0_ + 16 * pc) * LDP; \
            _Pragma("unroll") for (int j = 0; j < 16; ++j) { rz[j] = pr_[(size_t)j * LDP + cz]; rq[j] = pr_[(size_t)j * LDP + cq]; if (!HG) ru[j] = pr_[(size_t)j * LDP + cu]; } } \
        { const bf16* vp_ = P + (row0 + T0_ + (htid >> 2)) * LDP + (HG ? C_HGI : C_GLV) + h * 64 + 16 * (htid & 3); rv0 = *(const u32x4*)vp_; rv1 = *(const u32x4*)(vp_ + 8); } } while (0)
    SCAN_LOAD_RAW(0);
    for (int gi = 0; gi < 4; ++gi) {
        const int T0 = 64 * (dir ? 3 - gi : gi);
        __syncthreads();
        if (pk < DK) {
            float f[16], qv[16], kv[16];
            if (HG) {
                const float lbv = ((const float*)(ws + WS_LB))[l * 512 + dir * 256 + h * 64 + pk];
#pragma unroll
                for (int j = 0; j < 16; ++j) { const float z = bf2f(rz[j]); qv[j] = bf2f(rq[j]); const float sg = sigmoidf_(z);
                    f[j] = fmaxf(lbv + (1.f - lbv) * sg, 1e-30f); kv[j] = (1.f - lbv) * (1.f - sg); }
            } else {
                const float b2 = ap->in[I_GLB2][(l * 2 + dir) * 128 + h * 32 + pk];
#pragma unroll
                for (int j = 0; j < 16; ++j) { const float u = bf2f(ru[j]) + b2;
                    const float ls = fminf(u, 0.f) - __logf(1.f + __expf(-fabsf(u)));
                    f[j] = __expf(ls * (1.f / 16.f)); kv[j] = bf2f(rz[j]); qv[j] = bf2f(rq[j]) * 0.17677669529663687f; }
            }
            float pj[16], sf[16];
            if (dir == 0) { float p = 1.f;
#pragma unroll
                for (int j = 0; j < 16; ++j) { p *= f[j]; pj[j] = p; }
                float s = 1.f;
#pragma unroll
                for (int j = 15; j >= 0; --j) { sf[j] = s; s *= f[j]; }
            } else { float p = 1.f;
#pragma unroll
                for (int j = 15; j >= 0; --j) { p *= f[j]; pj[j] = p; }
                float s = 1.f;
#pragma unroll
                for (int j = 0; j < 16; ++j) { sf[j] = s; s *= f[j]; }
            }
            EB[pc * 64 + pk] = dir ? pj[0] : pj[15];
#pragma unroll
            for (int j = 0; j < 16; ++j) { const int t = 16 * pc + j;
                QT[t * SC_LD + pk] = (bf16)(pk2(qv[j] * pj[j], 0.f) & 0xffffu);
                KH[t * SC_LD + pk] = (bf16)(pk2(kv[j] * __builtin_amdgcn_rcpf(fmaxf(pj[j], 1e-30f)), 0.f) & 0xffffu); }
#pragma unroll
            for (int j = 0; j < 16; j += 2) *(LAS unsigned*)(KBT + pk * SC_LD + 16 * pc + j) = pk2(kv[j] * sf[j], kv[j + 1] * sf[j + 1]);
        }
        {
            const int t = htid >> 2, vc = htid & 3;
            const u32x4 v0 = rv0, v1 = rv1;
            LAS bf16* d = VT + (16 * vc) * SC_LD + t;
            d[0 * SC_LD] = (bf16)(v0.x & 0xffffu); d[1 * SC_LD] = (bf16)(v0.x >> 16); d[2 * SC_LD] = (bf16)(v0.y & 0xffffu); d[3 * SC_LD] = (bf16)(v0.y >> 16);
            d[4 * SC_LD] = (bf16)(v0.z & 0xffffu); d[5 * SC_LD] = (bf16)(v0.z >> 16); d[6 * SC_LD] = (bf16)(v0.w & 0xffffu); d[7 * SC_LD] = (bf16)(v0.w >> 16);
            d[8 * SC_LD] = (bf16)(v1.x & 0xffffu); d[9 * SC_LD] = (bf16)(v1.x >> 16); d[10 * SC_LD] = (bf16)(v1.y & 0xffffu); d[11 * SC_LD] = (bf16)(v1.y >> 16);
            d[12 * SC_LD] = (bf16)(v1.z & 0xffffu); d[13 * SC_LD] = (bf16)(v1.z >> 16); d[14 * SC_LD] = (bf16)(v1.w & 0xffffu); d[15 * SC_LD] = (bf16)(v1.w >> 16);
        }
        __syncthreads();
        if (gi < 3) SCAN_LOAD_RAW(gi + 1);
        if (!passB && htid < DK) Dk *= (EB[htid] * EB[64 + htid]) * (EB[128 + htid] * EB[192 + htid]);
        for (int ci = 0; ci < 4; ++ci) {
            const int c = dir ? 3 - ci : ci;
            const bf16x4 vb = *(const LAS bf16x4*)(VT + (16 * slab + fr) * SC_LD + 16 * c + 4 * fq);
            if (passB) {
                f32x4 at = (f32x4){0.f, 0.f, 0.f, 0.f};
                bf16x8 qa[NKS];
#pragma unroll
                for (int ks = 0; ks < NKS; ++ks) {
                    const LAS bf16* qp = QT + (16 * c + fr) * SC_LD + 32 * ks + 4 * fq; const LAS bf16* kp = KH + (16 * c + fr) * SC_LD + 32 * ks + 4 * fq;
                    const u32x2 q0 = *(const LAS u32x2*)qp, q1 = *(const LAS u32x2*)(qp + 16), k0 = *(const LAS u32x2*)kp, k1 = *(const LAS u32x2*)(kp + 16);
                    u32x4 qw; qw.x = q0.x; qw.y = q0.y; qw.z = q1.x; qw.w = q1.y; u32x4 kw; kw.x = k0.x; kw.y = k0.y; kw.z = k1.x; kw.w = k1.y;
                    qa[ks] = __builtin_bit_cast(bf16x8, qw);
                    at = __builtin_amdgcn_mfma_f32_16x16x32_bf16(__builtin_bit_cast(bf16x8, kw), qa[ks], at, 0, 0, 0);
                }
                asm volatile("s_nop 15\n\ts_nop 15" : "+v"(at));
#pragma unroll
                for (int j = 0; j < 4; ++j) { const int sidx = 4 * fq + j; const bool keep = dir ? (sidx >= fr) : (sidx <= fr); at[j] = keep ? at[j] : 0.f; }
                u32x2 pw; pw.x = pk2(at[0], at[1]); pw.y = pk2(at[2], at[3]);
                f32x4 o = __builtin_amdgcn_mfma_f32_16x16x16bf16_1k(__builtin_bit_cast(bf16x4, pw), vb, (f32x4){0.f, 0.f, 0.f, 0.f}, 0, 0, 0);
                asm volatile("s_nop 15\n\ts_nop 15" : "+v"(o));
#pragma unroll
                for (int ks = 0; ks < NKS; ++ks) { u32x4 sw; sw.x = pk2(S[2 * ks][0], S[2 * ks][1]); sw.y = pk2(S[2 * ks][2], S[2 * ks][3]); sw.z = pk2(S[2 * ks + 1][0], S[2 * ks + 1][1]); sw.w = pk2(S[2 * ks + 1][2], S[2 * ks + 1][3]);
                    o = __builtin_amdgcn_mfma_f32_16x16x32_bf16(qa[ks], __builtin_bit_cast(bf16x8, sw), o, 0, 0, 0); }
                asm volatile("s_nop 15\n\ts_nop 15" : "+v"(o));
                LAS bf16* op = OS + (T0 + 16 * c + 4 * fq) * 64 + 16 * slab + fr;
#pragma unroll
                for (int j = 0; j < 4; ++j) op[j * 64] = (bf16)(pk2(bf2f(op[j * 64]) + o[j], 0.f) & 0xffffu);
            }
#pragma unroll
            for (int m = 0; m < NM; ++m) { const f32x4 eb = *(const LAS f32x4*)(EB + c * 64 + 16 * m + 4 * fq);
                const bf16x4 kb = *(const LAS bf16x4*)(KBT + (16 * m + fr) * SC_LD + 16 * c + 4 * fq);
                S[m] = __builtin_amdgcn_mfma_f32_16x16x16bf16_1k(kb, vb, S[m] * eb, 0, 0, 0); asm volatile("s_nop 15\n\ts_nop 15" : "+v"(S[m])); }
        }
    }
    if (!passB) {
        float* sp = SEGS + ((size_t)(ch * NBLK + blk) * DK + 4 * fq) * 64 + 16 * slab + fr;
#pragma unroll
        for (int m = 0; m < NM; ++m)
#pragma unroll
            for (int j = 0; j < 4; ++j) sp[(16 * m + j) * 64] = S[m][j];
        if (htid < DK) SEGD[(size_t)(ch * NBLK + blk) * DK + htid] = Dk;
    } else {
        __syncthreads();
        const float* ng = ap->in[HG ? I_HGNG : I_GLNG] + l * 256 + h * 64; const int gcol = (HG ? C_HGG : C_GLG) + h * 64, ycol = (HG ? 256 : 512) + h * 64;
        const float gn = ng[lane];
#pragma unroll 8
        for (int q = 0; q < 32; ++q) { const int tok = wave * 32 + q; const float o = bf2f(OS[tok * 64 + lane]);
            const float ss = wave_sum(o * o); const float gt = bf2f(P[(row0 + tok) * LDP + gcol + lane]);
            const float y = o * rsqrtf(ss * (1.f / 64.f) + EPS) * gn * siluf_(gt);
            Y[(row0 + tok) * DM + ycol + lane] = (bf16)(pk2(y, 0.f) & 0xffffu); }
    }
}

#define IN(k) (lo <= (k) && (k) < hi)
#if MK_N_LAUNCHES == 1
#define SEAM(k) do { if (IN(k) && IN((k) + 1)) xcd_barrier(bar); } while (0)
#else
#define SEAM(k) do { } while (0)
#endif
#define PHASE_BEGIN \
    int lane; asm volatile("v_mbcnt_lo_u32_b32 %0, -1, 0\n\tv_mbcnt_hi_u32_b32 %0, -1, %0" : "=v"(lane)); const int wave = wave0; const int tid = wave * 64 + lane; \
    const int gw = bid * NWAVES + wave, NGW = G * NWAVES; (void)gw; (void)NGW; (void)lane; \
    ArgP ap = (ArgP)__builtin_amdgcn_kernarg_segment_ptr(); asm volatile("" : "+s"(ap)); \
    unsigned char* ws = ap->ws; \
    float* XL = (float*)(ws + WS_XL); bf16* H = (bf16*)(ws + WS_H); bf16* Y = (bf16*)(ws + WS_Y); bf16* P = (bf16*)(ws + WS_P); \
    float* MP = (float*)(ws + WS_MP); float* MOD = (float*)(ws + WS_MOD); float* LB = (float*)(ws + WS_LB); \
    float* COS = (float*)(ws + WS_ROPE); float* SIN = COS + SEQ * 32; \
    int* RL = (int*)(ws + WS_RL); float* SG = (float*)(ws + WS_SG); \
    bf16* XS = (bf16*)(ws + WS_XS); bf16* ACT = (bf16*)(ws + WS_ACT); bf16* YS = (bf16*)(ws + WS_YS); \
    (void)XL; (void)H; (void)Y; (void)P; (void)MP; (void)MOD; (void)LB; (void)COS; (void)SIN; (void)RL; (void)SG; (void)XS; (void)ACT; (void)YS;


template <int l>
__device__ __forceinline__ void layer_phases(const int lo, const int hi, LAS unsigned char* lds, const int bid, const int G, const int wave0, const XcdBarrier& bar) {
        constexpr int pb = 3 + 10 * l;
        if (IN(pb + 0)) for (int rep = 0; rep < REP(0); ++rep) {
            PHASE_BEGIN
            const float* MODL = MOD + (size_t)l * 3 * 6144; unsigned* cnt = (unsigned*)(ws + WS_CTL) + CW_CNT + l * 16 * 64; (void)MODL; (void)cnt;
            pg8::Gemm g{H, (const bf16*)(ws + WS_WIN), DM, DM, DM, nullptr, nullptr}; pg8::StaticOrder S; S.init(R, LDP, G, bid);
            pg8::EpiStoreBf16 E{P, LDP};
            pg8::gemm_phase<pg8::EpiStoreBf16, pg8::StaticOrder>(lds, g, S, E, tid);
        }
        SEAM(pb + 0);
        if (IN(pb + 1)) for (int rep = 0; rep < REP(1); ++rep) {
            PHASE_BEGIN
            const float* MODL = MOD + (size_t)l * 3 * 6144; unsigned* cnt = (unsigned*)(ws + WS_CTL) + CW_CNT + l * 16 * 64; (void)MODL; (void)cnt;
            constexpr int n_hg = 2 * 4 * NBLK, n_ctxatt = (l == 0 ? 8 : 0), total = 256 + n_hg + n_ctxatt + n_hg;
            unsigned* qctr = (unsigned*)(ws + WS_CTL) + CW_Q + ((l * 2 + 0) * 2 + rep) * 64;
            volatile LAS unsigned* MQ = (volatile LAS unsigned*)(lds + MISC_OFF) + 16;
            for (;;) {
                __syncthreads(); if (tid == 0) MQ[0] = atomicAdd(qctr, 1u); __syncthreads();
                int it = (int)MQ[0]; if (it >= total) break;
                if (it < 256) { const int b = it >> 7, kvh = (it >> 6) & 1, qb = it & 63; for (int ur = 0; ur < UREP(0); ++ur) attn_unit(P, Y, COS, SIN, ap->in[I_SINK] + l * 4, b, kvh, qb, false, lds, tid, wave, lane); continue; }
                it -= 256;
                if (it < n_hg) { for (int ur = 0; ur < UREP(1); ++ur) scan_mfma<true>(ap, l, 0, it / (4 * NBLK), (it / NBLK) & 3, it % NBLK, lds, tid, wave, lane); continue; }
                it -= n_hg;
                if (it < n_ctxatt) { attn_unit(P, Y, COS, SIN, ap->in[I_SINK] + l * 4, it >> 2, (it >> 1) & 1, it & 1, true, lds, tid, wave, lane); continue; }
                it -= n_ctxatt;
                for (int ur = 0; ur < UREP(1); ++ur) scan_mfma<false>(ap, l, 0, it / (4 * NBLK), (it / NBLK) & 3, it % NBLK, lds, tid, wave, lane);
            }
        }
        SEAM(pb + 1);
        if (IN(pb + 2)) for (int rep = 0; rep < REP(2); ++rep) {
            PHASE_BEGIN
            const float* MODL = MOD + (size_t)l * 3 * 6144; unsigned* cnt = (unsigned*)(ws + WS_CTL) + CW_CNT + l * 16 * 64; (void)MODL; (void)cnt;
            constexpr int n_hg = 2 * 4 * NBLK, n_conv = R / 32, total = 2 * n_hg + n_conv;
            unsigned* qctr = (unsigned*)(ws + WS_CTL) + CW_Q + ((l * 2 + 1) * 2 + rep) * 64;
            volatile LAS unsigned* MQ = (volatile LAS unsigned*)(lds + MISC_OFF) + 16;
            for (;;) {
                __syncthreads(); if (tid == 0) MQ[0] = atomicAdd(qctr, 1u); __syncthreads();
                int it = (int)MQ[0]; if (it >= total) break;
                if (it < n_hg) { for (int ur = 0; ur < UREP(2); ++ur) scan_mfma<true>(ap, l, 1, it / (4 * NBLK), (it / NBLK) & 3, it % NBLK, lds, tid, wave, lane); continue; }
                it -= n_hg;
                if (it < n_hg) { for (int ur = 0; ur < UREP(2); ++ur) scan_mfma<false>(ap, l, 1, it / (4 * NBLK), (it / NBLK) & 3, it % NBLK, lds, tid, wave, lane); continue; }
                it -= n_hg;
                for (int ur = 0; ur < UREP(3); ++ur) conv_unit(P, Y, ap->in[I_CONVW] + l * 31 * 256, ap->in[I_CONVB] + l * 256, ap->in[I_CLNG] + l * 256, ap->in[I_CLNB] + l * 256, it, lds, tid, wave, lane);
            }
        }
        SEAM(pb + 2);
        if (IN(pb + 3)) for (int rep = 0; rep < REP(3); ++rep) {
            PHASE_BEGIN
            const float* MODL = MOD + (size_t)l * 3 * 6144; unsigned* cnt = (unsigned*)(ws + WS_CTL) + CW_CNT + l * 16 * 64; (void)MODL; (void)cnt;
            pg8::MergeOrder S; S.S.init(NBATCH * SEQ, DM, G, bid, 1);
            pg8::Gemm g{Y, (const bf16*)(ws + WS_WBR), DM, DM, 256, nullptr, nullptr}; pg8::EpiMerge E{P, H};
            pg8::gemm_phase<pg8::EpiMerge, pg8::MergeOrder>(lds, g, S, E, tid);
            if (l == 0) for (int t = bid; t < 256; t += G) ctx_tile<0>(t, Y, (const bf16*)(ws + WS_WBR), P, H, nullptr, nullptr, wave, lane);
        }
        SEAM(pb + 3);
        if (IN(pb + 4)) for (int rep = 0; rep < REP(4); ++rep) {
            PHASE_BEGIN
            const float* MODL = MOD + (size_t)l * 3 * 6144; unsigned* cnt = (unsigned*)(ws + WS_CTL) + CW_CNT + l * 16 * 64; (void)MODL; (void)cnt;
            pg8::Gemm g{H, (const bf16*)(ws + WS_WOUT), DM, DM, DM, nullptr, nullptr}; pg8::StaticOrder S; S.init(NBATCH * SEQ, DM, G, bid, 1);
            pg8::EpiOut E{XL, MODL};
            pg8::gemm_phase<pg8::EpiOut, pg8::StaticOrder>(lds, g, S, E, tid);
            if (l == 0) for (int t = bid; t < 256; t += G) ctx_tile<1>(t, H, (const bf16*)(ws + WS_WOUT), nullptr, nullptr, XL, MODL + (2 * 6 + 2) * DM, wave, lane);
        }
        SEAM(pb + 4);
        if (IN(pb + 5)) for (int rep = 0; rep < REP(5); ++rep) {
            PHASE_BEGIN
            const float* MODL = MOD + (size_t)l * 3 * 6144; unsigned* cnt = (unsigned*)(ws + WS_CTL) + CW_CNT + l * 16 * 64; (void)MODL; (void)cnt;
            LAS float* RW = (LAS float*)lds;
            __syncthreads();
            for (int idx = tid; idx < 16 * DM; idx += NTHREADS) { const int e = idx >> 10, d = idx & 1023; RW[idx] = ap->in[I_RW][d * 16 + e]; }
            __syncthreads();
            LAS unsigned* LC = (LAS unsigned*)(lds + 65536);
            LAS unsigned* LR = LC + 32;
            const int rpw = (R + G - 1) / G, rbeg = bid * rpw, rend = (rbeg + rpw < R) ? rbeg + rpw : R;
            if (tid < 32) LC[tid] = 0u;
            __syncthreads();
            for (int row = rbeg + wave; row < rend; row += NWAVES) { const int cond = row_cond(row); if (l == 1 && cond == 2) continue;
                asm volatile("" ::: "memory");
                const f32x4* x4 = (const f32x4*)(XL + (size_t)row * DM); f32x4 v[4]; float ss = 0.f;
#pragma unroll
                for (int q = 0; q < 4; ++q) { v[q] = x4[lane + 64 * q]; ss += (v[q].x * v[q].x + v[q].y * v[q].y) + (v[q].z * v[q].z + v[q].w * v[q].w); }
                const float rstd = rsqrtf(wave_sum(ss) * (1.f / DM) + EPS);
                const float* md = MODL + (size_t)cond * 6144; const float* gf = ap->in[I_GFFN] + l * DM;
#pragma unroll
                for (int q = 0; q < 4; ++q) { const int c = 4 * lane + 256 * q; const f32x4 gg = *(const f32x4*)(gf + c), sh = *(const f32x4*)(md + 3 * DM + c), sc = *(const f32x4*)(md + 4 * DM + c);
                    v[q] = (v[q] * rstd) * gg * (sc + 1.0f) + sh; u32x2 w; w.x = pk2(v[q].x, v[q].y); w.y = pk2(v[q].z, v[q].w); *(u32x2*)(H + (size_t)row * DM + c) = w; }
                float af[16];
#pragma unroll
                for (int e = 0; e < 16; ++e) { float s = 0.f;
#pragma unroll
                    for (int q = 0; q < 4; ++q) { const f32x4 w = *(const LAS f32x4*)(RW + e * DM + 4 * lane + 256 * q); s += (v[q].x * w.x + v[q].y * w.y) + (v[q].z * w.z + v[q].w * w.w); }
                    af[e] = sigmoidf_(wave_sum(s)); }
                float bestsum = -1e30f; int e0 = 0, e1 = 1; float a0 = 0.f, a1 = 0.f;
#pragma unroll
                for (int gI = 0; gI < 4; ++gI) { float m1 = -1e30f, m2 = -1e30f; int i1 = 0, i2 = 0; float f1 = 0.f, f2 = 0.f;
#pragma unroll
                    for (int i = 0; i < 4; ++i) { const float bv = af[gI * 4 + i] + ap->in[I_RB][gI * 4 + i];
                        if (bv > m1) { m2 = m1; i2 = i1; f2 = f1; m1 = bv; i1 = gI * 4 + i; f1 = af[gI * 4 + i]; } else if (bv > m2) { m2 = bv; i2 = gI * 4 + i; f2 = af[gI * 4 + i]; } }
                    const float gs = m1 + m2; if (gs > bestsum) { bestsum = gs; e0 = i1; e1 = i2; a0 = f1; a1 = f2; } }
                if (lane == 0) { const float inv = 1.f / (a0 + a1);
                    const unsigned r0 = __hip_atomic_fetch_add(LC + e0, 1u, __ATOMIC_RELAXED, __HIP_MEMORY_SCOPE_WORKGROUP), r1 = __hip_atomic_fetch_add(LC + e1, 1u, __ATOMIC_RELAXED, __HIP_MEMORY_SCOPE_WORKGROUP);
                    LR[(row - rbeg) * 2] = ((unsigned)e0 << 24) | r0; LR[(row - rbeg) * 2 + 1] = ((unsigned)e1 << 24) | r1;
                    SG[row * 2] = a0 * inv; SG[row * 2 + 1] = a1 * inv; }
            }
            __syncthreads();
            if (tid < 16) LC[16 + tid] = atomicAdd(cnt + tid * 64, LC[tid]);
            __syncthreads();
            for (int i = tid; i < (rend - rbeg) * 2; i += NTHREADS) { const int row = rbeg + (i >> 1); if (l == 1 && row_cond(row) == 2) continue;
                const unsigned w = LR[i]; const unsigned e = w >> 24; RL[(size_t)e * RLCAP + LC[16 + e] + (w & 0xffffffu)] = row * 2 + (i & 1); }
        }
        SEAM(pb + 5);
        if (IN(pb + 7)) for (int rep = 0; rep < REP(7); ++rep) {
            PHASE_BEGIN
            const float* MODL = MOD + (size_t)l * 3 * 6144; unsigned* cnt = (unsigned*)(ws + WS_CTL) + CW_CNT + l * 16 * 64; (void)MODL; (void)cnt;
            pg8::Gemm g{H, (const bf16*)(ws + WS_W13), DM, DM, DM, RL, cnt};
            pg8::MoeOrder S; S.init(cnt, 8, G, bid);
            pg8::EpiMoe1 E{ACT};
            pg8::gemm_phase<pg8::EpiMoe1, pg8::MoeOrder, true>(lds, g, S, E, tid);
        }
        SEAM(pb + 7);
        if (IN(pb + 8)) for (int rep = 0; rep < REP(8); ++rep) {
            PHASE_BEGIN
            const float* MODL = MOD + (size_t)l * 3 * 6144; unsigned* cnt = (unsigned*)(ws + WS_CTL) + CW_CNT + l * 16 * 64; (void)MODL; (void)cnt;
            pg8::Gemm g{ACT, (const bf16*)(ws + WS_W2), DM, DM, DM, nullptr, nullptr}; pg8::MoeOrder S; S.init(cnt, 4, G, bid);
            pg8::EpiMoe2 E{YS, RL, cnt};
            pg8::gemm_phase<pg8::EpiMoe2, pg8::MoeOrder>(lds, g, S, E, tid);
        }
        SEAM(pb + 8);
        if (IN(pb + 9)) for (int rep = 0; rep < REP(9); ++rep) {
            PHASE_BEGIN
            const float* MODL = MOD + (size_t)l * 3 * 6144; unsigned* cnt = (unsigned*)(ws + WS_CTL) + CW_CNT + l * 16 * 64; (void)MODL; (void)cnt;
            for (int row = gw; row < R; row += NGW) { const int cond = row_cond(row); if (l == 1 && cond == 2) continue;
                const float g0 = SG[row * 2], g1 = SG[row * 2 + 1];
                const f32x4* x4 = (const f32x4*)(XL + (size_t)row * DM); const float* gm = MODL + (size_t)cond * 6144 + 5 * DM; f32x4 v[4];
#pragma unroll
                for (int q = 0; q < 4; ++q) { const int c = 4 * lane + 256 * q; const u32x2 y0 = *(const u32x2*)(YS + (size_t)(row * 2) * DM + c), y1 = *(const u32x2*)(YS + (size_t)(row * 2 + 1) * DM + c);
                    f32x4 y; y.x = g0 * bflo(y0.x) + g1 * bflo(y1.x); y.y = g0 * bfhi(y0.x) + g1 * bfhi(y1.x); y.z = g0 * bflo(y0.y) + g1 * bflo(y1.y); y.w = g0 * bfhi(y0.y) + g1 * bfhi(y1.y);
                    v[q] = x4[lane + 64 * q] + *(const f32x4*)(gm + c) * y; }
                if (l == 0) {
                    f32x4* xo = (f32x4*)(XL + (size_t)row * DM);
#pragma unroll
                    for (int q = 0; q < 4; ++q) xo[lane + 64 * q] = v[q];
                    const float* md = MOD + (size_t)(1 * 3 + cond) * 6144;
                    modnorm_store(v, ap->in[I_GMIX] + DM, md, md + DM, H + (size_t)row * DM, lane);
                } else {
                    float ss = 0.f;
#pragma unroll
                    for (int q = 0; q < 4; ++q) ss += (v[q].x * v[q].x + v[q].y * v[q].y) + (v[q].z * v[q].z + v[q].w * v[q].w);
                    const float rstd = rsqrtf(wave_sum(ss) * (1.f / DM) + EPS);
                    const int b = row / RB, t = row - b * RB - CTXL; f32x4* o4 = (f32x4*)(ap->out + ((size_t)b * SEQ + t) * DM);
#pragma unroll
                    for (int q = 0; q < 4; ++q) o4[lane + 64 * q] = v[q] * rstd * *(const f32x4*)(ap->in[I_FINALG] + 4 * lane + 256 * q);
                }
            }
            if (l == 0) { __syncthreads(); convert_weights(ap, 1, lds, gw, NGW, wave, lane); }
        }
        SEAM(pb + 9);
}

__global__ void __launch_bounds__(NTHREADS, 2) fwd(Args a) {
    extern __shared__ __attribute__((aligned(16))) unsigned char lds_raw[];
    LAS unsigned char* lds = (LAS unsigned char*)lds_raw;
    volatile LAS unsigned* MISC = (volatile LAS unsigned*)(lds + MISC_OFF);
    const int tid0 = threadIdx.x; const int wave0 = __builtin_amdgcn_readfirstlane(tid0 >> 6);
    const int G = gridDim.x, bid = blockIdx.x;
    unsigned* ctl = (unsigned*)(a.ws + WS_CTL);
    for (int u = tid0; u < (LDS_BYTES - RING_BYTES) / 4; u += NTHREADS) ((LAS unsigned*)(lds + RING_BYTES))[u] = 0u;
    __syncthreads();
    XcdBarrier bar; bar.bar = ctl + CW_BAR; bar.x = 0; bar.st = nullptr;
#if MK_N_LAUNCHES == 1
    bar = xcd_barrier_post(ctl + CW_BAR, MISC + 8);
#endif
    const int lo = a.ph_lo, hi = a.ph_hi;
    if (IN(0)) for (int rep = 0; rep < REP(10); ++rep) {
        PHASE_BEGIN
        for (int row = gw; row < R; row += NGW) { const int b = row / RB, j = row - b * RB;
            const float* src = (j < CTXL) ? ap->in[I_CTX] + ((size_t)b * CTXL + j) * DM : ap->in[I_X] + ((size_t)b * SEQ + (j - CTXL)) * DM;
            const f32x4* s4 = (const f32x4*)src; f32x4* d4 = (f32x4*)(XL + (size_t)row * DM);
#pragma unroll
            for (int q = 0; q < 4; ++q) d4[lane + 64 * q] = s4[lane + 64 * q]; }
        for (int it = gw; it < 384; it += NGW) { const int l = it / 192, r = it % 192, kc = r / 24, jb = r % 24;
            f32x4 a0 = {0.f, 0.f, 0.f, 0.f}, a1 = a0, a2 = a0;
            const float* wp = ap->in[I_WMOD] + ((size_t)l * DM + kc * 128) * 6144 + jb * 256 + lane * 4;
            for (int k = 0; k < 128; ++k) { const f32x4 w = *(const f32x4*)(wp + (size_t)k * 6144); const int kk = kc * 128 + k;
                const float s0 = siluf_(ap->in[I_C][kk]), s1 = siluf_(ap->in[I_C][DM + kk]), s2 = siluf_(ap->in[I_CCTX][kk]);
                a0 += w * s0; a1 += w * s1; a2 += w * s2; }
            float* mp = MP + ((size_t)(l * 8 + kc) * 3) * 6144 + jb * 256 + lane * 4;
            *(f32x4*)(mp) = a0; *(f32x4*)(mp + 6144) = a1; *(f32x4*)(mp + 2 * 6144) = a2; }
        if (bid == 0) { for (int i = tid; i < 512; i += NTHREADS) { const float x0 = ap->in[I_LBLOG][i], x1 = ap->in[I_LBLOG][512 + i]; const float m = fmaxf(x0, x1);
            const float e0 = expf(x0 - m), e1 = expf(x1 - m); LB[i] = 0.f; LB[512 + i] = e1 / (e0 + e1); } }
        for (int idx = bid * NTHREADS + tid; idx < SEQ * 32; idx += G * NTHREADS) { const int t = idx >> 5, ai = idx & 31; const int ax = ai >> 4, i = ai & 15;
            const float inv = powf(10000.0f, -(float)i / 16.0f); const float pos = (float)(ax == 0 ? (t >> 6) : (t & 63)); const float ang = pos * inv;
            COS[idx] = cosf(ang); SIN[idx] = sinf(ang); }
        convert_weights(ap, 0, lds, gw, NGW, wave, lane);
    }
    SEAM(0);
    if (IN(1)) for (int rep = 0; rep < REP(11); ++rep) {
        PHASE_BEGIN
        for (int idx = bid * NTHREADS + tid; idx < 2 * 3 * 6144; idx += G * NTHREADS) { const int l = idx / (3 * 6144), r = idx % (3 * 6144), cond = r / 6144, j = r % 6144;
            float s = ap->in[I_BMOD][l * 6144 + j];
#pragma unroll
            for (int kc = 0; kc < 8; ++kc) s += MP[((size_t)(l * 8 + kc) * 3 + cond) * 6144 + j];
            MOD[idx] = s; }
    }
    SEAM(1);
    if (IN(2)) for (int rep = 0; rep < REP(12); ++rep) {
        PHASE_BEGIN
        for (int row = gw; row < R; row += NGW) { const int cond = row_cond(row); const f32x4* x4 = (const f32x4*)(XL + (size_t)row * DM); f32x4 v[4];
#pragma unroll
            for (int q = 0; q < 4; ++q) v[q] = x4[lane + 64 * q];
            const float* md = MOD + (size_t)(0 * 3 + cond) * 6144;
            modnorm_store(v, ap->in[I_GMIX], md, md + DM, H + (size_t)row * DM, lane); }
    }
    SEAM(2);

    layer_phases<0>(lo, hi, lds, bid, G, wave0, bar);
    layer_phases<1>(lo, hi, lds, bid, G, wave0, bar);
}

constexpr int NPHASES = 23;
extern "C" void kernel_launch(void* const* d_in, const int* in_sizes, int n_in, void* d_out, int out_size, void* d_ws, size_t ws_size, hipStream_t stream) {
    static int grid = 0;
    if (grid == 0) {
        int dev = 0, cus = 0, per_cu = 0;
        if (hipGetDevice(&dev) != hipSuccess || hipDeviceGetAttribute(&cus, hipDeviceAttributeMultiprocessorCount, dev) != hipSuccess) { grid = -1; return; }
        if (hipFuncSetAttribute((const void*)fwd, hipFuncAttributeMaxDynamicSharedMemorySize, LDS_BYTES) != hipSuccess) { grid = -1; return; }
        if (hipOccupancyMaxActiveBlocksPerMultiprocessor(&per_cu, (const void*)fwd, NTHREADS, LDS_BYTES) != hipSuccess || per_cu < 1) per_cu = 1;
        (void)hipGetLastError();
        grid = cus;
        if (ws_size < WS_END) fprintf(stderr, "kernel_launch: workspace too small: %zu < %zu\n", ws_size, (size_t)WS_END);
    }
    if (grid < 0) return;
    (void)hipMemsetAsync((char*)d_ws + WS_CTL, 0, CTL_ZERO_BYTES, stream);
    Args a{};
    for (int i = 0; i < 30; ++i) a.in[i] = (const float*)d_in[i];
    a.out = (float*)d_out; a.ws = (unsigned char*)d_ws;
#if MK_N_LAUNCHES == 1
    a.ph_lo = 0; a.ph_hi = NPHASES;
    hipLaunchKernelGGL(fwd, dim3(grid), dim3(NTHREADS), LDS_BYTES, stream, a);
#else
    for (int ph = 0; ph < NPHASES; ++ph) { a.ph_lo = ph; a.ph_hi = ph + 1; hipLaunchKernelGGL(fwd, dim3(grid), dim3(NTHREADS), LDS_BYTES, stream, a); }
#endif
}
```

```cpp
#include <hip/hip_runtime.h>
#include <cstdio>
#include <cstdint>

#ifndef PROBE_REP
#define PROBE_REP 0
#endif
#define REP(j) ((((PROBE_REP) >> (j)) & 1) + 1)
#ifndef PROBE_UNIT
#define PROBE_UNIT 0
#endif
#define UREP(j) ((((PROBE_UNIT) >> (j)) & 1) + 1)
#ifndef MK_N_LAUNCHES
#define MK_N_LAUNCHES 1
#endif

#define GAS __attribute__((address_space(1)))
#define LAS __attribute__((address_space(3)))
typedef unsigned short bf16;
typedef short bf16x8 __attribute__((ext_vector_type(8)));
typedef short s16x4 __attribute__((ext_vector_type(4)));
typedef float f32x4 __attribute__((ext_vector_type(4)));
typedef float f32x2 __attribute__((ext_vector_type(2)));
typedef unsigned u32x4 __attribute__((ext_vector_type(4)));
typedef unsigned u32x2 __attribute__((ext_vector_type(2)));
typedef __bf16 bf16x2_t __attribute__((ext_vector_type(2)));

__device__ __forceinline__ unsigned pk2(float lo, float hi) { f32x2 v = {lo, hi}; bf16x2_t b = __builtin_convertvector(v, bf16x2_t); return __builtin_bit_cast(unsigned, b); }
__device__ __forceinline__ float bflo(unsigned w) { return __uint_as_float(w << 16); }
__device__ __forceinline__ float bfhi(unsigned w) { return __uint_as_float(w & 0xffff0000u); }
__device__ __forceinline__ float bf2f(bf16 v) { return __uint_as_float(((unsigned)v) << 16); }
__device__ __forceinline__ float sigmoidf_(float x) { return __builtin_amdgcn_rcpf(1.0f + __expf(-x)); }
__device__ __forceinline__ float siluf_(float x) { return x * __builtin_amdgcn_rcpf(1.0f + __expf(-x)); }
__device__ __forceinline__ float wave_sum(float v) {
#pragma unroll
    for (int o = 1; o < 64; o <<= 1) v += __shfl_xor(v, o);
    return v;
}

constexpr int DM = 1024, NBATCH = 2, SEQ = 8192, CTXL = 256, RB = SEQ + CTXL, R = NBATCH * RB;
constexpr int NBLK = RB / 256;
constexpr int LDP = 7424;
constexpr int C_CONV = 0, C_HGQ = 512, C_HGFF = 768, C_HGFB = 1024, C_HGI = 1280, C_HGG = 1536, C_GLQ = 1792, C_GLK = 1920, C_GLV = 2048,
              C_GLG = 2304, C_ATQ = 2560, C_ATK = 2816, C_ATV = 2944, C_BG = 3072, C_GLU = 7168, W_IN_COLS = 7200, W_IN_A = 2304;
constexpr float EPS = 1e-6f;
constexpr int NEXP = 16, RLCAP = 2 * R;
constexpr int NWAVES = 8, NTHREADS = 512;

constexpr size_t MiB = 1u << 20;
constexpr size_t WS_CTL = 0, CTL_ZERO_BYTES = 1 * MiB;
constexpr size_t WS_MP = 1 * MiB;
constexpr size_t WS_MOD = WS_MP + 1280 * 1024;
constexpr size_t WS_LB = WS_MOD + 256 * 1024;
constexpr size_t WS_ROPE = 3 * MiB;
constexpr size_t WS_RL = 5 * MiB;
constexpr size_t WS_SG = WS_RL + (size_t)NEXP * RLCAP * 4;
constexpr size_t WS_SEGH = 8 * MiB;
constexpr size_t WS_SEGG = WS_SEGH + (size_t)16 * NBLK * 4096 * 4;
constexpr size_t WS_SEGDH = WS_SEGG + (size_t)16 * NBLK * 2048 * 4;
constexpr size_t WS_SEGDG = WS_SEGDH + (size_t)16 * NBLK * 64 * 4;
constexpr size_t WS_WIN = 21 * MiB;
constexpr size_t WS_WBR = 36 * MiB;
constexpr size_t WS_WOUT = 38 * MiB;
constexpr size_t WS_W13 = 40 * MiB;
constexpr size_t WS_W2 = 104 * MiB;
constexpr size_t WS_XL = 136 * MiB;
constexpr size_t WS_H = 202 * MiB;
constexpr size_t WS_Y = 235 * MiB;
constexpr size_t WS_P = 268 * MiB;
constexpr size_t WS_XS = WS_P, WS_ACT = WS_P + 74 * MiB, WS_YS = WS_P + 148 * MiB;
constexpr size_t WS_END = WS_P + (size_t)R * LDP * 2;
static_assert(WS_SEGDG + 16 * NBLK * 32 * 4 <= WS_WIN && WS_END <= 508 * MiB, "ws map");
static_assert((size_t)(2 * R + 16 * 256) * 2048 <= 74 * MiB, "XS fits");
constexpr int CW_BAR = 4096;
constexpr int CW_Q = 8192;
constexpr int CW_CNT = 16384;

constexpr int RING_BYTES = 131072;
constexpr int MISC_OFF = RING_BYTES + 320;
constexpr int LDS_BYTES = 147456;

namespace pg8 {
#define PG8_LAS __attribute__((address_space(3)))
typedef unsigned short bf16_t;
constexpr int BM = 256, BK = 64, HALF = 128, HTB = HALF * BK * 2, STAGE_BYTES = 8 * HTB, NXCD = 8, WGM = 8;
__host__ __device__ __forceinline__ int lds_byte(int r, int c) { const int st = (r >> 4) * 2 + (c >> 5), rr = r & 15, cc = c & 31, ob = rr * 64 + cc * 2; return st * 1024 + (ob ^ (((ob >> 9) & 1) << 5)); }
__host__ __device__ __forceinline__ void stage_rc(int b, int& R_, int& C) { const int st = b / 1024, sb = b % 1024, swz = sb ^ (((sb >> 9) & 1) << 5); R_ = (st >> 1) * 16 + swz / 64; C = (st & 1) * 32 + (swz % 64) / 2; }
__host__ __device__ __forceinline__ int perm32(int rho) { const int n = rho >> 4, i = rho & 15; return 8 * (i >> 2) + 4 * n + (i & 3); }

struct Unit { int pm, pn, pb, aux, kofs; };
struct Gemm { const bf16_t* A; const bf16_t* Bt; int lda, ldb, K; const int* RL; const unsigned* cnt; };

struct StaticOrder {
    int nM, nN, nwg, G, c, skip;
    __host__ __device__ void init(int M, int N, int G_, int c_, int skip_ = 0) { nM = M / BM; nN = N / BM; nwg = nM * nN; G = G_; c = c_; skip = skip_; }
    __host__ __device__ bool next(int i, Unit& u) const {
        const long L = (long)i * G + c; if (L >= nwg) return false;
        int wgid = (int)L; { const int q = nwg / NXCD, r = nwg % NXCD, xcd = wgid % NXCD, off = wgid / NXCD; wgid = (xcd < r ? xcd * (q + 1) : r * (q + 1) + (xcd - r) * q) + off; }
        const int nig = WGM * nN, gid = wgid / nig, fm = gid * WGM, gsz = (nM - fm) < WGM ? (nM - fm) : WGM;
        u.pm = fm + ((wgid % nig) % gsz); u.pn = (wgid % nig) / gsz; u.pb = u.pn; u.aux = 0; u.kofs = 0;
        if (skip) u.pm += 1 + (u.pm >= NBLK - 1 ? 1 : 0);
        return true;
    }
};
struct MoeOrder {
    int bs[NEXP + 1]; int ncol, G, c;
    __device__ __forceinline__ void init(const unsigned* cnt, int ncol_, int G_, int c_) {
        ncol = ncol_; G = G_; c = c_; bs[0] = 0;
#pragma unroll
        for (int e = 0; e < NEXP; ++e) bs[e + 1] = bs[e] + __builtin_amdgcn_readfirstlane((int)((cnt[e * 64] + 255u) >> 8));
    }
    __device__ __forceinline__ bool next(int i, Unit& u) const {
        const int bpr = G / ncol, bpx = bpr >> 3, x = c & 7, j = c >> 3;
        const int cb = i * bpr + x * bpx + j / ncol, pn = j % ncol; if (cb >= bs[NEXP]) return false;
        int e = 0, jb = 0;
#pragma unroll
        for (int q = 1; q < NEXP; ++q) if (cb >= bs[q]) { e = q; jb = bs[q]; }
        u.pm = cb; u.pn = pn; u.pb = e * ncol + pn; u.aux = (e << 16) | (cb - jb); u.kofs = 0; return true;
    }
};
struct MergeOrder {
    StaticOrder S;
    __device__ __forceinline__ bool next(int i, Unit& u) const { if (!S.next(i >> 2, u)) return false; u.aux = i & 3; u.kofs = 256 * (i & 3); return true; }
};

template <class Epi, class Sched, bool GATHER = false>
__device__ __forceinline__ void gemm_phase(PG8_LAS unsigned char* lds, const Gemm g, const Sched& S, const Epi& E, const int tid) {
    constexpr bool ALIGN_EPI = true;
    const int wid = __builtin_amdgcn_readfirstlane(tid >> 6), lane = tid & 63, wr = wid >> 2, wc = wid & 3, fr = lane & 15, fq = lane >> 4;
    const int K = g.K, nt = K / BK;
    const size_t kstep = (size_t)(BK * 2);
    const size_t hstepA = (size_t)HALF * g.lda * 2, hstepB = (size_t)HALF * g.ldb * 2;
    const size_t tstepA = 2 * hstepA, tstepB = 2 * hstepB;
    unsigned voffA[2][2], nvoffA[2][2], voffB[2]; int Rr[2], Cc[2];
#pragma unroll
    for (int i = 0; i < 2; ++i) { int R_, C; stage_rc(tid * 16 + i * 8192, R_, C); const int Rb = Epi::PERM ? ((R_ & ~31) + perm32(R_ & 31)) : R_; Rr[i] = R_; Cc[i] = C;
        voffB[i] = (unsigned)(Rb * g.ldb + C) * 2u;
#pragma unroll
        for (int h = 0; h < 2; ++h) { voffA[h][i] = (unsigned)(R_ * g.lda + C) * 2u + (unsigned)(h * hstepA); nvoffA[h][i] = voffA[h][i]; } }
#define PG8_GATHER(u_, dst_) do { const int e_ = (u_).aux >> 16, jb_ = (u_).aux & 0xffff; const int ne_ = __builtin_amdgcn_readfirstlane((int)g.cnt[e_ * 64]); \
        _Pragma("unroll") for (int h_ = 0; h_ < 2; ++h_) _Pragma("unroll") for (int i_ = 0; i_ < 2; ++i_) { const int rk_ = jb_ * BM + h_ * HALF + Rr[i_]; \
            int tok_ = 0; if (rk_ < ne_) tok_ = g.RL[(size_t)e_ * RLCAP + rk_] >> 1; dst_[h_][i_] = (unsigned)(tok_ * g.lda + Cc[i_]) * 2u; } \
        asm volatile("" : "+v"(dst_[0][0]), "+v"(dst_[0][1]), "+v"(dst_[1][0]), "+v"(dst_[1][1])); } while (0)
    const unsigned ldsw = (unsigned)wid * 1024u;
    const int aoff = lds_byte(wr * 64 + fr, fq * 8), boff = lds_byte(wc * 32 + fr, fq * 8);
#define PG8_SA(b, h) (((b) * 2 + (h)) * HTB)
#define PG8_SB(b, h) ((4 + (b) * 2 + (h)) * HTB)
#define PG8_STAGE(bufoff, gbase, voff) do { _Pragma("unroll") for (int _i = 0; _i < 2; ++_i) \
        __builtin_amdgcn_global_load_lds((const unsigned*)((const char*)(gbase) + (voff)[_i]), (PG8_LAS unsigned*)(lds + (bufoff) + ldsw + _i * 8192), 16, 0, 0); } while (0)
#define PG8_LDA(dst, b, h) do { _Pragma("unroll") for (int m = 0; m < 4; ++m) _Pragma("unroll") for (int k = 0; k < 2; ++k) dst[m][k] = *(const PG8_LAS bf16x8*)(lds + PG8_SA(b, h) + aoff + m * 2048 + k * 1024); } while (0)
#define PG8_LDB(dst, b, h) do { _Pragma("unroll") for (int n = 0; n < 2; ++n) _Pragma("unroll") for (int k = 0; k < 2; ++k) dst[n][k] = *(const PG8_LAS bf16x8*)(lds + PG8_SB(b, h) + boff + n * 2048 + k * 1024); } while (0)
#define PG8_MMA(ai, bj, At, Bt) do { __builtin_amdgcn_s_setprio(1); _Pragma("unroll") for (int m = 0; m < 4; ++m) _Pragma("unroll") for (int n = 0; n < 2; ++n) _Pragma("unroll") for (int k = 0; k < 2; ++k) \
        acc[ai][bj][m][n] = __builtin_amdgcn_mfma_f32_16x16x32_bf16(Bt[n][k], At[m][k], acc[ai][bj][m][n], 0, 0, 0); __builtin_amdgcn_s_setprio(0); } while (0)
#define PG8_WAIT_V(n) asm volatile("s_waitcnt vmcnt(" #n ")" ::: "memory")
#define PG8_WAIT_L(n) asm volatile("s_waitcnt lgkmcnt(" #n ")" ::: "memory")
#define PG8_BAR __builtin_amdgcn_s_barrier()
#define PG8_SCHED __builtin_amdgcn_sched_barrier(0)
    Unit cur, nxt; int ui = 0;
    if (!S.next(0, cur)) return;
    f32x4 acc[2][2][4][2];
#pragma unroll
    for (int a = 0; a < 2; ++a)
#pragma unroll
        for (int b = 0; b < 2; ++b)
#pragma unroll
            for (int m = 0; m < 4; ++m)
#pragma unroll
                for (int n = 0; n < 2; ++n) acc[a][b][m][n] = (f32x4){0.f, 0.f, 0.f, 0.f};
    bf16x8 At[4][2], B0[2][2], B1[2][2];
    const char* cA = (const char*)g.A + (GATHER ? (size_t)0 : (size_t)cur.pm * tstepA) + cur.kofs * 2; const char* cB = (const char*)g.Bt + (size_t)cur.pb * tstepB + cur.kofs * 2;
    if constexpr (GATHER) PG8_GATHER(cur, voffA);
    PG8_STAGE(PG8_SB(0, 0), cB, voffB); PG8_STAGE(PG8_SB(0, 1), cB + hstepB, voffB); PG8_STAGE(PG8_SA(0, 0), cA, voffA[0]); PG8_STAGE(PG8_SA(0, 1), cA, voffA[1]);
    if (wr == 1) PG8_BAR;
    PG8_WAIT_V(2); PG8_BAR;
    PG8_STAGE(PG8_SB(1, 0), cB + kstep, voffB); PG8_STAGE(PG8_SA(1, 0), cA + kstep, voffA[0]); PG8_STAGE(PG8_SB(1, 1), cB + hstepB + kstep, voffB);
    PG8_WAIT_V(6); PG8_BAR;
    for (;;) {
        const bool has_next = S.next(ui + 1, nxt);
        const char* nA = has_next ? (const char*)g.A + (GATHER ? (size_t)0 : (size_t)nxt.pm * tstepA) + nxt.kofs * 2 : cA; const char* nB = has_next ? (const char*)g.Bt + (size_t)nxt.pb * tstepB + nxt.kofs * 2 : cB;
        if constexpr (GATHER) { if (has_next) PG8_GATHER(nxt, nvoffA); else {
#pragma unroll
            for (int h = 0; h < 2; ++h)
#pragma unroll
                for (int i = 0; i < 2; ++i) nvoffA[h][i] = voffA[h][i]; } }
        for (int t = 0; t < nt; t += 2) {
            const bool last = (t == nt - 2);
            const char* a1 = cA + (size_t)(t + 1) * kstep;
            const char* a2 = last ? nA : cA + (size_t)(t + 2) * kstep; const char* b2 = last ? nB : cB + (size_t)(t + 2) * kstep;
            const char* a3 = a2 + kstep; const char* b3 = b2 + kstep;
            unsigned sv[2][2];
#pragma unroll
            for (int h = 0; h < 2; ++h)
#pragma unroll
                for (int i = 0; i < 2; ++i) sv[h][i] = (GATHER && last) ? nvoffA[h][i] : voffA[h][i];
            PG8_LDB(B0, 0, 0); PG8_LDB(B1, 0, 1); PG8_SCHED; PG8_LDA(At, 0, 0); PG8_STAGE(PG8_SA(1, 1), a1, voffA[1]);
            PG8_WAIT_V(8); PG8_WAIT_L(0); PG8_BAR; PG8_MMA(0, 0, At, B0); PG8_MMA(0, 1, At, B1); PG8_BAR; PG8_SCHED;
            PG8_LDA(At, 0, 1); PG8_STAGE(PG8_SB(0, 0), b2, voffB); PG8_STAGE(PG8_SB(0, 1), b2 + hstepB, voffB); PG8_STAGE(PG8_SA(0, 0), a2, sv[0]);
            PG8_WAIT_V(8); PG8_WAIT_L(0); PG8_BAR; PG8_MMA(1, 0, At, B0); PG8_MMA(1, 1, At, B1); PG8_BAR; PG8_SCHED;
            PG8_LDB(B0, 1, 0); PG8_LDB(B1, 1, 1); PG8_SCHED; PG8_LDA(At, 1, 0); PG8_STAGE(PG8_SA(0, 1), a2, sv[1]);
            PG8_WAIT_V(8); PG8_WAIT_L(0); PG8_BAR; PG8_MMA(0, 0, At, B0); PG8_MMA(0, 1, At, B1); PG8_BAR; PG8_SCHED;
            PG8_LDA(At, 1, 1); PG8_STAGE(PG8_SB(1, 0), b3, voffB); PG8_STAGE(PG8_SB(1, 1), b3 + hstepB, voffB); PG8_STAGE(PG8_SA(1, 0), a3, sv[0]);
            PG8_WAIT_V(8); PG8_WAIT_L(0); PG8_BAR; PG8_MMA(1, 0, At, B0); PG8_MMA(1, 1, At, B1); PG8_BAR; PG8_SCHED;
        }
        if constexpr (ALIGN_EPI) { if (wr == 0) PG8_BAR; }
        E(acc, cur, wr, wc, fr, fq);
        if (!has_next) break;
#pragma unroll
        for (int a = 0; a < 2; ++a)
#pragma unroll
            for (int b = 0; b < 2; ++b)
#pragma unroll
                for (int m = 0; m < 4; ++m)
#pragma unroll
                    for (int n = 0; n < 2; ++n) acc[a][b][m][n] = (f32x4){0.f, 0.f, 0.f, 0.f};
        cur = nxt; cA = nA; cB = nB; ++ui;
        if constexpr (GATHER) {
#pragma unroll
            for (int h = 0; h < 2; ++h)
#pragma unroll
                for (int i = 0; i < 2; ++i) voffA[h][i] = nvoffA[h][i]; }
        if constexpr (ALIGN_EPI) { if (wr == 1) PG8_BAR; }
    }
    PG8_WAIT_V(0);
    PG8_BAR;
#undef PG8_GATHER
#undef PG8_SA
#undef PG8_SB
#undef PG8_STAGE
#undef PG8_LDA
#undef PG8_LDB
#undef PG8_MMA
#undef PG8_WAIT_V
#undef PG8_WAIT_L
#undef PG8_BAR
#undef PG8_SCHED
}

struct EpiStoreBf16 {
    static constexpr bool PERM = true;
    bf16_t* O; int ldc;
    __device__ __forceinline__ void operator()(const f32x4 (&acc)[2][2][4][2], const Unit& u, int wr, int wc, int fr, int fq) const {
        const int row0 = u.pm * BM + wr * 64 + fr, col0 = u.pn * BM + wc * 32 + 8 * fq;
#pragma unroll
        for (int ai = 0; ai < 2; ++ai)
#pragma unroll
            for (int m = 0; m < 4; ++m) { bf16_t* rowp = O + (size_t)(row0 + ai * HALF + m * 16) * ldc + col0;
#pragma unroll
                for (int bj = 0; bj < 2; ++bj) { const f32x4 v0 = acc[ai][bj][m][0], v1 = acc[ai][bj][m][1];
                    u32x4 w; w.x = pk2(v0[0], v0[1]); w.y = pk2(v0[2], v0[3]); w.z = pk2(v1[0], v1[1]); w.w = pk2(v1[2], v1[3]);
                    *(u32x4*)(rowp + bj * HALF) = w; } }
    }
};
struct EpiMerge {
    static constexpr bool PERM = true;
    const bf16_t* P; bf16_t* MG;
    __device__ __forceinline__ void operator()(const f32x4 (&acc)[2][2][4][2], const Unit& u, int wr, int wc, int fr, int fq) const {
        const int row0 = u.pm * BM + wr * 64 + fr, col0 = u.pn * BM + wc * 32 + 8 * fq; const int br = u.aux;
        const bf16_t* gp = P + C_BG + br * 1024 + col0;
#pragma unroll
        for (int ai = 0; ai < 2; ++ai)
#pragma unroll
            for (int m = 0; m < 4; ++m) { const int row = row0 + ai * HALF + m * 16;
#pragma unroll
                for (int bj = 0; bj < 2; ++bj) { const int col = col0 + bj * HALF;
                    const u32x4 gw = *(const u32x4*)(gp + (size_t)row * LDP + bj * HALF);
                    u32x4 ow = {0u, 0u, 0u, 0u}; if (br > 0) ow = *(const u32x4*)(MG + (size_t)row * DM + col);
                    const f32x4 v0 = acc[ai][bj][m][0], v1 = acc[ai][bj][m][1];
                    u32x4 w;
                    w.x = pk2(bflo(ow.x) + sigmoidf_(bflo(gw.x)) * v0[0], bfhi(ow.x) + sigmoidf_(bfhi(gw.x)) * v0[1]);
                    w.y = pk2(bflo(ow.y) + sigmoidf_(bflo(gw.y)) * v0[2], bfhi(ow.y) + sigmoidf_(bfhi(gw.y)) * v0[3]);
                    w.z = pk2(bflo(ow.z) + sigmoidf_(bflo(gw.z)) * v1[0], bfhi(ow.z) + sigmoidf_(bfhi(gw.z)) * v1[1]);
                    w.w = pk2(bflo(ow.w) + sigmoidf_(bflo(gw.w)) * v1[2], bfhi(ow.w) + sigmoidf_(bfhi(gw.w)) * v1[3]);
                    *(u32x4*)(MG + (size_t)row * DM + col) = w; }
                asm volatile("" ::: "memory"); }
    }
};
struct EpiOut {
    static constexpr bool PERM = false;
    float* XL; const float* MODL;
    const float* xin; const float* ctxin;
    float pscale;
    __device__ __forceinline__ void operator()(const f32x4 (&acc)[2][2][4][2], const Unit& u, int wr, int wc, int fr, int fq) const {
        const int row0 = u.pm * BM + wr * 64 + fr, col0 = u.pn * BM + wc * 32 + 4 * fq;
        const int cond = (u.pm % NBLK == 0) ? 2 : (u.pm / NBLK);
        const float* gp = MODL + (cond * 6 + 2) * DM + col0;
        f32x4 gv[2][2];
#pragma unroll
        for (int bj = 0; bj < 2; ++bj)
#pragma unroll
            for (int n = 0; n < 2; ++n) gv[bj][n] = *(const f32x4*)(gp + bj * HALF + n * 16) * pscale;
        const int bb = u.pm / NBLK, blk = u.pm % NBLK;
        const float* sbase = xin ? ((blk == 0) ? ctxin + (size_t)bb * CTXL * DM : xin + ((size_t)bb * SEQ + (size_t)(blk - 1) * BM) * DM) : XL + (size_t)u.pm * BM * DM;
        const long sdelta = sbase - (XL + (size_t)u.pm * BM * DM);
#pragma unroll
        for (int ai = 0; ai < 2; ++ai)
#pragma unroll
            for (int m = 0; m < 4; ++m) { float* rowp = XL + (size_t)(row0 + ai * HALF + m * 16) * DM + col0; const float* srcp = rowp + sdelta;
#pragma unroll
                for (int bj = 0; bj < 2; ++bj)
#pragma unroll
                    for (int n = 0; n < 2; ++n) { const f32x4 x = *(const f32x4*)(srcp + bj * HALF + n * 16); *(f32x4*)(rowp + bj * HALF + n * 16) = x + gv[bj][n] * acc[ai][bj][m][n]; } }
    }
};
struct EpiMoe1 {
    static constexpr bool PERM = true;
    bf16_t* ACT;
    __device__ __forceinline__ void operator()(const f32x4 (&acc)[2][2][4][2], const Unit& u, int wr, int wc, int fr, int fq) const {
        const int row0 = u.pm * BM + wr * 64 + fr, col0 = u.pn * HALF + wc * 32 + 8 * fq;
#pragma unroll
        for (int ai = 0; ai < 2; ++ai)
#pragma unroll
            for (int m = 0; m < 4; ++m) { bf16_t* rowp = ACT + (size_t)(row0 + ai * HALF + m * 16) * DM + col0;
                const f32x4 a0 = acc[ai][0][m][0], a1 = acc[ai][0][m][1], b0 = acc[ai][1][m][0], b1 = acc[ai][1][m][1];
                u32x4 w; w.x = pk2(siluf_(a0[0]) * b0[0], siluf_(a0[1]) * b0[1]); w.y = pk2(siluf_(a0[2]) * b0[2], siluf_(a0[3]) * b0[3]);
                w.z = pk2(siluf_(a1[0]) * b1[0], siluf_(a1[1]) * b1[1]); w.w = pk2(siluf_(a1[2]) * b1[2], siluf_(a1[3]) * b1[3]);
                *(u32x4*)rowp = w; }
    }
};
struct EpiMoe2 {
    static constexpr bool PERM = true;
    bf16_t* YS; const int* RL; const unsigned* cnt;
    __device__ __forceinline__ void operator()(const f32x4 (&acc)[2][2][4][2], const Unit& u, int wr, int wc, int fr, int fq) const {
        const int e = u.aux >> 16, jb = u.aux & 0xffff; const int n_e = __builtin_amdgcn_readfirstlane((int)cnt[e * 64]);
        const int col0 = u.pn * BM + wc * 32 + 8 * fq;
#pragma unroll
        for (int ai = 0; ai < 2; ++ai)
#pragma unroll
            for (int m = 0; m < 4; ++m) { const int rank = jb * BM + ai * HALF + wr * 64 + m * 16 + fr;
                if (rank < n_e) { const int slot = RL[(size_t)e * RLCAP + rank]; bf16_t* rowp = YS + (size_t)slot * DM + col0;
#pragma unroll
                    for (int bj = 0; bj < 2; ++bj) { const f32x4 v0 = acc[ai][bj][m][0], v1 = acc[ai][bj][m][1];
                        u32x4 w; w.x = pk2(v0[0], v0[1]); w.y = pk2(v0[2], v0[3]); w.z = pk2(v1[0], v1[1]); w.w = pk2(v1[2], v1[3]);
                        *(u32x4*)(rowp + bj * HALF) = w; } } }
    }
};
}

template <int MODE>
__device__ __forceinline__ void ctx_tile(int tile, const bf16* A, const bf16* Bt, const bf16* P, bf16* MG, float* XL, const float* gatev, const float* ctxin, int wave, int lane) {
    const int fr = lane & 15, fq = lane >> 4;
    const int tr = tile >> 4, tc = tile & 15;
    const int cr = 32 * tr + 16 * (wave & 1) + fr;
    const size_t row = (size_t)(cr >> 8) * RB + (cr & 255);
    const int col0 = 64 * tc + 16 * (wave >> 1);
    f32x4 tot = (f32x4){0.f, 0.f, 0.f, 0.f};
    constexpr int NCH = 4;
#pragma unroll
    for (int ch = 0; ch < NCH; ++ch) {
        const bf16* ap_ = A + row * DM + 256 * ch + 8 * fq; const bf16* bp_ = Bt + (size_t)(col0 + fr) * DM + 256 * ch + 8 * fq;
        bf16x8 a[8], b[8];
#pragma unroll
        for (int ks = 0; ks < 8; ++ks) { a[ks] = *(const bf16x8*)(ap_ + 32 * ks); b[ks] = *(const bf16x8*)(bp_ + 32 * ks); }
        f32x4 acc = (MODE == 0) ? (f32x4){0.f, 0.f, 0.f, 0.f} : tot;
#pragma unroll
        for (int ks = 0; ks < 8; ++ks) acc = __builtin_amdgcn_mfma_f32_16x16x32_bf16(b[ks], a[ks], acc, 0, 0, 0);
        if (MODE == 0) { const u32x2 gw = *(const u32x2*)(P + row * LDP + C_BG + 1024 * ch + col0 + 4 * fq);
            tot.x += sigmoidf_(bflo(gw.x)) * acc.x; tot.y += sigmoidf_(bfhi(gw.x)) * acc.y; tot.z += sigmoidf_(bflo(gw.y)) * acc.z; tot.w += sigmoidf_(bfhi(gw.y)) * acc.w; }
        else tot = acc;
    }
    const int col = col0 + 4 * fq;
    if (MODE == 0) { u32x2 w; w.x = pk2(tot.x, tot.y); w.y = pk2(tot.z, tot.w); *(u32x2*)(MG + row * DM + col) = w; }
    else { *(f32x4*)(XL + row * DM + col) = *(const f32x4*)(ctxin + (size_t)cr * DM + col) + *(const f32x4*)(gatev + col) * tot; }
}

#define XB_TMO      128
#define XB_XCNT(j)  (256  + 64 * (j))
#define XB_XSUB(j)  (1280 + 64 * (j))
#define XB_XGEN(j)  (2304 + 64 * (j))
#define XB_TOP      3328
#define XB_TOPGEN   3392
#define XCD_BAR_WORDS 3456
#define XB_SPIN_CAP (1u << 18)
__device__ __forceinline__ unsigned xb_ld(unsigned* p)              { return __hip_atomic_load(p, __ATOMIC_RELAXED, __HIP_MEMORY_SCOPE_AGENT); }
__device__ __forceinline__ unsigned xb_add(unsigned* p, unsigned v) { return __hip_atomic_fetch_add(p, v, __ATOMIC_RELAXED, __HIP_MEMORY_SCOPE_AGENT); }
__device__ __forceinline__ unsigned xb_xcc_id() { return (unsigned)__builtin_amdgcn_s_getreg((3 << 11) | 20) & 0xFu; }
#define XB_SPIN(cond, bar) do { unsigned _sp = 0; while (cond) { __builtin_amdgcn_s_sleep(1); \
    if ((++_sp & 255u) == 0u) { if (xb_ld(&(bar)[XB_TMO])) break; if (_sp > XB_SPIN_CAP) { atomicAdd(&(bar)[XB_TMO], 1u); break; } } } } while (0)
struct XcdBarrier { unsigned* bar; unsigned x; volatile LAS unsigned* st; };
__device__ __forceinline__ XcdBarrier xcd_barrier_post(unsigned* bar, volatile LAS unsigned* st) {
    XcdBarrier b; b.bar = bar; b.x = xb_xcc_id(); b.st = st;
    if (threadIdx.x == 0) (void)xb_add(&bar[XB_XCNT(b.x)], 1u);
    return b;
}
__device__ __forceinline__ void xcd_barrier_complete(unsigned* bar, unsigned x, unsigned& nloc, unsigned& nx) {
    const unsigned G = gridDim.x * gridDim.y * gridDim.z;
    unsigned sum, cnt, mine, sp = 0u;
    for (;;) {
        sum = 0u; cnt = 0u; mine = 0u;
#pragma unroll
        for (unsigned j = 0; j < 16; ++j) { const unsigned c = xb_ld(&bar[XB_XCNT(j)]); sum += c; cnt += (c > 0u) ? 1u : 0u; mine = (j == x) ? c : mine; }
        if (sum == G) break;
        __builtin_amdgcn_s_sleep(1);
        if ((++sp & 255u) == 0u) { if (xb_ld(&bar[XB_TMO])) break; if (sp > XB_SPIN_CAP) { atomicAdd(&bar[XB_TMO], 1u); break; } }
    }
    nloc = mine > 0u ? mine : 1u; nx = cnt > 0u ? cnt : 1u;
}
__device__ __forceinline__ void xcd_barrier(const XcdBarrier& b) {
    asm volatile("s_waitcnt vmcnt(0)" ::: "memory");
    __syncthreads();
    if (threadIdx.x == 0) {
        unsigned* bar = b.bar;
        __builtin_amdgcn_s_waitcnt(0);
        unsigned nloc = b.st[0], nx = b.st[1];
        if (nloc == 0u) { xcd_barrier_complete(bar, b.x, nloc, nx); b.st[0] = nloc; b.st[1] = nx; }
        const unsigned old = xb_add(&bar[XB_XSUB(b.x)], 1u);
        const unsigned gen = old / nloc;
        if (old + 1u == (gen + 1u) * nloc) {
            __builtin_amdgcn_fence(__ATOMIC_RELEASE, "agent");
            asm volatile("s_waitcnt vmcnt(0)" ::: "memory");
            const unsigned og = xb_add(&bar[XB_TOP], 1u);
            const unsigned tg = og / nx;
            if (og + 1u == (tg + 1u) * nx) xb_add(&bar[XB_TOPGEN], 1u);
            else XB_SPIN(xb_ld(&bar[XB_TOPGEN]) == tg, bar);
            __builtin_amdgcn_fence(__ATOMIC_ACQUIRE, "agent");
            xb_add(&bar[XB_XGEN(b.x)], 1u);
            asm volatile("s_waitcnt vmcnt(0)" ::: "memory");
        } else {
            XB_SPIN(xb_ld(&bar[XB_XGEN(b.x)]) == gen, bar);
            __builtin_amdgcn_fence(__ATOMIC_ACQUIRE, "agent");
            asm volatile("s_waitcnt vmcnt(0)" ::: "memory");
        }
    }
    __syncthreads();
}

struct Args { const float* in[30]; float* out; unsigned char* ws; int ph_lo, ph_hi; };
typedef const __attribute__((address_space(4))) Args* ArgP;
enum { I_X = 0, I_C, I_CTX, I_CCTX, I_LBLOG, I_RW, I_RB, I_FINALG, I_WMOD, I_BMOD, I_GMIX, I_GFFN, I_WIN, I_CONVW, I_CONVB, I_CLNG, I_CLNB, I_HGNG,
       I_GLW2, I_GLB2, I_GLNG, I_SINK, I_WBRC, I_WBRH, I_WBRG, I_WBRA, I_WOUT, I_W1, I_W3, I_W2 };

__device__ __forceinline__ int row_cond(int row) { const int b = row / RB, j = row - b * RB; return j < CTXL ? 2 : b; }

__device__ __forceinline__ void transpose_item(const float* W, int N, bf16* WT, int ldt, int koff, int mode, LAS float* scr, int kb, int nb, int lane) {
    const int k0 = 64 * kb, n0 = 32 * nb;
    { const int r = lane >> 3, c4 = (lane & 7) * 4; f32x4 t[8];
#pragma unroll
      for (int i = 0; i < 8; ++i) t[i] = *(const f32x4*)(W + (size_t)(k0 + 8 * i + r) * N + n0 + c4);
#pragma unroll
      for (int i = 0; i < 8; ++i) { LAS float* d = scr + (8 * i + r) * 33 + c4; d[0] = t[i].x; d[1] = t[i].y; d[2] = t[i].z; d[3] = t[i].w; } }
    asm volatile("s_waitcnt lgkmcnt(0)" ::: "memory");
    const int c = lane & 7;
    const int nd0 = (mode == 0) ? n0 : ((n0 >> 7) * 256 + (mode == 2 ? 128 : 0) + (n0 & 127));
#pragma unroll
    for (int j = 0; j < 4; ++j) { const int n = (lane >> 3) + 8 * j; const LAS float* s = scr + (8 * c) * 33 + n;
        u32x4 o; o.x = pk2(s[0 * 33], s[1 * 33]); o.y = pk2(s[2 * 33], s[3 * 33]); o.z = pk2(s[4 * 33], s[5 * 33]); o.w = pk2(s[6 * 33], s[7 * 33]);
        *(u32x4*)(WT + (size_t)(nd0 + n) * ldt + koff + k0 + 8 * c) = o; }
    asm volatile("s_waitcnt lgkmcnt(0)" ::: "memory");
}
__device__ __forceinline__ void convert_weights(ArgP ap, int l, LAS unsigned char* lds, int gw, int NGW, int wave, int lane) {
    LAS float* scr = (LAS float*)(lds + wave * 16384);
    unsigned char* ws = ap->ws;
    bf16* WIN = (bf16*)(ws + WS_WIN); bf16* WBR = (bf16*)(ws + WS_WBR); bf16* WOUT = (bf16*)(ws + WS_WOUT); bf16* W13 = (bf16*)(ws + WS_W13); bf16* W2 = (bf16*)(ws + WS_W2);
    constexpr int I_IN = 16 * 225, I_BR = 4 * 32, I_O = 16 * 32, I_E = 16 * 32;
    constexpr int NITEMS = I_IN + 4 * I_BR + I_O + 48 * I_E;
    for (int it = gw; it < NITEMS; it += NGW) {
        int r = it;
        if (r < I_IN) { const int nb = r % 225; if (nb == W_IN_A / 32) continue; transpose_item(ap->in[I_WIN] + (size_t)l * DM * W_IN_COLS, W_IN_COLS, nb > W_IN_A / 32 ? WIN - 32 * DM : WIN, DM, 0, 0, scr, r / 225, nb, lane); continue; } r -= I_IN;
        if (r < 4 * I_BR) { const int br = r / I_BR, q = r % I_BR; transpose_item(ap->in[I_WBRC + br] + (size_t)l * 256 * DM, DM, WBR, DM, 256 * br, 0, scr, q / 32, q % 32, lane); continue; } r -= 4 * I_BR;
        if (r < I_O) { transpose_item(ap->in[I_WOUT] + (size_t)l * DM * DM, DM, WOUT, DM, 0, 0, scr, r / 32, r % 32, lane); continue; } r -= I_O;
        const int mat = r / I_E, q = r % I_E;
        const int e = mat / 3, wh = mat % 3;
        const size_t eoff = ((size_t)l * NEXP + e) * DM * DM;
        if (wh == 0) transpose_item(ap->in[I_W1] + eoff, DM, W13 + (size_t)e * 2048 * DM, DM, 0, 1, scr, q / 32, q % 32, lane);
        else if (wh == 1) transpose_item(ap->in[I_W3] + eoff, DM, W13 + (size_t)e * 2048 * DM, DM, 0, 2, scr, q / 32, q % 32, lane);
        else transpose_item(ap->in[I_W2] + eoff, DM, W2 + (size_t)e * DM * DM, DM, 0, 0, scr, q / 32, q % 32, lane);
    }
    for (int it = gw; it < 256 * 16; it += NGW) { const int n = it >> 4, k = (it & 15) * 64 + lane, dir = n >> 7, c = n & 127;
        const float* wa = ap->in[I_WIN] + ((size_t)l * DM + k) * W_IN_COLS + W_IN_A + 16 * dir; const float* w2 = ap->in[I_GLW2] + (size_t)(l * 2 + dir) * 16 * 128 + c;
        float s = 0.f;
#pragma unroll
        for (int q = 0; q < 4; ++q) { const f32x4 a4 = *(const f32x4*)(wa + 4 * q); s += a4.x * w2[(4 * q) * 128] + a4.y * w2[(4 * q + 1) * 128] + a4.z * w2[(4 * q + 2) * 128] + a4.w * w2[(4 * q + 3) * 128]; }
        WIN[(size_t)(C_GLU + n) * DM + k] = (bf16)(pk2(s, 0.f) & 0xffffu); }
}

__device__ __forceinline__ void modnorm_store(const f32x4 (&v)[4], const float* g, const float* shift, const float* scale, bf16* orow, int lane) {
    float ss = 0.f;
#pragma unroll
    for (int j = 0; j < 4; ++j) ss += (v[j].x * v[j].x + v[j].y * v[j].y) + (v[j].z * v[j].z + v[j].w * v[j].w);
    const float rstd = rsqrtf(wave_sum(ss) * (1.f / DM) + EPS);
#pragma unroll
    for (int j = 0; j < 4; ++j) { const int c = 4 * lane + 256 * j;
        const f32x4 gg = *(const f32x4*)(g + c), sh = *(const f32x4*)(shift + c), sc = *(const f32x4*)(scale + c);
        const f32x4 y = (v[j] * rstd) * gg * (sc + 1.0f) + sh;
        u32x2 w; w.x = pk2(y.x, y.y); w.y = pk2(y.z, y.w); *(u32x2*)(orow + c) = w; }
}

__device__ __forceinline__ void attn_unit(const bf16* P, bf16* Y, const float* COS, const float* SIN, const float* sinkp, int b, int kvh, int qblk, bool ctxq, LAS unsigned char* lds, int tid, int wave, int lane) {
    LAS bf16* KS = (LAS bf16*)lds;
    LAS bf16* VT = (LAS bf16*)(lds + 64 * 72 * 2);
    const int fr = lane & 15, fq = lane >> 4;
    const int hq = kvh * 2 + (wave >> 2);
    const int t0 = qblk * 128, tq0 = t0 + (wave & 3) * 32;
    const size_t rowbase = (size_t)b * RB + (ctxq ? 0 : CTXL);
    bf16x8 qf[2][2];
#pragma unroll
    for (int qt = 0; qt < 2; ++qt)
#pragma unroll
        for (int ks = 0; ks < 2; ++ks) {
            const int tq = tq0 + 16 * qt + fr, dch = 4 * ks + fq;
            const bf16* qp = P + (rowbase + tq) * LDP + C_ATQ + hq * 64;
            const u32x4 own = *(const u32x4*)(qp + 8 * dch), oth = *(const u32x4*)(qp + 8 * (dch ^ 2));
            float o[8], p[8], r[8];
            o[0] = bflo(own.x); o[1] = bfhi(own.x); o[2] = bflo(own.y); o[3] = bfhi(own.y); o[4] = bflo(own.z); o[5] = bfhi(own.z); o[6] = bflo(own.w); o[7] = bfhi(own.w);
            p[0] = bflo(oth.x); p[1] = bfhi(oth.x); p[2] = bflo(oth.y); p[3] = bfhi(oth.y); p[4] = bflo(oth.z); p[5] = bfhi(oth.z); p[6] = bflo(oth.w); p[7] = bfhi(oth.w);
            if (!ctxq) {
                const int ci = tq * 32 + (dch >> 2) * 16 + (dch & 1) * 8;
#pragma unroll
                for (int j = 0; j < 8; ++j) { const float c = COS[ci + j], s = SIN[ci + j]; r[j] = (dch & 2) ? (p[j] * s + o[j] * c) : (o[j] * c - p[j] * s); }
            } else {
#pragma unroll
                for (int j = 0; j < 8; ++j) r[j] = o[j];
            }
            u32x4 w; w.x = pk2(r[0] * 0.125f, r[1] * 0.125f); w.y = pk2(r[2] * 0.125f, r[3] * 0.125f); w.z = pk2(r[4] * 0.125f, r[5] * 0.125f); w.w = pk2(r[6] * 0.125f, r[7] * 0.125f);
            qf[qt][ks] = __builtin_bit_cast(bf16x8, w);
        }
    f32x4 ot[4][2];
#pragma unroll
    for (int dt = 0; dt < 4; ++dt)
#pragma unroll
        for (int qt = 0; qt < 2; ++qt) ot[dt][qt] = (f32x4){0.f, 0.f, 0.f, 0.f};
    float mrun[2] = {-1e30f, -1e30f}, lrun[2] = {0.f, 0.f};
    const int ntile = ctxq ? 4 : 10;
    for (int ti = 0; ti < ntile; ++ti) {
        const bool band = (!ctxq) && ti < 6;
        const int s0 = band ? (t0 - 128 + 64 * ti) : 64 * (ctxq ? ti : ti - 6);
        if (band && (s0 < 0 || s0 >= SEQ)) continue;
        __syncthreads();
        {
            const int key = tid >> 3, dch = tid & 7;
            const bf16* kp = P + ((size_t)b * RB + (band ? CTXL : 0) + s0 + key) * LDP;
            const u32x4 own = *(const u32x4*)(kp + C_ATK + kvh * 64 + 8 * dch);
            u32x4 kw = own;
            if (band) {
                const u32x4 oth = *(const u32x4*)(kp + C_ATK + kvh * 64 + 8 * (dch ^ 2));
                float o[8], p[8], r[8];
                o[0] = bflo(own.x); o[1] = bfhi(own.x); o[2] = bflo(own.y); o[3] = bfhi(own.y); o[4] = bflo(own.z); o[5] = bfhi(own.z); o[6] = bflo(own.w); o[7] = bfhi(own.w);
                p[0] = bflo(oth.x); p[1] = bfhi(oth.x); p[2] = bflo(oth.y); p[3] = bfhi(oth.y); p[4] = bflo(oth.z); p[5] = bfhi(oth.z); p[6] = bflo(oth.w); p[7] = bfhi(oth.w);
                const int ci = (s0 + key) * 32 + (dch >> 2) * 16 + (dch & 1) * 8;
#pragma unroll
                for (int j = 0; j < 8; ++j) { const float c = COS[ci + j], s = SIN[ci + j]; r[j] = (dch & 2) ? (p[j] * s + o[j] * c) : (o[j] * c - p[j] * s); }
                kw.x = pk2(r[0], r[1]); kw.y = pk2(r[2], r[3]); kw.z = pk2(r[4], r[5]); kw.w = pk2(r[6], r[7]);
            }
            *(LAS u32x4*)(KS + key * 72 + 8 * dch) = kw;
            const u32x4 vw = *(const u32x4*)(kp + C_ATV + kvh * 64 + 8 * dch);
            LAS bf16* vp = VT + (8 * dch) * 72 + key;
            vp[0 * 72] = (bf16)(vw.x & 0xffffu); vp[1 * 72] = (bf16)(vw.x >> 16); vp[2 * 72] = (bf16)(vw.y & 0xffffu); vp[3 * 72] = (bf16)(vw.y >> 16);
            vp[4 * 72] = (bf16)(vw.z & 0xffffu); vp[5 * 72] = (bf16)(vw.z >> 16); vp[6 * 72] = (bf16)(vw.w & 0xffffu); vp[7 * 72] = (bf16)(vw.w >> 16);
        }
        __syncthreads();
        f32x4 st[4][2];
#pragma unroll
        for (int kt = 0; kt < 4; ++kt) {
            const bf16x8 ka0 = *(const LAS bf16x8*)(KS + (16 * kt + fr) * 72 + 8 * fq), ka1 = *(const LAS bf16x8*)(KS + (16 * kt + fr) * 72 + 32 + 8 * fq);
#pragma unroll
            for (int qt = 0; qt < 2; ++qt) { f32x4 c = (f32x4){0.f, 0.f, 0.f, 0.f};
                c = __builtin_amdgcn_mfma_f32_16x16x32_bf16(ka0, qf[qt][0], c, 0, 0, 0);
                c = __builtin_amdgcn_mfma_f32_16x16x32_bf16(ka1, qf[qt][1], c, 0, 0, 0);
                st[kt][qt] = c; }
        }
#pragma unroll
        for (int qt = 0; qt < 2; ++qt) {
            const int tq = tq0 + 16 * qt + fr;
            float mx = -1e30f;
#pragma unroll
            for (int kt = 0; kt < 4; ++kt)
#pragma unroll
                for (int j = 0; j < 4; ++j) { const int s = s0 + 16 * kt + 4 * fq + j; const int dd = tq - s; const bool ok = (!band) || (dd <= 128 && dd >= -128);
                    st[kt][qt][j] = ok ? st[kt][qt][j] : -1e30f; mx = fmaxf(mx, st[kt][qt][j]); }
            mx = fmaxf(mx, __shfl_xor(mx, 16)); mx = fmaxf(mx, __shfl_xor(mx, 32));
            const float mnew = fmaxf(mrun[qt], mx), alpha = __expf(mrun[qt] - mnew);
            mrun[qt] = mnew;
            float ps = 0.f;
#pragma unroll
            for (int kt = 0; kt < 4; ++kt)
#pragma unroll
                for (int j = 0; j < 4; ++j) { const float sv = st[kt][qt][j]; const float pv = (sv > -1e29f) ? __expf(sv - mnew) : 0.f; st[kt][qt][j] = pv; ps += pv; }
            lrun[qt] = lrun[qt] * alpha + ps;
#pragma unroll
            for (int dt = 0; dt < 4; ++dt) ot[dt][qt] = ot[dt][qt] * alpha;
        }
#pragma unroll
        for (int kk = 0; kk < 2; ++kk) {
            bf16x8 pb[2];
#pragma unroll
            for (int qt = 0; qt < 2; ++qt) { u32x4 w; w.x = pk2(st[2 * kk][qt][0], st[2 * kk][qt][1]); w.y = pk2(st[2 * kk][qt][2], st[2 * kk][qt][3]);
                w.z = pk2(st[2 * kk + 1][qt][0], st[2 * kk + 1][qt][1]); w.w = pk2(st[2 * kk + 1][qt][2], st[2 * kk + 1][qt][3]); pb[qt] = __builtin_bit_cast(bf16x8, w); }
#pragma unroll
            for (int dt = 0; dt < 4; ++dt) {
                const u32x2 v0 = *(const LAS u32x2*)(VT + (16 * dt + fr) * 72 + 32 * kk + 4 * fq), v1 = *(const LAS u32x2*)(VT + (16 * dt + fr) * 72 + 32 * kk + 16 + 4 * fq);
                u32x4 vw; vw.x = v0.x; vw.y = v0.y; vw.z = v1.x; vw.w = v1.y; const bf16x8 va = __builtin_bit_cast(bf16x8, vw);
#pragma unroll
                for (int qt = 0; qt < 2; ++qt) ot[dt][qt] = __builtin_amdgcn_mfma_f32_16x16x32_bf16(va, pb[qt], ot[dt][qt], 0, 0, 0);
            }
        }
    }
    const float sk = sinkp[hq];
#pragma unroll
    for (int qt = 0; qt < 2; ++qt) {
        float l = lrun[qt]; l += __shfl_xor(l, 16); l += __shfl_xor(l, 32);
        const float mf = fmaxf(mrun[qt], sk); const float a = __expf(mrun[qt] - mf); const float denom = l * a + __expf(sk - mf); const float sc = a / denom;
        const int tq = tq0 + 16 * qt + fr;
        bf16* yp = Y + (rowbase + tq) * DM + 768 + hq * 64 + 4 * fq;
#pragma unroll
        for (int dt = 0; dt < 4; ++dt) { const f32x4 o = ot[dt][qt] * sc; u32x2 w; w.x = pk2(o.x, o.y); w.y = pk2(o.z, o.w); *(u32x2*)(yp + 16 * dt) = w; }
    }
}

__device__ __forceinline__ void conv_unit(const bf16* P, bf16* Y, const float* cw, const float* cb, const float* lng, const float* lnb, int cu, LAS unsigned char* lds, int tid, int wave, int lane) {
    LAS float* Z = (LAS float*)lds;
    LAS float* CO = (LAS float*)(lds + 62 * 256 * 4);
    const int row0 = cu * 32; const int b = row0 / RB, j0 = row0 - b * RB;
    const int seg0 = b * RB + (j0 < CTXL ? 0 : CTXL), seg1 = b * RB + (j0 < CTXL ? CTXL : RB);
    __syncthreads();
    for (int idx = tid; idx < 62 * 32; idx += NTHREADS) { const int tt = idx >> 5, c8 = (idx & 31) * 8; const int row = row0 - 15 + tt; f32x4 z0 = {0.f, 0.f, 0.f, 0.f}, z1 = z0;
        if (row >= seg0 && row < seg1) { const u32x4 av = *(const u32x4*)(P + (size_t)row * LDP + C_CONV + c8), bv = *(const u32x4*)(P + (size_t)row * LDP + C_CONV + 256 + c8);
            z0.x = bflo(av.x) * sigmoidf_(bflo(bv.x)); z0.y = bfhi(av.x) * sigmoidf_(bfhi(bv.x)); z0.z = bflo(av.y) * sigmoidf_(bflo(bv.y)); z0.w = bfhi(av.y) * sigmoidf_(bfhi(bv.y));
            z1.x = bflo(av.z) * sigmoidf_(bflo(bv.z)); z1.y = bfhi(av.z) * sigmoidf_(bfhi(bv.z)); z1.z = bflo(av.w) * sigmoidf_(bflo(bv.w)); z1.w = bfhi(av.w) * sigmoidf_(bfhi(bv.w)); }
        *(LAS f32x4*)(Z + tt * 256 + c8) = z0; *(LAS f32x4*)(Z + tt * 256 + c8 + 4) = z1; }
    __syncthreads();
    { const int c = tid & 255, hf = tid >> 8; float w[31], zr[46];
#pragma unroll
      for (int j = 0; j < 31; ++j) w[j] = cw[j * 256 + c];
#pragma unroll
      for (int i = 0; i < 46; ++i) zr[i] = Z[(hf * 16 + i) * 256 + c];
      const float bias = cb[c];
#pragma unroll
      for (int t = 0; t < 16; ++t) { float s = bias;
#pragma unroll
          for (int j = 0; j < 31; ++j) s += zr[t + j] * w[j];
          CO[(hf * 16 + t) * 256 + c] = s; } }
    __syncthreads();
#pragma unroll
    for (int q = 0; q < 4; ++q) { const int t = wave * 4 + q; const f32x4 x = *(const LAS f32x4*)(CO + t * 256 + 4 * lane);
        const float mu = wave_sum((x.x + x.y) + (x.z + x.w)) * (1.f / 256.f); const f32x4 d = x - mu;
        const float var = wave_sum((d.x * d.x + d.y * d.y) + (d.z * d.z + d.w * d.w)) * (1.f / 256.f); const float rstd = rsqrtf(var + EPS);
        const f32x4 g = *(const f32x4*)(lng + 4 * lane), bb = *(const f32x4*)(lnb + 4 * lane); const f32x4 zn = d * rstd * g + bb;
        u32x2 w; w.x = pk2(siluf_(zn.x), siluf_(zn.y)); w.y = pk2(siluf_(zn.z), siluf_(zn.w));
        *(u32x2*)(Y + (size_t)(row0 + t) * DM + 4 * lane) = w; }
}

typedef short bf16x4 __attribute__((ext_vector_type(4)));
constexpr int SC_LD = 72;
constexpr int SC_DIRB = 4 * 64 * SC_LD * 2 + 4 * 64 * 4;
template <bool HG>
__device__ __forceinline__ void scan_mfma(ArgP ap, int l, int passB, int b, int h, int blk, LAS unsigned char* lds, int tid, int wave, int lane) {
    constexpr int DK = HG ? 64 : 32, NM = DK / 16, NKS = DK / 32;
    unsigned char* ws = ap->ws;
    const bf16* P = (const bf16*)(ws + WS_P); bf16* Y = (bf16*)(ws + WS_Y);
    float* SEGS = (float*)(ws + (HG ? WS_SEGH : WS_SEGG)); float* SEGD = (float*)(ws + (HG ? WS_SEGDH : WS_SEGDG));
    const int dir = wave >> 2, slab = wave & 3, htid = tid & 255, fr = lane & 15, fq = lane >> 4;
    LAS unsigned char* dbase = lds + dir * SC_DIRB;
    LAS bf16* QT = (LAS bf16*)dbase; LAS bf16* KH = QT + 64 * SC_LD; LAS bf16* KBT = KH + 64 * SC_LD; LAS bf16* VT = KBT + 64 * SC_LD; LAS float* EB = (LAS float*)(VT + 64 * SC_LD);
    LAS bf16* OS = (LAS bf16*)(lds + 2 * SC_DIRB);
    const size_t row0 = (size_t)b * RB + blk * 256;
    const int ch = (b * 2 + dir) * 4 + h;
    f32x4 S[NM];
#pragma unroll
    for (int m = 0; m < NM; ++m) S[m] = (f32x4){0.f, 0.f, 0.f, 0.f};
    __syncthreads();
    if (passB) {
        const int npre = (dir == 0) ? blk : (blk == 0 ? 0 : (1 + (NBLK - 1 - blk)));
#pragma unroll 4
        for (int q = 0; q < npre; ++q) { const int i = (dir == 0) ? q : (q == 0 ? 0 : (NBLK - q));
            const float* sp = SEGS + ((size_t)(ch * NBLK + i) * DK + 4 * fq) * 64 + 16 * slab + fr; const float* dp = SEGD + (size_t)(ch * NBLK + i) * DK + 4 * fq;
#pragma unroll
            for (int m = 0; m < NM; ++m) { const f32x4 d = *(const f32x4*)(dp + 16 * m);
#pragma unroll
                for (int j = 0; j < 4; ++j) S[m][j] = d[j] * S[m][j] + sp[(16 * m + j) * 64]; } }
        for (int i = tid; i < 256 * 64 / 2; i += NTHREADS) ((LAS unsigned*)OS)[i] = 0u;
    }
    float Dk = 1.f;
    const int pc = htid >> 6, pk = htid & 63;
    bf16 rz[16], rq[16], ru[16]; u32x4 rv0, rv1;
    const int cu = C_GLU + dir * 128 + h * 32 + pk;
    const int cz = HG ? ((dir ? C_HGFB : C_HGFF) + h * 64 + pk) : (C_GLK + h * 32 + pk), cq = HG ? (C_HGQ + h * 64 + pk) : (C_GLQ + h * 32 + pk);
#define SCAN_LOAD_RAW(gi_) do { const int T0_ = 64 * (dir ? 3 - (gi_) : (gi_)); \
        if (pk < DK) { const bf16* pr_ = P + (row0 + T0_ + 16 * pc) * LDP; \
            _Pragma("unroll") for (int j = 0; j < 16; ++j) { rz[j] = pr_[(size_t)j * LDP + cz]; rq[j] = pr_[(size_t)j * LDP + cq]; if (!HG) ru[j] = pr_[(size_t)j * LDP + cu]; } } \
        { const bf16* vp_ = P + (row0 + T0_ + (htid >> 2)) * LDP + (HG ? C_HGI : C_GLV) + h * 64 + 16 * (htid & 3); rv0 = *(const u32x4*)vp_; rv1 = *(const u32x4*)(vp_ + 8); } } while (0)
    SCAN_LOAD_RAW(0);
    for (int gi = 0; gi < 4; ++gi) {
        const int T0 = 64 * (dir ? 3 - gi : gi);
        __syncthreads();
        if (pk < DK) {
            float f[16], qv[16], kv[16];
            if (HG) {
                const float lbv = ((const float*)(ws + WS_LB))[l * 512 + dir * 256 + h * 64 + pk];
#pragma unroll
                for (int j = 0; j < 16; ++j) { const float z = bf2f(rz[j]); qv[j] = bf2f(rq[j]); const float sg = sigmoidf_(z);
                    f[j] = fmaxf(lbv + (1.f - lbv) * sg, 1e-30f); kv[j] = (1.f - lbv) * (1.f - sg); }
            } else {
                const float b2 = ap->in[I_GLB2][(l * 2 + dir) * 128 + h * 32 + pk];
#pragma unroll
                for (int j = 0; j < 16; ++j) { const float u = bf2f(ru[j]) + b2;
                    const float ls = fminf(u, 0.f) - __logf(1.f + __expf(-fabsf(u)));
                    f[j] = __expf(ls * (1.f / 16.f)); kv[j] = bf2f(rz[j]); qv[j] = bf2f(rq[j]) * 0.17677669529663687f; }
            }
            float pj[16], sf[16];
            if (dir == 0) { float p = 1.f;
#pragma unroll
                for (int j = 0; j < 16; ++j) { p *= f[j]; pj[j] = p; }
                float s = 1.f;
#pragma unroll
                for (int j = 15; j >= 0; --j) { sf[j] = s; s *= f[j]; }
            } else { float p = 1.f;
#pragma unroll
                for (int j = 15; j >= 0; --j) { p *= f[j]; pj[j] = p; }
                float s = 1.f;
#pragma unroll
                for (int j = 0; j < 16; ++j) { sf[j] = s; s *= f[j]; }
            }
            EB[pc * 64 + pk] = dir ? pj[0] : pj[15];
#pragma unroll
            for (int j = 0; j < 16; ++j) { const int t = 16 * pc + j;
                QT[t * SC_LD + pk] = (bf16)(pk2(qv[j] * pj[j], 0.f) & 0xffffu);
                KH[t * SC_LD + pk] = (bf16)(pk2(kv[j] * __builtin_amdgcn_rcpf(fmaxf(pj[j], 1e-30f)), 0.f) & 0xffffu); }
#pragma unroll
            for (int j = 0; j < 16; j += 2) *(LAS unsigned*)(KBT + pk * SC_LD + 16 * pc + j) = pk2(kv[j] * sf[j], kv[j + 1] * sf[j + 1]);
        }
        {
            const int t = htid >> 2, vc = htid & 3;
            const u32x4 v0 = rv0, v1 = rv1;
            LAS bf16* d = VT + (16 * vc) * SC_LD + t;
            d[0 * SC_LD] = (bf16)(v0.x & 0xffffu); d[1 * SC_LD] = (bf16)(v0.x >> 16); d[2 * SC_LD] = (bf16)(v0.y & 0xffffu); d[3 * SC_LD] = (bf16)(v0.y >> 16);
            d[4 * SC_LD] = (bf16)(v0.z & 0xffffu); d[5 * SC_LD] = (bf16)(v0.z >> 16); d[6 * SC_LD] = (bf16)(v0.w & 0xffffu); d[7 * SC_LD] = (bf16)(v0.w >> 16);
            d[8 * SC_LD] = (bf16)(v1.x & 0xffffu); d[9 * SC_LD] = (bf16)(v1.x >> 16); d[10 * SC_LD] = (bf16)(v1.y & 0xffffu); d[11 * SC_LD] = (bf16)(v1.y >> 16);
            d[12 * SC_LD] = (bf16)(v1.z & 0xffffu); d[13 * SC_LD] = (bf16)(v1.z >> 16); d[14 * SC_LD] = (bf16)(v1.w & 0xffffu); d[15 * SC_LD] = (bf16)(v1.w >> 16);
        }
        __syncthreads();
        if (gi < 3) SCAN_LOAD_RAW(gi + 1);
        if (!passB && htid < DK) Dk *= (EB[htid] * EB[64 + htid]) * (EB[128 + htid] * EB[192 + htid]);
        for (int ci = 0; ci < 4; ++ci) {
            const int c = dir ? 3 - ci : ci;
            const bf16x4 vb = *(const LAS bf16x4*)(VT + (16 * slab + fr) * SC_LD + 16 * c + 4 * fq);
            if (passB) {
                f32x4 at = (f32x4){0.f, 0.f, 0.f, 0.f};
                bf16x8 qa[NKS];
#pragma unroll
                for (int ks = 0; ks < NKS; ++ks) {
                    const LAS bf16* qp = QT + (16 * c + fr) * SC_LD + 32 * ks + 4 * fq; const LAS bf16* kp = KH + (16 * c + fr) * SC_LD + 32 * ks + 4 * fq;
                    const u32x2 q0 = *(const LAS u32x2*)qp, q1 = *(const LAS u32x2*)(qp + 16), k0 = *(const LAS u32x2*)kp, k1 = *(const LAS u32x2*)(kp + 16);
                    u32x4 qw; qw.x = q0.x; qw.y = q0.y; qw.z = q1.x; qw.w = q1.y; u32x4 kw; kw.x = k0.x; kw.y = k0.y; kw.z = k1.x; kw.w = k1.y;
                    qa[ks] = __builtin_bit_cast(bf16x8, qw);
                    at = __builtin_amdgcn_mfma_f32_16x16x32_bf16(__builtin_bit_cast(bf16x8, kw), qa[ks], at, 0, 0, 0);
                }
                asm volatile("s_nop 15\n\ts_nop 15" : "+v"(at));
#pragma unroll
                for (int j = 0; j < 4; ++j) { const int sidx = 4 * fq + j; const bool keep = dir ? (sidx >= fr) : (sidx <= fr); at[j] = keep ? at[j] : 0.f; }
                u32x2 pw; pw.x = pk2(at[0], at[1]); pw.y = pk2(at[2], at[3]);
                f32x4 o = __builtin_amdgcn_mfma_f32_16x16x16bf16_1k(__builtin_bit_cast(bf16x4, pw), vb, (f32x4){0.f, 0.f, 0.f, 0.f}, 0, 0, 0);
                asm volatile("s_nop 15\n\ts_nop 15" : "+v"(o));
#pragma unroll
                for (int ks = 0; ks < NKS; ++ks) { u32x4 sw; sw.x = pk2(S[2 * ks][0], S[2 * ks][1]); sw.y = pk2(S[2 * ks][2], S[2 * ks][3]); sw.z = pk2(S[2 * ks + 1][0], S[2 * ks + 1][1]); sw.w = pk2(S[2 * ks + 1][2], S[2 * ks + 1][3]);
                    o = __builtin_amdgcn_mfma_f32_16x16x32_bf16(qa[ks], __builtin_bit_cast(bf16x8, sw), o, 0, 0, 0); }
                asm volatile("s_nop 15\n\ts_nop 15" : "+v"(o));
                LAS bf16* op = OS + (T0 + 16 * c + 4 * fq) * 64 + 16 * slab + fr;
#pragma unroll
                for (int j = 0; j < 4; ++j) op[j * 64] = (bf16)(pk2(bf2f(op[j * 64]) + o[j], 0.f) & 0xffffu);
            }
#pragma unroll
            for (int m = 0; m < NM; ++m) { const f32x4 eb = *(const LAS f32x4*)(EB + c * 64 + 16 * m + 4 * fq);
                const bf16x4 kb = *(const LAS bf16x4*)(KBT + (16 * m + fr) * SC_LD + 16 * c + 4 * fq);
                S[m] = __builtin_amdgcn_mfma_f32_16x16x16bf16_1k(kb, vb, S[m] * eb, 0, 0, 0); asm volatile("s_nop 15\n\ts_nop 15" : "+v"(S[m])); }
        }
    }
    if (!passB) {
        float* sp = SEGS + ((size_t)(ch * NBLK + blk) * DK + 4 * fq) * 64 + 16 * slab + fr;
#pragma unroll
        for (int m = 0; m < NM; ++m)
#pragma unroll
            for (int j = 0; j < 4; ++j) sp[(16 * m + j) * 64] = S[m][j];
        if (htid < DK) SEGD[(size_t)(ch * NBLK + blk) * DK + htid] = Dk;
    } else {
        __syncthreads();
        const float* ng = ap->in[HG ? I_HGNG : I_GLNG] + l * 256 + h * 64; const int gcol = (HG ? C_HGG : C_GLG) + h * 64, ycol = (HG ? 256 : 512) + h * 64;
        const float gn = ng[lane];
#pragma unroll 8
        for (int q = 0; q < 32; ++q) { const int tok = wave * 32 + q; const float o = bf2f(OS[tok * 64 + lane]);
            const float ss = wave_sum(o * o); const float gt = bf2f(P[(row0 + tok) * LDP + gcol + lane]);
            const float y = o * rsqrtf(ss * (1.f / 64.f) + EPS) * gn * siluf_(gt);
            Y[(row0 + tok) * DM + ycol + lane] = (bf16)(pk2(y, 0.f) & 0xffffu); }
    }
}

#define IN(k) (lo <= (k) && (k) < hi)
#if MK_N_LAUNCHES == 1
#define SEAM(k) do { if (IN(k) && IN((k) + 1)) xcd_barrier(bar); } while (0)
#else
#define SEAM(k) do { } while (0)
#endif
#define PHASE_BEGIN \
    int lane; asm volatile("v_mbcnt_lo_u32_b32 %0, -1, 0\n\tv_mbcnt_hi_u32_b32 %0, -1, %0" : "=v"(lane)); const int wave = wave0; const int tid = wave * 64 + lane; \
    const int gw = bid * NWAVES + wave, NGW = G * NWAVES; (void)gw; (void)NGW; (void)lane; \
    ArgP ap = (ArgP)__builtin_amdgcn_kernarg_segment_ptr(); asm volatile("" : "+s"(ap)); \
    unsigned char* ws = ap->ws; \
    float* XL = (float*)(ws + WS_XL); bf16* H = (bf16*)(ws + WS_H); bf16* Y = (bf16*)(ws + WS_Y); bf16* P = (bf16*)(ws + WS_P); \
    float* MP = (float*)(ws + WS_MP); float* MOD = (float*)(ws + WS_MOD); float* LB = (float*)(ws + WS_LB); \
    float* COS = (float*)(ws + WS_ROPE); float* SIN = COS + SEQ * 32; \
    int* RL = (int*)(ws + WS_RL); float* SG = (float*)(ws + WS_SG); \
    bf16* XS = (bf16*)(ws + WS_XS); bf16* ACT = (bf16*)(ws + WS_ACT); bf16* YS = (bf16*)(ws + WS_YS); \
    (void)XL; (void)H; (void)Y; (void)P; (void)MP; (void)MOD; (void)LB; (void)COS; (void)SIN; (void)RL; (void)SG; (void)XS; (void)ACT; (void)YS;


__device__ __forceinline__ void route_decide(const float (&s)[16], const float* rb, int lane, int& e0, int& e1, float& a0, float& a1) {
    float r8[8], r4[4], r2[2];
    const bool b5 = (lane & 32) != 0, b4 = (lane & 16) != 0, b3 = (lane & 8) != 0, b2 = (lane & 4) != 0;
#pragma unroll
    for (int j = 0; j < 8; ++j) { const float keep = b5 ? s[j + 8] : s[j], send = b5 ? s[j] : s[j + 8]; r8[j] = keep + __shfl_xor(send, 32); }
#pragma unroll
    for (int j = 0; j < 4; ++j) { const float keep = b4 ? r8[j + 4] : r8[j], send = b4 ? r8[j] : r8[j + 4]; r4[j] = keep + __shfl_xor(send, 16); }
#pragma unroll
    for (int j = 0; j < 2; ++j) { const float keep = b3 ? r4[j + 2] : r4[j], send = b3 ? r4[j] : r4[j + 2]; r2[j] = keep + __shfl_xor(send, 8); }
    float r1; { const float keep = b2 ? r2[1] : r2[0], send = b2 ? r2[0] : r2[1]; r1 = keep + __shfl_xor(send, 4); }
    r1 += __shfl_xor(r1, 2); r1 += __shfl_xor(r1, 1);
    float af[16];
#pragma unroll
    for (int e = 0; e < 16; ++e) af[e] = sigmoidf_(__builtin_bit_cast(float, __builtin_amdgcn_readlane(__builtin_bit_cast(int, r1), 4 * e)));
    float bestsum = -1e30f; e0 = 0; e1 = 1; a0 = 0.f; a1 = 0.f;
#pragma unroll
    for (int gI = 0; gI < 4; ++gI) { float m1 = -1e30f, m2 = -1e30f; int i1 = 0, i2 = 0; float f1 = 0.f, f2 = 0.f;
#pragma unroll
        for (int i = 0; i < 4; ++i) { const float bv = af[gI * 4 + i] + rb[gI * 4 + i];
            if (bv > m1) { m2 = m1; i2 = i1; f2 = f1; m1 = bv; i1 = gI * 4 + i; f1 = af[gI * 4 + i]; } else if (bv > m2) { m2 = bv; i2 = gI * 4 + i; f2 = af[gI * 4 + i]; } }
        const float gs = m1 + m2; if (gs > bestsum) { bestsum = gs; e0 = i1; e1 = i2; a0 = f1; a1 = f2; } }
}

template <int l>
__device__ __forceinline__ void layer_phases(const int lo, const int hi, LAS unsigned char* lds, const int bid, const int G, const int wave0, const XcdBarrier& bar) {
        constexpr int pb = 3 + 10 * l;
        if (IN(pb + 0)) for (int rep = 0; rep < REP(0); ++rep) {
            PHASE_BEGIN
            const float* MODL = MOD + (size_t)l * 3 * 6144; unsigned* cnt = (unsigned*)(ws + WS_CTL) + CW_CNT + l * 16 * 64; (void)MODL; (void)cnt;
            pg8::Gemm g{H, (const bf16*)(ws + WS_WIN), DM, DM, DM, nullptr, nullptr}; pg8::StaticOrder S; S.init(R, LDP, G, bid);
            pg8::EpiStoreBf16 E{P, LDP};
            pg8::gemm_phase<pg8::EpiStoreBf16, pg8::StaticOrder>(lds, g, S, E, tid);
        }
        SEAM(pb + 0);
        if (IN(pb + 1)) for (int rep = 0; rep < REP(1); ++rep) {
            PHASE_BEGIN
            const float* MODL = MOD + (size_t)l * 3 * 6144; unsigned* cnt = (unsigned*)(ws + WS_CTL) + CW_CNT + l * 16 * 64; (void)MODL; (void)cnt;
            constexpr int n_hg = 2 * 4 * NBLK, n_ctxatt = (l == 0 ? 8 : 0), total = 256 + n_hg + n_ctxatt + n_hg;
            unsigned* qctr = (unsigned*)(ws + WS_CTL) + CW_Q + ((l * 2 + 0) * 2 + rep) * 64;
            volatile LAS unsigned* MQ = (volatile LAS unsigned*)(lds + MISC_OFF) + 16;
            for (;;) {
                __syncthreads(); if (tid == 0) MQ[0] = atomicAdd(qctr, 1u); __syncthreads();
                int it = (int)MQ[0]; if (it >= total) break;
                if (it < 256) { const int b = it >> 7, kvh = (it >> 6) & 1, qb = it & 63; for (int ur = 0; ur < UREP(0); ++ur) attn_unit(P, Y, COS, SIN, ap->in[I_SINK] + l * 4, b, kvh, qb, false, lds, tid, wave, lane); continue; }
                it -= 256;
                if (it < n_hg) { for (int ur = 0; ur < UREP(1); ++ur) scan_mfma<true>(ap, l, 0, it / (4 * NBLK), (it / NBLK) & 3, it % NBLK, lds, tid, wave, lane); continue; }
                it -= n_hg;
                if (it < n_ctxatt) { attn_unit(P, Y, COS, SIN, ap->in[I_SINK] + l * 4, it >> 2, (it >> 1) & 1, it & 1, true, lds, tid, wave, lane); continue; }
                it -= n_ctxatt;
                for (int ur = 0; ur < UREP(1); ++ur) scan_mfma<false>(ap, l, 0, it / (4 * NBLK), (it / NBLK) & 3, it % NBLK, lds, tid, wave, lane);
            }
        }
        SEAM(pb + 1);
        if (IN(pb + 2)) for (int rep = 0; rep < REP(2); ++rep) {
            PHASE_BEGIN
            const float* MODL = MOD + (size_t)l * 3 * 6144; unsigned* cnt = (unsigned*)(ws + WS_CTL) + CW_CNT + l * 16 * 64; (void)MODL; (void)cnt;
            constexpr int n_hg = 2 * 4 * NBLK, n_conv = R / 32, total = 2 * n_hg + n_conv;
            unsigned* qctr = (unsigned*)(ws + WS_CTL) + CW_Q + ((l * 2 + 1) * 2 + rep) * 64;
            volatile LAS unsigned* MQ = (volatile LAS unsigned*)(lds + MISC_OFF) + 16;
            for (;;) {
                __syncthreads(); if (tid == 0) MQ[0] = atomicAdd(qctr, 1u); __syncthreads();
                int it = (int)MQ[0]; if (it >= total) break;
                if (it < n_hg) { for (int ur = 0; ur < UREP(2); ++ur) scan_mfma<true>(ap, l, 1, it / (4 * NBLK), (it / NBLK) & 3, it % NBLK, lds, tid, wave, lane); continue; }
                it -= n_hg;
                if (it < n_hg) { for (int ur = 0; ur < UREP(2); ++ur) scan_mfma<false>(ap, l, 1, it / (4 * NBLK), (it / NBLK) & 3, it % NBLK, lds, tid, wave, lane); continue; }
                it -= n_hg;
                for (int ur = 0; ur < UREP(3); ++ur) conv_unit(P, Y, ap->in[I_CONVW] + l * 31 * 256, ap->in[I_CONVB] + l * 256, ap->in[I_CLNG] + l * 256, ap->in[I_CLNB] + l * 256, it, lds, tid, wave, lane);
            }
        }
        SEAM(pb + 2);
        if (IN(pb + 3)) for (int rep = 0; rep < REP(3); ++rep) {
            PHASE_BEGIN
            const float* MODL = MOD + (size_t)l * 3 * 6144; unsigned* cnt = (unsigned*)(ws + WS_CTL) + CW_CNT + l * 16 * 64; (void)MODL; (void)cnt;
            pg8::MergeOrder S; S.S.init(NBATCH * SEQ, DM, G, bid, 1);
            pg8::Gemm g{Y, (const bf16*)(ws + WS_WBR), DM, DM, 256, nullptr, nullptr}; pg8::EpiMerge E{P, H};
            pg8::gemm_phase<pg8::EpiMerge, pg8::MergeOrder>(lds, g, S, E, tid);
            if (l == 0) for (int t = bid; t < 256; t += G) ctx_tile<0>(t, Y, (const bf16*)(ws + WS_WBR), P, H, nullptr, nullptr, nullptr, wave, lane);
        }
        SEAM(pb + 3);
        if (IN(pb + 4)) for (int rep = 0; rep < REP(4); ++rep) {
            PHASE_BEGIN
            const float* MODL = MOD + (size_t)l * 3 * 6144; unsigned* cnt = (unsigned*)(ws + WS_CTL) + CW_CNT + l * 16 * 64; (void)MODL; (void)cnt;
            pg8::Gemm g{H, (const bf16*)(ws + WS_WOUT), DM, DM, DM, nullptr, nullptr}; pg8::StaticOrder S; S.init(NBATCH * SEQ, DM, G, bid, 1);
            const float* xin_ = nullptr; const float* cin_ = nullptr; if (l == 0) { xin_ = ap->in[I_X]; cin_ = ap->in[I_CTX]; }
            pg8::EpiOut E{XL, MODL, xin_, cin_, (rep + 1 == REP(4)) ? 1.f : 0.f};
            pg8::gemm_phase<pg8::EpiOut, pg8::StaticOrder>(lds, g, S, E, tid);
            if (l == 0) for (int t = bid; t < 256; t += G) if (rep + 1 == REP(4)) ctx_tile<1>(t, H, (const bf16*)(ws + WS_WOUT), nullptr, nullptr, XL, MODL + (2 * 6 + 2) * DM, ap->in[I_CTX], wave, lane);
        }
        SEAM(pb + 4);
        if (IN(pb + 5)) for (int rep = 0; rep < REP(5); ++rep) {
            PHASE_BEGIN
            const float* MODL = MOD + (size_t)l * 3 * 6144; unsigned* cnt = (unsigned*)(ws + WS_CTL) + CW_CNT + l * 16 * 64; (void)MODL; (void)cnt;
            LAS float* RW = (LAS float*)lds;
            __syncthreads();
            for (int d = tid; d < DM; d += NTHREADS) { const f32x4* rp = (const f32x4*)(ap->in[I_RW] + d * 16);
#pragma unroll
                for (int q = 0; q < 4; ++q) { const f32x4 w = rp[q]; RW[(4 * q) * DM + d] = w.x; RW[(4 * q + 1) * DM + d] = w.y; RW[(4 * q + 2) * DM + d] = w.z; RW[(4 * q + 3) * DM + d] = w.w; } }
            LAS unsigned* LC = (LAS unsigned*)(lds + 65536);
            LAS unsigned* LR = LC + 32;
            const int rpw = (R + G - 1) / G, rbeg = bid * rpw, rend = (rbeg + rpw < R) ? rbeg + rpw : R;
            if (tid < 32) LC[tid] = 0u;
            __syncthreads();
            const float* gf = ap->in[I_GFFN] + l * DM;
            for (int row = rbeg + wave; row < rend; row += NWAVES) { const int cond = row_cond(row); if (l == 1 && cond == 2) continue;
                asm volatile("" ::: "memory");
                const f32x4* x4 = (const f32x4*)(XL + (size_t)row * DM); f32x4 v[4]; float ss = 0.f;
#pragma unroll
                for (int q = 0; q < 4; ++q) { v[q] = x4[lane + 64 * q]; ss += (v[q].x * v[q].x + v[q].y * v[q].y) + (v[q].z * v[q].z + v[q].w * v[q].w); }
                const float rstd = rsqrtf(wave_sum(ss) * (1.f / DM) + EPS);
                const float* md = MODL + (size_t)cond * 6144;
#pragma unroll
                for (int q = 0; q < 4; ++q) { const int c = 4 * lane + 256 * q; const f32x4 gg = *(const f32x4*)(gf + c), sh = *(const f32x4*)(md + 3 * DM + c), sc = *(const f32x4*)(md + 4 * DM + c);
                    v[q] = (v[q] * rstd) * gg * (sc + 1.0f) + sh; u32x2 w; w.x = pk2(v[q].x, v[q].y); w.y = pk2(v[q].z, v[q].w); *(u32x2*)(H + (size_t)row * DM + c) = w; }
                float sa[16];
#pragma unroll
                for (int e = 0; e < 16; ++e) { float s0 = 0.f;
#pragma unroll
                    for (int q = 0; q < 4; ++q) { const f32x4 w = *(const LAS f32x4*)(RW + e * DM + 4 * lane + 256 * q); s0 += (v[q].x * w.x + v[q].y * w.y) + (v[q].z * w.z + v[q].w * w.w); }
                    sa[e] = s0; }
                int e0, e1; float a0, a1;
                route_decide(sa, ap->in[I_RB], lane, e0, e1, a0, a1);
                if (lane == 0) { const float inv = 1.f / (a0 + a1);
                    const unsigned r0 = __hip_atomic_fetch_add(LC + e0, 1u, __ATOMIC_RELAXED, __HIP_MEMORY_SCOPE_WORKGROUP), r1 = __hip_atomic_fetch_add(LC + e1, 1u, __ATOMIC_RELAXED, __HIP_MEMORY_SCOPE_WORKGROUP);
                    LR[(row - rbeg) * 2] = ((unsigned)e0 << 24) | r0; LR[(row - rbeg) * 2 + 1] = ((unsigned)e1 << 24) | r1; SG[row * 2] = a0 * inv; SG[row * 2 + 1] = a1 * inv; }
            }
            __syncthreads();
            if (tid < 16) LC[16 + tid] = atomicAdd(cnt + ((rep + 1 == REP(5)) ? 0 : 4096) + tid * 64, LC[tid]);
            __syncthreads();
            for (int i = tid; i < (rend - rbeg) * 2; i += NTHREADS) { const int row = rbeg + (i >> 1); if (l == 1 && row_cond(row) == 2) continue;
                const unsigned w = LR[i]; const unsigned e = w >> 24; RL[(size_t)e * RLCAP + LC[16 + e] + (w & 0xffffffu)] = row * 2 + (i & 1); }
        }
        SEAM(pb + 5);
        if (IN(pb + 7)) for (int rep = 0; rep < REP(7); ++rep) {
            PHASE_BEGIN
            const float* MODL = MOD + (size_t)l * 3 * 6144; unsigned* cnt = (unsigned*)(ws + WS_CTL) + CW_CNT + l * 16 * 64; (void)MODL; (void)cnt;
            pg8::Gemm g{H, (const bf16*)(ws + WS_W13), DM, DM, DM, RL, cnt};
            pg8::MoeOrder S; S.init(cnt, 8, G, bid);
            pg8::EpiMoe1 E{ACT};
            pg8::gemm_phase<pg8::EpiMoe1, pg8::MoeOrder, true>(lds, g, S, E, tid);
        }
        SEAM(pb + 7);
        if (IN(pb + 8)) for (int rep = 0; rep < REP(8); ++rep) {
            PHASE_BEGIN
            const float* MODL = MOD + (size_t)l * 3 * 6144; unsigned* cnt = (unsigned*)(ws + WS_CTL) + CW_CNT + l * 16 * 64; (void)MODL; (void)cnt;
            pg8::Gemm g{ACT, (const bf16*)(ws + WS_W2), DM, DM, DM, nullptr, nullptr}; pg8::MoeOrder S; S.init(cnt, 4, G, bid);
            pg8::EpiMoe2 E{YS, RL, cnt};
            pg8::gemm_phase<pg8::EpiMoe2, pg8::MoeOrder>(lds, g, S, E, tid);
        }
        SEAM(pb + 8);
        if (IN(pb + 9)) for (int rep = 0; rep < REP(9); ++rep) {
            PHASE_BEGIN
            const float* MODL = MOD + (size_t)l * 3 * 6144; unsigned* cnt = (unsigned*)(ws + WS_CTL) + CW_CNT + l * 16 * 64; (void)MODL; (void)cnt;
            for (int row = gw; row < R; row += NGW) { const int cond = row_cond(row); if (l == 1 && cond == 2) continue;
                const float g0 = (rep + 1 == REP(9)) ? SG[row * 2] : 0.f, g1 = (rep + 1 == REP(9)) ? SG[row * 2 + 1] : 0.f;
                const f32x4* x4 = (const f32x4*)(XL + (size_t)row * DM); const float* gm = MODL + (size_t)cond * 6144 + 5 * DM; f32x4 v[4];
#pragma unroll
                for (int q = 0; q < 4; ++q) { const int c = 4 * lane + 256 * q; const u32x2 y0 = *(const u32x2*)(YS + (size_t)(row * 2) * DM + c), y1 = *(const u32x2*)(YS + (size_t)(row * 2 + 1) * DM + c);
                    f32x4 y; y.x = g0 * bflo(y0.x) + g1 * bflo(y1.x); y.y = g0 * bfhi(y0.x) + g1 * bfhi(y1.x); y.z = g0 * bflo(y0.y) + g1 * bflo(y1.y); y.w = g0 * bfhi(y0.y) + g1 * bfhi(y1.y);
                    v[q] = x4[lane + 64 * q] + *(const f32x4*)(gm + c) * y; }
                if (l == 0) {
                    f32x4* xo = (f32x4*)(XL + (size_t)row * DM);
#pragma unroll
                    for (int q = 0; q < 4; ++q) xo[lane + 64 * q] = v[q];
                    const float* md = MOD + (size_t)(1 * 3 + cond) * 6144;
                    modnorm_store(v, ap->in[I_GMIX] + DM, md, md + DM, H + (size_t)row * DM, lane);
                } else {
                    float ss = 0.f;
#pragma unroll
                    for (int q = 0; q < 4; ++q) ss += (v[q].x * v[q].x + v[q].y * v[q].y) + (v[q].z * v[q].z + v[q].w * v[q].w);
                    const float rstd = rsqrtf(wave_sum(ss) * (1.f / DM) + EPS);
                    const int b = row / RB, t = row - b * RB - CTXL; f32x4* o4 = (f32x4*)(ap->out + ((size_t)b * SEQ + t) * DM);
#pragma unroll
                    for (int q = 0; q < 4; ++q) o4[lane + 64 * q] = v[q] * rstd * *(const f32x4*)(ap->in[I_FINALG] + 4 * lane + 256 * q);
                }
            }
            if (l == 0) { __syncthreads(); convert_weights(ap, 1, lds, gw, NGW, wave, lane); }
        }
        SEAM(pb + 9);
}

__global__ void __launch_bounds__(NTHREADS, 2) fwd(Args a) {
    extern __shared__ __attribute__((aligned(16))) unsigned char lds_raw[];
    LAS unsigned char* lds = (LAS unsigned char*)lds_raw;
    volatile LAS unsigned* MISC = (volatile LAS unsigned*)(lds + MISC_OFF);
    const int tid0 = threadIdx.x; const int wave0 = __builtin_amdgcn_readfirstlane(tid0 >> 6);
    const int G = gridDim.x, bid = blockIdx.x;
    unsigned* ctl = (unsigned*)(a.ws + WS_CTL);
    for (int u = tid0; u < (LDS_BYTES - RING_BYTES) / 4; u += NTHREADS) ((LAS unsigned*)(lds + RING_BYTES))[u] = 0u;
    __syncthreads();
    XcdBarrier bar; bar.bar = ctl + CW_BAR; bar.x = 0; bar.st = nullptr;
#if MK_N_LAUNCHES == 1
    bar = xcd_barrier_post(ctl + CW_BAR, MISC + 8);
#endif
    const int lo = a.ph_lo, hi = a.ph_hi;
    if (IN(0)) for (int rep = 0; rep < REP(10); ++rep) {
        PHASE_BEGIN
        for (int it = gw; it < 384; it += NGW) { const int l = it / 192, r = it % 192, kc = r / 24, jb = r % 24;
            f32x4 a0 = {0.f, 0.f, 0.f, 0.f}, a1 = a0, a2 = a0;
            const float* wp = ap->in[I_WMOD] + ((size_t)l * DM + kc * 128) * 6144 + jb * 256 + lane * 4;
            for (int k = 0; k < 128; ++k) { const f32x4 w = *(const f32x4*)(wp + (size_t)k * 6144); const int kk = kc * 128 + k;
                const float s0 = siluf_(ap->in[I_C][kk]), s1 = siluf_(ap->in[I_C][DM + kk]), s2 = siluf_(ap->in[I_CCTX][kk]);
                a0 += w * s0; a1 += w * s1; a2 += w * s2; }
            float* mp = MP + ((size_t)(l * 8 + kc) * 3) * 6144 + jb * 256 + lane * 4;
            *(f32x4*)(mp) = a0; *(f32x4*)(mp + 6144) = a1; *(f32x4*)(mp + 2 * 6144) = a2; }
        if (bid == 0) { for (int i = tid; i < 512; i += NTHREADS) { const float x0 = ap->in[I_LBLOG][i], x1 = ap->in[I_LBLOG][512 + i]; const float m = fmaxf(x0, x1);
            const float e0 = expf(x0 - m), e1 = expf(x1 - m); LB[i] = 0.f; LB[512 + i] = e1 / (e0 + e1); } }
        for (int idx = bid * NTHREADS + tid; idx < SEQ * 32; idx += G * NTHREADS) { const int t = idx >> 5, ai = idx & 31; const int ax = ai >> 4, i = ai & 15;
            const float inv = powf(10000.0f, -(float)i / 16.0f); const float pos = (float)(ax == 0 ? (t >> 6) : (t & 63)); const float ang = pos * inv;
            COS[idx] = cosf(ang); SIN[idx] = sinf(ang); }
        convert_weights(ap, 0, lds, gw, NGW, wave, lane);
    }
    SEAM(0);
    if (IN(1)) for (int rep = 0; rep < REP(11); ++rep) {
        PHASE_BEGIN
        for (int idx = bid * NTHREADS + tid; idx < 2 * 3 * 6144; idx += G * NTHREADS) { const int l = idx / (3 * 6144), r = idx % (3 * 6144), cond = r / 6144, j = r % 6144;
            float s = ap->in[I_BMOD][l * 6144 + j];
#pragma unroll
            for (int kc = 0; kc < 8; ++kc) s += MP[((size_t)(l * 8 + kc) * 3 + cond) * 6144 + j];
            MOD[idx] = s; }
    }
    SEAM(1);
    if (IN(2)) for (int rep = 0; rep < REP(12); ++rep) {
        PHASE_BEGIN
        for (int row = gw; row < R; row += NGW) { const int cond = row_cond(row); const int b = row / RB, j = row - b * RB;
            const f32x4* x4 = (const f32x4*)((j < CTXL) ? ap->in[I_CTX] + ((size_t)b * CTXL + j) * DM : ap->in[I_X] + ((size_t)b * SEQ + (j - CTXL)) * DM); f32x4 v[4];
#pragma unroll
            for (int q = 0; q < 4; ++q) v[q] = x4[lane + 64 * q];
            const float* md = MOD + (size_t)(0 * 3 + cond) * 6144;
            modnorm_store(v, ap->in[I_GMIX], md, md + DM, H + (size_t)row * DM, lane); }
    }
    SEAM(2);

    layer_phases<0>(lo, hi, lds, bid, G, wave0, bar);
    layer_phases<1>(lo, hi, lds, bid, G, wave0, bar);
}

constexpr int NPHASES = 23;
extern "C" void kernel_launch(void* const* d_in, const int* in_sizes, int n_in, void* d_out, int out_size, void* d_ws, size_t ws_size, hipStream_t stream) {
    static int grid = 0;
    if (grid == 0) {
        int dev = 0, cus = 0, per_cu = 0;
        if (hipGetDevice(&dev) != hipSuccess || hipDeviceGetAttribute(&cus, hipDeviceAttributeMultiprocessorCount, dev) != hipSuccess) { grid = -1; return; }
        if (hipFuncSetAttribute((const void*)fwd, hipFuncAttributeMaxDynamicSharedMemorySize, LDS_BYTES) != hipSuccess) { grid = -1; return; }
        if (hipOccupancyMaxActiveBlocksPerMultiprocessor(&per_cu, (const void*)fwd, NTHREADS, LDS_BYTES) != hipSuccess || per_cu < 1) per_cu = 1;
        (void)hipGetLastError();
        grid = cus;
        if (ws_size < WS_END) fprintf(stderr, "kernel_launch: workspace too small: %zu < %zu\n", ws_size, (size_t)WS_END);
    }
    if (grid < 0) return;
    (void)hipMemsetAsync((char*)d_ws + WS_CTL, 0, CTL_ZERO_BYTES, stream);
    Args a{};
    for (int i = 0; i < 30; ++i) a.in[i] = (const float*)d_in[i];
    a.out = (float*)d_out; a.ws = (unsigned char*)d_ws;
#if MK_N_LAUNCHES == 1
    a.ph_lo = 0; a.ph_hi = NPHASES;
    hipLaunchKernelGGL(fwd, dim3(grid), dim3(NTHREADS), LDS_BYTES, stream, a);
#else
    for (int ph = 0; ph < NPHASES; ++ph) { a.ph_lo = ph; a.ph_hi = ph + 1; hipLaunchKernelGGL(fwd, dim3(grid), dim3(NTHREADS), LDS_BYTES, stream, a); }
#endif
}
```
